# Optimizing an MI355X kernel written in HIP

```python
import math
import jax, jax.numpy as jnp
from jax import lax
import numpy as np

D_MODEL = 1024
BATCH = 8
SEQ = 4096
DEPTH = 2

CTX_LEN = 256
GRID_W = 64
D_MIX = D_MODEL
D_MLSTM = D_MIX // 2
D_HYENA = D_MIX - D_MLSTM
MLSTM_HEADS = 4
MLSTM_HEAD_DIM = D_MLSTM // MLSTM_HEADS
MLSTM_CHUNK = 64
N_GATES = 4 * MLSTM_HEADS
SHORT_CONV = 3
HYENA_ORDER = 2
FILTER_BANDS = 8
FILTER_EMB = 1 + 2 * FILTER_BANDS
FILTER_HIDDEN = 64
DECAY_TARGET = 1e-2
FAST_DECAY_PCT = 0.3
SLOW_DECAY_PCT = 1.5
MIN_DECAY = math.log(DECAY_TARGET) / SLOW_DECAY_PCT
MAX_DECAY = math.log(DECAY_TARGET) / FAST_DECAY_PCT
RMS_EPS = 1e-6
SPLIT_SIZES = [2 * D_MLSTM, D_MLSTM, D_MLSTM, D_MLSTM, N_GATES, (HYENA_ORDER + 1) * D_HYENA, D_HYENA]
D_IN = sum(SPLIT_SIZES)

kernel_name = "hybrid_mlstm_hyena_prefix_dit"


def rms_norm(x, g):
    xf = x.astype(jnp.float32)
    y = xf * lax.rsqrt(jnp.mean(xf * xf, axis=-1, keepdims=True) + RMS_EPS)
    return (y * g.astype(jnp.float32)).astype(x.dtype)


def _conv3(u, w, b):
    p = jnp.pad(u, [(0, 0)] * (u.ndim - 2) + [(1, 1), (0, 0)])
    return p[..., :-2, :] * w[0] + p[..., 1:-1, :] * w[1] + p[..., 2:, :] * w[2] + b


def short_conv(u, w, b, rows):
    if rows is None:
        return _conv3(u, w, b)
    bsz, L, ch = u.shape
    return _conv3(u.reshape(bsz, rows, GRID_W, ch), w, b).reshape(bsz, L, ch)


def mlstm_chunkwise(q, k, v, i_pre, f_pre, state):
    bsz, nh, L, d = q.shape
    nc = L // MLSTM_CHUNK

    def to_chunks(a):
        a = a.reshape((bsz, nh, nc, MLSTM_CHUNK) + a.shape[3:])
        return jnp.moveaxis(a, 2, 0)

    logf = jax.nn.log_sigmoid(f_pre)
    lower = jnp.tril(jnp.ones((MLSTM_CHUNK, MLSTM_CHUNK), dtype=bool))

    def step(carry, inp):
        C, n, m = carry
        qc, kc, vc, ic, fc = inp
        bcum = jnp.cumsum(fc, axis=-1)
        dmat = bcum[..., :, None] - bcum[..., None, :] + ic[..., None, :]
        dmat = jnp.where(lower, dmat, -jnp.inf)
        inter = bcum + m[..., None]
        m_t = jnp.maximum(inter, jnp.max(dmat, axis=-1))
        s = jnp.einsum('bhtd,bhsd->bhts', qc, kc) * jnp.exp(dmat - m_t[..., None])
        w_inter = jnp.exp(inter - m_t)
        num = jnp.einsum('bhts,bhsv->bhtv', s, vc) + w_inter[..., None] * jnp.einsum('bhtk,bhkv->bhtv', qc, C)
        den = jnp.sum(s, axis=-1) + w_inter * jnp.einsum('bhtk,bhk->bht', qc, n)
        h = num / jnp.maximum(jnp.abs(den), jnp.exp(-m_t))[..., None]
        b_last = bcum[..., -1]
        src = b_last[..., None] - bcum + ic
        m_new = jnp.maximum(b_last + m, jnp.max(src, axis=-1))
        ws = jnp.exp(src - m_new[..., None])
        wc = jnp.exp(b_last + m - m_new)
        C_new = wc[..., None, None] * C + jnp.einsum('bhs,bhsk,bhsv->bhkv', ws, kc, vc)
        n_new = wc[..., None] * n + jnp.einsum('bhs,bhsk->bhk', ws, kc)
        return (C_new, n_new, m_new), h

    state, h = lax.scan(step, state, (to_chunks(q), to_chunks(k), to_chunks(v), to_chunks(i_pre), to_chunks(logf)))
    h = jnp.moveaxis(h, 0, 2).reshape(bsz, nh, L, d)
    return h, state


def mlstm_prep(u_qk, v, g, b_gates, conv_w, conv_b, rows):
    bsz, L, _ = v.shape
    qk = jax.nn.silu(short_conv(u_qk, conv_w, conv_b, rows).astype(jnp.float32))
    q, k = jnp.split(qk, 2, axis=-1)

    def heads(a):
        return a.reshape(bsz, L, MLSTM_HEADS, MLSTM_HEAD_DIM).transpose(0, 2, 1, 3).astype(jnp.float32)

    gates = (g + b_gates).astype(jnp.float32).reshape(bsz, L, 4, MLSTM_HEADS).transpose(2, 0, 3, 1)
    return heads(q), heads(k) * (MLSTM_HEAD_DIM ** -0.5), heads(v), gates


def mlstm_bidirectional(ctx_in, lat_in):
    qc, kc, vc, gc = ctx_in
    ql, kl, vl, gl = lat_in
    bsz = qc.shape[0]
    zero = (jnp.zeros((bsz, MLSTM_HEADS, MLSTM_HEAD_DIM, MLSTM_HEAD_DIM), jnp.float32),
            jnp.zeros((bsz, MLSTM_HEADS, MLSTM_HEAD_DIM), jnp.float32),
            jnp.zeros((bsz, MLSTM_HEADS), jnp.float32))
    flip = lambda a: jnp.flip(a, axis=2)
    hc_f, st_f = mlstm_chunkwise(qc, kc, vc, gc[0], gc[1], zero)
    hl_f, _ = mlstm_chunkwise(ql, kl, vl, gl[0], gl[1], st_f)
    hc_b, st_b = mlstm_chunkwise(flip(qc), flip(kc), flip(vc), flip(gc[2]), flip(gc[3]), zero)
    hl_b, _ = mlstm_chunkwise(flip(ql), flip(kl), flip(vl), flip(gl[2]), flip(gl[3]), st_b)
    return hc_f + flip(hc_b), hl_f + flip(hl_b)


def mlstm_output(h, o, zm, mh_gain):
    bsz, nh, L, d = h.shape
    h = h.transpose(0, 2, 1, 3) * jax.nn.sigmoid(o.astype(jnp.float32)).reshape(bsz, L, nh, d)
    h = h * lax.rsqrt(jnp.mean(h * h, axis=-1, keepdims=True) + RMS_EPS)
    h = h.reshape(bsz, L, nh * d) * mh_gain.astype(jnp.float32)
    return h * jax.nn.silu(zm.astype(jnp.float32))


def implicit_filters(L, w1, b1, freq, w2, b2, w3):
    f32 = lambda a: a.astype(jnp.float32)
    pos = jnp.arange(L, dtype=jnp.float32)
    bands = jnp.arange(1, FILTER_BANDS + 1, dtype=jnp.float32)
    ang = (2.0 * math.pi / L) * pos[:, None] * bands[None, :]
    feats = jnp.concatenate([(pos / L)[:, None], jnp.sin(ang), jnp.cos(ang)], axis=-1)
    hdn = jnp.sin(f32(freq[0]) * (feats @ f32(w1) + f32(b1)))
    hdn = jnp.sin(f32(freq[1]) * (hdn @ f32(w2) + f32(b2)))
    filt = (hdn @ f32(w3)).reshape(L, HYENA_ORDER, D_HYENA)
    offset = jnp.abs(pos - L // 2) / (L / 2)
    rates = jnp.abs(jnp.linspace(MIN_DECAY, MAX_DECAY, D_HYENA, dtype=jnp.float32))
    filt = filt * jnp.exp(-offset[:, None, None] * rates)
    return filt * lax.rsqrt(jnp.sum(filt * filt, axis=0, keepdims=True) + RMS_EPS)


def fft_long_conv(u, h, bias):
    L = u.shape[1]
    n = 2 * L
    uf = jnp.fft.rfft(u, n=n, axis=1)
    hf = jnp.fft.rfft(h, n=n, axis=0)
    y = jnp.fft.irfft(uf * hf[None], n=n, axis=1)[:, L // 2: L // 2 + L]
    return y + u * bias


def hyena_mixer(u_hy, zh, rows, conv_w, conv_b, filt, fbias):
    uv = short_conv(u_hy, conv_w, conv_b, rows).astype(jnp.float32)
    v, x1, x2 = jnp.split(uv, 3, axis=-1)
    fb = fbias.astype(jnp.float32)
    z = x1 * fft_long_conv(v, filt[:, 0], fb[0])
    y = x2 * fft_long_conv(z, filt[:, 1], fb[1])
    return y * jax.nn.silu(zh.astype(jnp.float32))


def split_proj(u):
    idx = [int(s) for s in np.cumsum(SPLIT_SIZES)[:-1]]
    return jnp.split(u, idx, axis=-1)


def setup_inputs(seed: int = 0) -> dict:
    key = jax.random.key(seed)
    ks = jax.random.split(key, 24)
    nrm = lambda k, shape, s: jax.random.normal(k, shape, jnp.float32) * s
    fbias = jnp.linspace(3.0, 6.0, MLSTM_HEADS, dtype=jnp.float32)
    zb = jnp.zeros_like(fbias)
    gate_offset = jnp.stack([zb, fbias, zb, fbias])[None]
    b_gates = (nrm(ks[9], (DEPTH, 4, MLSTM_HEADS), 0.1) + gate_offset).reshape(DEPTH, N_GATES)
    return {
        'x': nrm(ks[0], (BATCH, SEQ, D_MODEL), 1.0),
        'c': nrm(ks[1], (BATCH, D_MODEL), 1.0),
        'ctx': nrm(ks[2], (BATCH, CTX_LEN, D_MODEL), 1.0),
        'c_ctx': nrm(ks[3], (D_MODEL,), 1.0),
        'w_mod': nrm(ks[4], (DEPTH, D_MODEL, 3 * D_MODEL), 0.5 * D_MODEL ** -0.5),
        'b_mod': nrm(ks[5], (DEPTH, 3 * D_MODEL), 0.01),
        'pre_gain': 1.0 + nrm(ks[6], (DEPTH, D_MODEL), 0.05),
        'post_gain': 1.0 + nrm(ks[7], (DEPTH, D_MODEL), 0.05),
        'w_in': nrm(ks[8], (DEPTH, D_MODEL, D_IN), D_MODEL ** -0.5),
        'b_gates': b_gates,
        'conv_qk_w': nrm(ks[10], (DEPTH, SHORT_CONV, 2 * D_MLSTM), SHORT_CONV ** -0.5),
        'conv_qk_b': nrm(ks[11], (DEPTH, 2 * D_MLSTM), 0.01),
        'mh_gain': 1.0 + nrm(ks[12], (DEPTH, D_MLSTM), 0.05),
        'hy_conv_w': nrm(ks[13], (DEPTH, SHORT_CONV, (HYENA_ORDER + 1) * D_HYENA), SHORT_CONV ** -0.5),
        'hy_conv_b': nrm(ks[14], (DEPTH, (HYENA_ORDER + 1) * D_HYENA), 0.01),
        'filt_w1': nrm(ks[15], (DEPTH, FILTER_EMB, FILTER_HIDDEN), FILTER_EMB ** -0.5),
        'filt_b1': nrm(ks[16], (DEPTH, FILTER_HIDDEN), 0.01),
        'filt_freq': 1.0 + nrm(ks[17], (DEPTH, 2, FILTER_HIDDEN), 0.05),
        'filt_w2': nrm(ks[18], (DEPTH, FILTER_HIDDEN, FILTER_HIDDEN), FILTER_HIDDEN ** -0.5),
        'filt_b2': nrm(ks[19], (DEPTH, FILTER_HIDDEN), 0.01),
        'filt_w3': nrm(ks[20], (DEPTH, FILTER_HIDDEN, HYENA_ORDER * D_HYENA), FILTER_HIDDEN ** -0.5),
        'filt_bias': nrm(ks[21], (DEPTH, HYENA_ORDER, D_HYENA), 0.1),
        'w_out': nrm(ks[22], (DEPTH, D_MIX, D_MODEL), D_MIX ** -0.5),
    }


def reference(x, c, ctx, c_ctx, w_mod, b_mod, pre_gain, post_gain, w_in, b_gates,
              conv_qk_w, conv_qk_b, mh_gain, hy_conv_w, hy_conv_b, filt_w1, filt_b1,
              filt_freq, filt_w2, filt_b2, filt_w3, filt_bias, w_out):
    rows = x.shape[1] // GRID_W
    L_lat, L_ctx = x.shape[1], ctx.shape[1]
    xl, xc = x, ctx
    s_lat = jax.nn.silu(c)
    s_ctx = jax.nn.silu(c_ctx)
    for l in range(DEPTH):
        last = l == DEPTH - 1
        shift_l, scale_l, gate_l = jnp.split(s_lat @ w_mod[l] + b_mod[l], 3, axis=-1)
        shift_c, scale_c, gate_c = jnp.split(s_ctx @ w_mod[l] + b_mod[l], 3, axis=-1)
        hl = rms_norm(xl, pre_gain[l]) * (1.0 + scale_l[:, None]) + shift_l[:, None]
        hc = rms_norm(xc, pre_gain[l]) * (1.0 + scale_c) + shift_c
        qk_l, v_l, o_l, zm_l, g_l, hy_l, zh_l = split_proj(hl @ w_in[l])
        qk_c, v_c, o_c, zm_c, g_c, hy_c, zh_c = split_proj(hc @ w_in[l])
        ctx_in = mlstm_prep(qk_c, v_c, g_c, b_gates[l], conv_qk_w[l], conv_qk_b[l], None)
        lat_in = mlstm_prep(qk_l, v_l, g_l, b_gates[l], conv_qk_w[l], conv_qk_b[l], rows)
        hm_c, hm_l = mlstm_bidirectional(ctx_in, lat_in)
        m_l = mlstm_output(hm_l, o_l, zm_l, mh_gain[l])
        filt_l = implicit_filters(L_lat, filt_w1[l], filt_b1[l], filt_freq[l], filt_w2[l], filt_b2[l], filt_w3[l])
        y_hy_l = hyena_mixer(hy_l, zh_l, rows, hy_conv_w[l], hy_conv_b[l], filt_l, filt_bias[l])
        y_l = jnp.concatenate([m_l, y_hy_l], axis=-1).astype(xl.dtype) @ w_out[l]
        new_xl = xl + gate_l[:, None] * rms_norm(y_l, post_gain[l])
        if not last:
            m_c = mlstm_output(hm_c, o_c, zm_c, mh_gain[l])
            filt_c = implicit_filters(L_ctx, filt_w1[l], filt_b1[l], filt_freq[l], filt_w2[l], filt_b2[l], filt_w3[l])
            y_hy_c = hyena_mixer(hy_c, zh_c, None, hy_conv_w[l], hy_conv_b[l], filt_c, filt_bias[l])
            y_c = jnp.concatenate([m_c, y_hy_c], axis=-1).astype(xc.dtype) @ w_out[l]
            xc = xc + gate_c * rms_norm(y_c, post_gain[l])
        xl = new_xl
    return xl
```

```cpp
#include <hip/hip_runtime.h>
#include <hip/hip_cooperative_groups.h>
#include <cstdio>
#include <cstdint>
namespace cg = cooperative_groups;

constexpr int NB = 8, LSEQ = 4096, DM = 1024, LCTX = 256, DEPTH = 2;
constexpr int MLAT = NB * LSEQ, MCTX = NB * LCTX, MT = MLAT + MCTX;
constexpr int DIN = 4624, NU1 = 2560, NU2 = 2048, NPK = NU1 + NU2;
constexpr int QK8_STRIDE = (LCTX + LSEQ) * 256 + 8192;
constexpr int LDV2 = 264;
constexpr int LDU1 = 2048;
constexpr int NH = 4, HD = 128, DML = 512, DHY = 512;
constexpr float RMS_EPS = 1e-6f;
constexpr int NTHR = 512;
constexpr int LDS_BYTES = 147456;
#ifndef PROBE_PHASE
#define PROBE_PHASE -1
#endif
#ifndef PROBE_COUNT
#define PROBE_COUNT 1
#endif
#ifndef REP_PREP
#define REP_PREP 1
#endif
#ifndef REP_NORM
#define REP_NORM 1
#endif
#ifndef REP_GEMM1
#define REP_GEMM1 1
#endif
#ifndef REP_MLSTM
#define REP_MLSTM 1
#endif
#ifndef REP_HYENA
#define REP_HYENA 1
#endif
#ifndef REP_HYCTX
#define REP_HYCTX 1
#endif
#ifndef REP_COMB
#define REP_COMB 1
#endif
#ifndef REP_GEMM2
#define REP_GEMM2 1
#endif
#ifndef NAIVE_MLSTM
#define NAIVE_MLSTM 0
#endif
#ifndef NAIVE_HYENA
#define NAIVE_HYENA 0
#endif
#ifndef NAIVE_GEMM
#define NAIVE_GEMM 0
#endif

constexpr size_t MiB = 1u << 20;
constexpr size_t WS_CTL = 0;
constexpr size_t WS_MOD = 1 * MiB;
constexpr size_t WS_HDN = 2 * MiB;
constexpr size_t WS_HDNC = 4 * MiB;
constexpr size_t WS_GATES = 5 * MiB;
constexpr size_t WS_WGT = 512 * 1024;
constexpr size_t WS_GP = 4 * MiB + 256 * 1024;
constexpr size_t WS_XC1 = 8 * MiB;
constexpr size_t WS_WINT = 16 * MiB;
constexpr size_t WS_WOUTT = 34 * MiB;
constexpr size_t WS_HB = 40 * MiB;
constexpr size_t WS_U1 = 108 * MiB;
constexpr size_t WS_V2 = 244 * MiB;
constexpr size_t WS_UT = 280 * MiB;
constexpr size_t WS_YMIX = 416 * MiB;
constexpr size_t WS_FT = 485 * MiB;
constexpr size_t WS_END = 502 * MiB;

constexpr int CW_QUEUE = 4096;

typedef unsigned short bf16_t;
typedef float f32x4 __attribute__((ext_vector_type(4)));
typedef float f32x2 __attribute__((ext_vector_type(2)));
typedef unsigned u32x4 __attribute__((ext_vector_type(4)));
typedef unsigned u32x2 __attribute__((ext_vector_type(2)));

struct Args {
    const float* in[23];
    float* out;
    unsigned char* ws;
    int ph_lo, ph_hi;
    int rep_phase, rep_count;
};

__device__ __forceinline__ float bf2f(unsigned b) { return __uint_as_float(b << 16); }
__device__ __forceinline__ unsigned f2bf(float f) { unsigned u = __float_as_uint(f); return (u + 0x7fffu + ((u >> 16) & 1u)) >> 16; }
__device__ __forceinline__ unsigned pk2(float lo, float hi) { return f2bf(lo) | (f2bf(hi) << 16); }
__device__ __forceinline__ float silu_f(float x) { return x / (1.f + __expf(-x)); }
__device__ __forceinline__ float sigmoid_f(float x) { return 1.f / (1.f + __expf(-x)); }
typedef const Args __attribute__((address_space(4)))* KArgsP;
__device__ __forceinline__ Args kargs() {
    int z = 0; asm volatile("" : "+s"(z));
    KArgsP p = (KArgsP)((const char __attribute__((address_space(4)))*)__builtin_amdgcn_kernarg_segment_ptr() + z);
    Args a;
#pragma unroll
    for (int i = 0; i < 23; ++i) a.in[i] = p->in[i];
    a.out = p->out; a.ws = p->ws; a.ph_lo = p->ph_lo; a.ph_hi = p->ph_hi; a.rep_phase = p->rep_phase; a.rep_count = p->rep_count;
    return a;
}
__device__ __forceinline__ int opaque_tid() { int t = threadIdx.x; asm volatile("" : "+v"(t)); return t; }
__device__ __forceinline__ float wave_sum(float v) {
#pragma unroll
    for (int o = 1; o < 64; o <<= 1) v += __shfl_xor(v, o);
    return v;
}

__device__ __forceinline__ void phase_prep(const Args& a, unsigned char* lds) {
    const int tid = opaque_tid(), G = gridDim.x;
    float* scr = (float*)lds;
    constexpr int IT_WIN = 2 * 16 * 72, IT_WOUT = 2 * 16 * 16, IT_MOD = 2 * 48, IT_HDN = 132, IT_WG = 2;
    constexpr int NIT = IT_WIN + IT_WOUT + IT_MOD + IT_HDN + IT_WG;
    bool s_loaded = false;
    for (int it = blockIdx.x; it < NIT; it += G) {
        int r = it;
        if (r < IT_WIN + IT_WOUT) {
            const float* W; bf16_t* WT; int N, kb, nb, srccol;
            if (r < IT_WIN) { const int l = r / (16 * 72); r %= 16 * 72; kb = r / 72; nb = r % 72; N = DIN;
                W = a.in[8] + (size_t)l * DM * DIN; WT = (bf16_t*)(a.ws + WS_WINT) + (size_t)l * NPK * DM; srccol = nb * 64 + (nb >= 40 ? 16 : 0); }
            else { r -= IT_WIN; const int l = r / 256; r %= 256; kb = r / 16; nb = r % 16; N = DM;
                W = a.in[22] + (size_t)l * DM * DM; WT = (bf16_t*)(a.ws + WS_WOUTT) + (size_t)l * DM * DM; srccol = nb * 64; }
            __syncthreads();
#pragma unroll
            for (int i = 0; i < 8; ++i) { const int e = tid + i * 512, kk = e >> 6, nn = e & 63; scr[kk * 65 + nn] = W[(size_t)(kb * 64 + kk) * N + srccol + nn]; }
            __syncthreads();
            { const int nn = tid >> 3, k8 = (tid & 7) * 8; u32x4 o;
              o.x = pk2(scr[(k8 + 0) * 65 + nn], scr[(k8 + 1) * 65 + nn]); o.y = pk2(scr[(k8 + 2) * 65 + nn], scr[(k8 + 3) * 65 + nn]);
              o.z = pk2(scr[(k8 + 4) * 65 + nn], scr[(k8 + 5) * 65 + nn]); o.w = pk2(scr[(k8 + 6) * 65 + nn], scr[(k8 + 7) * 65 + nn]);
              *(u32x4*)(WT + (size_t)(nb * 64 + nn) * DM + kb * 64 + k8) = o; }
            continue;
        }
        r -= IT_WIN + IT_WOUT;
        if (r < IT_MOD) {
            const int l = r / 48, cb = r % 48;
            float* S = scr + 8192;
            float* P = scr;
            __syncthreads();
            if (!s_loaded) {
                for (int i = tid; i < 9 * 1024; i += 512) { const int v = i >> 10, k = i & 1023; const float cv = (v < 8) ? a.in[1][v * 1024 + k] : a.in[3][k]; S[i] = silu_f(cv); }
                s_loaded = true;
            }
            __syncthreads();
            const int kg = tid >> 6, col = cb * 64 + (tid & 63);
            const float* W = a.in[4] + (size_t)l * DM * 3072;
            float acc[9];
#pragma unroll
            for (int v = 0; v < 9; ++v) acc[v] = 0.f;
            for (int k = kg * 128; k < kg * 128 + 128; ++k) { const float w = W[(size_t)k * 3072 + col];
#pragma unroll
                for (int v = 0; v < 9; ++v) acc[v] += S[v * 1024 + k] * w; }
#pragma unroll
            for (int v = 0; v < 9; ++v) P[(kg * 9 + v) * 64 + (tid & 63)] = acc[v];
            __syncthreads();
            for (int i = tid; i < 9 * 64; i += 512) { const int v = i >> 6, cc = i & 63; float s = a.in[5][l * 3072 + cb * 64 + cc];
#pragma unroll
                for (int g = 0; g < 8; ++g) s += P[(g * 9 + v) * 64 + cc];
                ((float*)(a.ws + WS_MOD))[(size_t)(l * 9 + v) * 3072 + cb * 64 + cc] = s; }
            continue;
        }
        r -= IT_MOD;
        if (r >= IT_HDN) {
            const int l = r - IT_HDN; const float* w = a.in[8] + (size_t)l * DM * DIN; bf16_t* wg = (bf16_t*)(a.ws + WS_WGT) + (size_t)l * 16 * 1024;
            for (int i = tid; i < 16384; i += 512) wg[(i & 15) * 1024 + (i >> 4)] = (bf16_t)f2bf(w[(size_t)(i >> 4) * DIN + 2560 + (i & 15)]);
            continue;
        }
        {
            __syncthreads();
            float* W1 = scr;
            float* W2 = scr + 17 * 64;
            float* B1 = W2 + 64 * 64; float* B2 = B1 + 64; float* F0 = B2 + 64; float* F1 = F0 + 64;
            float* FT = F1 + 64;
            float* H1 = FT + 8 * 17;
            const int lb = ((r * 64) < 8192) ? ((r * 64) >> 12) : 0;
            for (int i = tid; i < 17 * 64; i += 512) W1[i] = a.in[15][lb * 17 * 64 + i];
            for (int i = tid; i < 64 * 64; i += 512) W2[i] = a.in[18][lb * 64 * 64 + i];
            if (tid < 64) { B1[tid] = a.in[16][lb * 64 + tid]; B2[tid] = a.in[19][lb * 64 + tid]; F0[tid] = a.in[17][lb * 128 + tid]; F1[tid] = a.in[17][lb * 128 + 64 + tid]; }
            const int j = tid & 63, pg = tid >> 6;
            for (int sub = 0; sub < 8; ++sub) {
                const int p = r * 64 + sub * 8 + pg;
                const int L = (p < 8192) ? 4096 : 256; const int pos = (p < 8192) ? (p & 4095) : (p - 8192);
                __syncthreads();
                if (j < 17) { float f;
                    if (j == 0) f = (float)pos / (float)L;
                    else { const int bnd = (j <= 8) ? j : j - 8; const float ang = (6.283185307179586f / (float)L) * (float)pos * (float)bnd; f = (j <= 8) ? sinf(ang) : cosf(ang); }
                    FT[pg * 17 + j] = f; }
                __syncthreads();
                { float s = B1[j];
#pragma unroll
                  for (int f = 0; f < 17; ++f) s += FT[pg * 17 + f] * W1[f * 64 + j];
                  H1[pg * 64 + j] = sinf(F0[j] * s); }
                __syncthreads();
                { float s = B2[j];
#pragma unroll 8
                  for (int i = 0; i < 64; ++i) s += H1[pg * 64 + i] * W2[i * 64 + j];
                  float* dst = (p < 8192) ? (float*)(a.ws + WS_HDN) + (size_t)p * 64 : (float*)(a.ws + WS_HDNC) + (size_t)pos * 64;
                  dst[j] = sinf(F1[j] * s); }
            }
        }
    }
    __syncthreads();
}

__device__ __forceinline__ void phase_norm(const Args& a, int l, bool has_prev, bool do_next, unsigned char* lds) {
    const int tid = opaque_tid(), G = gridDim.x, lane = tid & 63, wave = tid >> 6;
    float* Wg = (float*)lds;
    __syncthreads();
#if NAIVE_MLSTM
    if (do_next) { const float* w = a.in[8] + (size_t)l * DM * DIN; for (int i = tid; i < 16384; i += 512) Wg[(i & 15) * 1024 + (i >> 4)] = w[(size_t)(i >> 4) * DIN + 2560 + (i & 15)]; }
#endif
    __syncthreads();
    const float* MOD = (const float*)(a.ws + WS_MOD);
    const float* Y = (const float*)(a.ws + WS_U1);
    bf16_t* HB = (bf16_t*)(a.ws + WS_HB);
    float* GATES = (float*)(a.ws + WS_GATES);
    float* XC1 = (float*)(a.ws + WS_XC1);
    const int nrows = do_next ? MT : MLAT;
    for (int row = blockIdx.x * 8 + wave; row < nrows; row += G * 8) {
        const bool is_ctx = row >= MLAT; const int mv = is_ctx ? 8 : (row >> 12);
        const float* xin; float* xout;
        if (l == 0 || (has_prev && l == 1)) xin = is_ctx ? a.in[2] + (size_t)(row - MLAT) * DM : a.in[0] + (size_t)row * DM;
        else xin = a.out + (size_t)row * DM;
        xout = is_ctx ? XC1 + (size_t)(row - MLAT) * DM : a.out + (size_t)row * DM;
        f32x4 xv[4];
#pragma unroll
        for (int j = 0; j < 4; ++j) xv[j] = ((const f32x4*)xin)[lane + 64 * j];
        if (has_prev) {
            const int lp = l - 1;
            f32x4 yv[4]; float ss = 0.f;
#pragma unroll
            for (int j = 0; j < 4; ++j) { yv[j] = ((const f32x4*)(Y + (size_t)row * DM))[lane + 64 * j]; ss += yv[j].x * yv[j].x + yv[j].y * yv[j].y + yv[j].z * yv[j].z + yv[j].w * yv[j].w; }
            const float r = rsqrtf(wave_sum(ss) * (1.f / DM) + RMS_EPS);
#pragma unroll
            for (int j = 0; j < 4; ++j) { const f32x4 gt = ((const f32x4*)(MOD + (size_t)(lp * 9 + mv) * 3072 + 2048))[lane + 64 * j]; const f32x4 pg = ((const f32x4*)(a.in[7] + lp * DM))[lane + 64 * j];
                xv[j] = xv[j] + gt * (yv[j] * r * pg); ((f32x4*)xout)[lane + 64 * j] = xv[j]; }
        }
        if (do_next) {
            float ss = 0.f;
#pragma unroll
            for (int j = 0; j < 4; ++j) ss += xv[j].x * xv[j].x + xv[j].y * xv[j].y + xv[j].z * xv[j].z + xv[j].w * xv[j].w;
            const float r = rsqrtf(wave_sum(ss) * (1.f / DM) + RMS_EPS);
#if NAIVE_MLSTM
            float ga[16];
#pragma unroll
            for (int g = 0; g < 16; ++g) ga[g] = 0.f;
#endif
#pragma unroll
            for (int j = 0; j < 4; ++j) {
                const f32x4 pg = ((const f32x4*)(a.in[6] + l * DM))[lane + 64 * j];
                const f32x4 sh = ((const f32x4*)(MOD + (size_t)(l * 9 + mv) * 3072))[lane + 64 * j];
                const f32x4 sc = ((const f32x4*)(MOD + (size_t)(l * 9 + mv) * 3072 + 1024))[lane + 64 * j];
                const f32x4 h = xv[j] * r * pg * (sc + 1.f) + sh;
                u32x2 o; o.x = pk2(h.x, h.y); o.y = pk2(h.z, h.w);
                ((u32x2*)(HB + (size_t)row * DM))[lane + 64 * j] = o;
#if NAIVE_MLSTM
#pragma unroll
                for (int g = 0; g < 16; ++g) { const f32x4 wv = ((const f32x4*)(Wg + g * 1024))[lane + 64 * j]; ga[g] += h.x * wv.x + h.y * wv.y + h.z * wv.z + h.w * wv.w; if ((g & 3) == 3) asm volatile("" ::: "memory"); }
#endif
            }
#if NAIVE_MLSTM
#pragma unroll
            for (int g = 0; g < 16; ++g) ga[g] = wave_sum(ga[g]);
            float mine = 0.f;
#pragma unroll
            for (int g = 0; g < 16; ++g) mine = (lane == g) ? ga[g] : mine;
            if (lane < 16) GATES[(size_t)row * 16 + lane] = mine + a.in[9][l * 16 + lane];
#endif
        }
    }
    __syncthreads();
}

__device__ __forceinline__ void gemm_naive(const bf16_t* A, const bf16_t* Bt, int M, int N, int K, void* out, int ldo, int mode, unsigned char* lds) {
    const int tid = opaque_tid(), G = gridDim.x;
    float* As = (float*)lds;
    float* Bs = As + 64 * 33;
    const int ntm = M / 64, ntn = N / 64;
    const int ty = tid >> 4, tx = tid & 15;
    for (int t = blockIdx.x; t < ntm * ntn; t += G) {
        const int tm = t / ntn, tn = t % ntn;
        float acc[2][4] = {};
        for (int k0 = 0; k0 < K; k0 += 32) {
            __syncthreads();
            { const int r = tid >> 3, c4 = (tid & 7) * 4;
              const u32x2 va = *(const u32x2*)(A + (size_t)(tm * 64 + r) * K + k0 + c4);
              As[r * 33 + c4] = bf2f(va.x & 0xffff); As[r * 33 + c4 + 1] = bf2f(va.x >> 16); As[r * 33 + c4 + 2] = bf2f(va.y & 0xffff); As[r * 33 + c4 + 3] = bf2f(va.y >> 16);
              const u32x2 vb = *(const u32x2*)(Bt + (size_t)(tn * 64 + r) * K + k0 + c4);
              Bs[r * 33 + c4] = bf2f(vb.x & 0xffff); Bs[r * 33 + c4 + 1] = bf2f(vb.x >> 16); Bs[r * 33 + c4 + 2] = bf2f(vb.y & 0xffff); Bs[r * 33 + c4 + 3] = bf2f(vb.y >> 16); }
            __syncthreads();
#pragma unroll 8
            for (int kk = 0; kk < 32; ++kk) {
                const float a0 = As[(ty * 2) * 33 + kk], a1 = As[(ty * 2 + 1) * 33 + kk];
#pragma unroll
                for (int j = 0; j < 4; ++j) { const float b = Bs[(tx * 4 + j) * 33 + kk]; acc[0][j] += a0 * b; acc[1][j] += a1 * b; }
            }
        }
#pragma unroll
        for (int i = 0; i < 2; ++i)
#pragma unroll
            for (int j = 0; j < 4; ++j) { const size_t r = tm * 64 + ty * 2 + i, c = tn * 64 + tx * 4 + j;
                if (mode == 0) ((bf16_t*)out)[r * ldo + c] = (bf16_t)f2bf(acc[i][j]);
                else if (mode == 1) ((bf16_t*)out)[c * ldo + r] = (bf16_t)f2bf(acc[i][j]);
                else ((float*)out)[r * ldo + c] = acc[i][j]; }
    }
    __syncthreads();
}


namespace pg8 {
#define PG8_LAS __attribute__((address_space(3)))
typedef short bf16x8 __attribute__((ext_vector_type(8)));
constexpr int BM = 256, BK = 64, HALF = 128, HTB = HALF * BK * 2, STAGE_BYTES = 8 * HTB, NXCD = 8, WGM = 8;
__device__ __forceinline__ int lds_byte(int r, int c) { const int st = (r >> 4) * 2 + (c >> 5), rr = r & 15, cc = c & 31, ob = rr * 64 + cc * 2; return st * 1024 + (ob ^ (((ob >> 9) & 1) << 5)); }
__device__ __forceinline__ void stage_rc(int b, int& R, int& C) { const int st = b / 1024, sb = b % 1024, swz = sb ^ (((sb >> 9) & 1) << 5); R = (st >> 1) * 16 + swz / 64; C = (st & 1) * 32 + (swz % 64) / 2; }
__device__ __forceinline__ int perm32(int rho) { const int n = rho >> 4, i = rho & 15; return 8 * (i >> 2) + 4 * n + (i & 3); }
__device__ __forceinline__ unsigned cvt_pk_bf16(float lo, float hi) { unsigned r; asm volatile("v_cvt_pk_bf16_f32 %0, %1, %2" : "=v"(r) : "v"(lo), "v"(hi)); return r; }

struct Unit { const char* A; const char* B; char* out; int ldo, r0, c0; };

template <class Dec> struct GridOrder {
    int nM, nN, nwg, G, c; Dec dec;
    __device__ void init(int nM_, int nN_, int G_, int c_, const Dec& d) { nM = nM_; nN = nN_; nwg = nM * nN; G = G_; c = c_; dec = d; }
    __device__ bool next(int i, Unit& u) const {
        const long L = (long)i * G + c; if (L >= nwg) return false;
        int wgid = (int)L; { const int q = nwg / NXCD, r = nwg % NXCD, xcd = wgid % NXCD, off = wgid / NXCD; wgid = (xcd < r ? xcd * (q + 1) : r * (q + 1) + (xcd - r) * q) + off; }
        const int nig = WGM * nN, gid = wgid / nig, fm = gid * WGM, gsz = (nM - fm) < WGM ? (nM - fm) : WGM;
        const int pm = fm + ((wgid % nig) % gsz), pn = (wgid % nig) / gsz; dec(pm, pn, u); return true;
    }
};

template <bool PERM, class Sched>
__device__ __forceinline__ void gemm_phase(PG8_LAS unsigned char* lds, const int K, const Sched& S) {
    const int tid = opaque_tid(), wid = __builtin_amdgcn_readfirstlane(tid >> 6), lane = tid & 63, wr = wid >> 2, wc = wid & 3, fr = lane & 15, fq = lane >> 4;
    const int nt = K / BK;
    unsigned voffA[2], voffB[2];
#pragma unroll
    for (int i = 0; i < 2; ++i) { int R, C; stage_rc(tid * 16 + i * 8192, R, C); const int Rb = PERM ? ((R & ~31) + perm32(R & 31)) : R;
        voffA[i] = (unsigned)(R * K + C) * 2u; voffB[i] = (unsigned)(Rb * K + C) * 2u; }
    const size_t kstep = (size_t)(BK * 2);
    const size_t hstep = (size_t)HALF * K * 2;
    const unsigned ldsw = (unsigned)wid * 1024u;
    const int aoff = lds_byte(wr * 64 + fr, fq * 8), boff = lds_byte(wc * 32 + fr, fq * 8);
#define PG8_SA(b, h) (((b) * 2 + (h)) * HTB)
#define PG8_SB(b, h) ((4 + (b) * 2 + (h)) * HTB)
#define PG8_STAGE(bufoff, gbase, voff) do { _Pragma("unroll") for (int _i = 0; _i < 2; ++_i) \
        __builtin_amdgcn_global_load_lds((const unsigned*)((const char*)(gbase) + (voff)[_i]), (PG8_LAS unsigned*)(lds + (bufoff) + ldsw + _i * 8192), 16, 0, 0); } while (0)
#define PG8_LDA(dst, b, h) do { _Pragma("unroll") for (int m = 0; m < 4; ++m) _Pragma("unroll") for (int k = 0; k < 2; ++k) dst[m][k] = *(const PG8_LAS bf16x8*)(lds + PG8_SA(b, h) + aoff + m * 2048 + k * 1024); } while (0)
#define PG8_LDB(dst, b, h) do { _Pragma("unroll") for (int n = 0; n < 2; ++n) _Pragma("unroll") for (int k = 0; k < 2; ++k) dst[n][k] = *(const PG8_LAS bf16x8*)(lds + PG8_SB(b, h) + boff + n * 2048 + k * 1024); } while (0)
#define PG8_MMA(ai, bj, At, Bt) do { __builtin_amdgcn_s_setprio(1); _Pragma("unroll") for (int m = 0; m < 4; ++m) _Pragma("unroll") for (int n = 0; n < 2; ++n) _Pragma("unroll") for (int k = 0; k < 2; ++k) \
        acc[ai][bj][m][n] = __builtin_amdgcn_mfma_f32_16x16x32_bf16(Bt[n][k], At[m][k], acc[ai][bj][m][n], 0, 0, 0); __builtin_amdgcn_s_setprio(0); } while (0)
#define PG8_WAIT_V(n) asm volatile("s_waitcnt vmcnt(" #n ")" ::: "memory")
#define PG8_WAIT_L(n) asm volatile("s_waitcnt lgkmcnt(" #n ")" ::: "memory")
#define PG8_BAR __builtin_amdgcn_s_barrier()
#define PG8_SCHED __builtin_amdgcn_sched_barrier(0)
    Unit cur, nxt; int ui = 0;
    if (!S.next(0, cur)) return;
    f32x4 acc[2][2][4][2];
#pragma unroll
    for (int a = 0; a < 2; ++a)
#pragma unroll
        for (int b = 0; b < 2; ++b)
#pragma unroll
            for (int m = 0; m < 4; ++m)
#pragma unroll
                for (int n = 0; n < 2; ++n) acc[a][b][m][n] = (f32x4){0.f, 0.f, 0.f, 0.f};
    bf16x8 At[4][2], B0[2][2], B1[2][2];
    const char* cA = cur.A; const char* cB = cur.B;
    PG8_STAGE(PG8_SB(0, 0), cB, voffB); PG8_STAGE(PG8_SA(0, 0), cA, voffA); PG8_STAGE(PG8_SB(0, 1), cB + hstep, voffB); PG8_STAGE(PG8_SA(0, 1), cA + hstep, voffA);
    if (wr == 1) PG8_BAR;
    PG8_WAIT_V(4); PG8_BAR;
    PG8_STAGE(PG8_SB(1, 0), cB + kstep, voffB); PG8_STAGE(PG8_SA(1, 0), cA + kstep, voffA); PG8_STAGE(PG8_SB(1, 1), cB + hstep + kstep, voffB);
    PG8_WAIT_V(6); PG8_BAR;
    for (;;) {
        const bool has_next = S.next(ui + 1, nxt);
        const char* nA = has_next ? nxt.A : cA; const char* nB = has_next ? nxt.B : cB;
        for (int t = 0; t < nt; t += 2) {
            const bool last = (t == nt - 2);
            const char* a1 = cA + (size_t)(t + 1) * kstep;
            const char* a2 = last ? nA : cA + (size_t)(t + 2) * kstep; const char* b2 = last ? nB : cB + (size_t)(t + 2) * kstep;
            const char* a3 = a2 + kstep; const char* b3 = b2 + kstep;
            PG8_LDB(B0, 0, 0); PG8_SCHED; PG8_LDA(At, 0, 0); PG8_STAGE(PG8_SA(1, 1), a1 + hstep, voffA);
            PG8_WAIT_L(8); PG8_BAR; PG8_WAIT_L(0); PG8_MMA(0, 0, At, B0); PG8_BAR; PG8_SCHED;
            PG8_LDB(B1, 0, 1); PG8_STAGE(PG8_SB(0, 0), b2, voffB);
            PG8_BAR; PG8_WAIT_L(0); PG8_MMA(0, 1, At, B1); PG8_BAR;
            PG8_LDA(At, 0, 1); PG8_STAGE(PG8_SA(0, 0), a2, voffA);
            PG8_BAR; PG8_WAIT_L(0); PG8_MMA(1, 0, At, B0); PG8_BAR; PG8_SCHED;
            PG8_STAGE(PG8_SB(0, 1), b2 + hstep, voffB);
            PG8_WAIT_V(6); PG8_BAR; PG8_MMA(1, 1, At, B1); PG8_BAR;
            PG8_LDB(B0, 1, 0); PG8_SCHED; PG8_LDA(At, 1, 0); PG8_STAGE(PG8_SA(0, 1), a2 + hstep, voffA);
            PG8_WAIT_L(8); PG8_BAR; PG8_WAIT_L(0); PG8_MMA(0, 0, At, B0); PG8_BAR; PG8_SCHED;
            PG8_LDB(B1, 1, 1); PG8_STAGE(PG8_SB(1, 0), b3, voffB);
            PG8_BAR; PG8_WAIT_L(0); PG8_MMA(0, 1, At, B1); PG8_BAR;
            PG8_LDA(At, 1, 1); PG8_STAGE(PG8_SA(1, 0), a3, voffA);
            PG8_BAR; PG8_WAIT_L(0); PG8_MMA(1, 0, At, B0); PG8_BAR; PG8_SCHED;
            PG8_STAGE(PG8_SB(1, 1), b3 + hstep, voffB);
            PG8_WAIT_V(6); PG8_BAR; PG8_MMA(1, 1, At, B1); PG8_BAR;
        }
        {
            const int row0 = cur.r0 + wr * 64 + fr;
            if (PERM) {
                bf16_t* base = (bf16_t*)cur.out; const int col0 = cur.c0 + wc * 32 + 8 * fq;
#pragma unroll
                for (int ai = 0; ai < 2; ++ai)
#pragma unroll
                    for (int m = 0; m < 4; ++m) { bf16_t* rowp = base + (size_t)(row0 + ai * HALF + m * 16) * cur.ldo + col0;
#pragma unroll
                        for (int bj = 0; bj < 2; ++bj) { const f32x4 v0 = acc[ai][bj][m][0], v1 = acc[ai][bj][m][1];
                            u32x4 w; w.x = cvt_pk_bf16(v0[0], v0[1]); w.y = cvt_pk_bf16(v0[2], v0[3]); w.z = cvt_pk_bf16(v1[0], v1[1]); w.w = cvt_pk_bf16(v1[2], v1[3]);
                            *(u32x4*)(rowp + bj * HALF) = w; } }
            } else {
                float* base = (float*)cur.out; const int col0 = cur.c0 + wc * 32 + 4 * fq;
#pragma unroll
                for (int ai = 0; ai < 2; ++ai)
#pragma unroll
                    for (int m = 0; m < 4; ++m) { float* rowp = base + (size_t)(row0 + ai * HALF + m * 16) * cur.ldo + col0;
#pragma unroll
                        for (int bj = 0; bj < 2; ++bj)
#pragma unroll
                            for (int n = 0; n < 2; ++n) *(f32x4*)(rowp + bj * HALF + n * 16) = acc[ai][bj][m][n]; }
            }
        }
        if (!has_next) break;
#pragma unroll
        for (int a = 0; a < 2; ++a)
#pragma unroll
            for (int b = 0; b < 2; ++b)
#pragma unroll
                for (int m = 0; m < 4; ++m)
#pragma unroll
                    for (int n = 0; n < 2; ++n) acc[a][b][m][n] = (f32x4){0.f, 0.f, 0.f, 0.f};
        cur = nxt; cA = nA; cB = nB; ++ui;
    }
    PG8_WAIT_V(0);
    if (wr == 0) PG8_BAR;
    PG8_BAR;
#undef PG8_SA
#undef PG8_SB
#undef PG8_STAGE
#undef PG8_LDA
#undef PG8_LDB
#undef PG8_MMA
#undef PG8_WAIT_V
#undef PG8_WAIT_L
#undef PG8_BAR
#undef PG8_SCHED
}
}

struct DecIn {
    const char* HB; const char* W; char* U1; char* UT;
    __device__ void operator()(int pm, int pn, pg8::Unit& u) const {
        const char* tp = HB + (size_t)pm * 256 * DM * 2; const char* wp = W + (size_t)pn * 256 * DM * 2;
        if (pn < 4) { u.A = tp; u.B = wp; u.out = U1; u.ldo = LDU1; u.r0 = pm * 256; u.c0 = pn * 256; }
        else if (pn < 6) { u.A = tp; u.B = wp; u.out = U1 + (WS_V2 - WS_U1) + (size_t)(pn - 4) * MT * LDV2 * 2; u.ldo = LDV2; u.r0 = pm * 256; u.c0 = 0; }
        else if (pn < 10) { u.A = tp; u.B = wp; u.out = U1; u.ldo = LDU1; u.r0 = pm * 256; u.c0 = (pn - 2) * 256; }
        else { u.A = wp; u.B = tp; u.out = UT; u.ldo = MT; u.r0 = (pn - 10) * 256; u.c0 = pm * 256; }
    }
};
struct DecOut {
    const char* YM; const char* W; char* Y;
    __device__ void operator()(int pm, int pn, pg8::Unit& u) const {
        u.A = YM + (size_t)pm * 256 * DM * 2; u.B = W + (size_t)pn * 256 * DM * 2; u.out = Y; u.ldo = DM; u.r0 = pm * 256; u.c0 = pn * 256;
    }
};

__device__ __forceinline__ void mlstm_naive(const Args& a, int l, unsigned char* lds) {
    const int tid = opaque_tid(), G = gridDim.x;
    const bf16_t* U1 = (const bf16_t*)(a.ws + WS_U1);
    const float* GATES = (const float*)(a.ws + WS_GATES);
    bf16_t* HDo = (bf16_t*)(a.ws + WS_HB);
    float* qs = (float*)lds; float* ks = qs + 128; float* vs = ks + 128; float* sc = vs + 32;
    float* pnum = sc + 8;
    float* pden = pnum + 512;
    const float* cw = a.in[10] + (size_t)l * 3 * 1024; const float* cb = a.in[11] + (size_t)l * 1024;
    for (int it = blockIdx.x; it < 256; it += G) {
        const int dvs = it & 3, dir = (it >> 2) & 1, hh = (it >> 3) & 3, b = it >> 5;
        float C[8], nn[8];
#pragma unroll
        for (int i = 0; i < 8; ++i) { C[i] = 0.f; nn[i] = 0.f; }
        float m = 0.f;
        const int j = tid & 31, dg = tid >> 5;
        for (int step = 0; step < LCTX + LSEQ; ++step) {
            int seqlen, tt, rowbase; bool is_ctx = step < LCTX;
            if (is_ctx) { seqlen = LCTX; tt = dir ? (LCTX - 1 - step) : step; rowbase = MLAT + b * LCTX; }
            else { seqlen = LSEQ; const int s2 = step - LCTX; tt = dir ? (LSEQ - 1 - s2) : s2; rowbase = b * LSEQ; }
            const int row = rowbase + tt;
            if (tid < 256) {
                const int ch = (tid < 128) ? (hh * 128 + tid) : (512 + hh * 128 + (tid - 128));
                bool has_l, has_r;
                if (is_ctx) { has_l = tt > 0; has_r = tt < seqlen - 1; } else { has_l = (tt & 63) != 0; has_r = (tt & 63) != 63; }
                float v = bf2f(U1[(size_t)row * NU1 + ch]) * cw[1024 + ch] + cb[ch];
                if (has_l) v += bf2f(U1[(size_t)(row - 1) * NU1 + ch]) * cw[ch];
                if (has_r) v += bf2f(U1[(size_t)(row + 1) * NU1 + ch]) * cw[2048 + ch];
                v = silu_f(v);
                if (tid < 128) qs[tid] = v; else ks[tid - 128] = v * 0.08838834764831845f;
            } else if (tid < 288) {
                vs[tid - 256] = bf2f(U1[(size_t)row * NU1 + 1024 + hh * 128 + dvs * 32 + (tid - 256)]);
            } else if (tid == 288) {
                const float ip = GATES[(size_t)row * 16 + (2 * dir) * 4 + hh], fp = GATES[(size_t)row * 16 + (2 * dir + 1) * 4 + hh];
                const float logf = fminf(fp, 0.f) - log1pf(__expf(-fabsf(fp)));
                const float mn = fmaxf(logf + m, ip);
                sc[0] = __expf(logf + m - mn); sc[1] = __expf(ip - mn); sc[2] = __expf(-mn);
                m = mn;
            }
            __syncthreads();
            const float fw = sc[0], iw = sc[1];
            float pn = 0.f, pd = 0.f;
#pragma unroll
            for (int dd = 0; dd < 8; ++dd) { const int d = dg * 8 + dd; const float kk = ks[d], qq = qs[d];
                C[dd] = fw * C[dd] + iw * kk * vs[j]; nn[dd] = fw * nn[dd] + iw * kk; pn += qq * C[dd]; pd += qq * nn[dd]; }
            pnum[dg * 32 + j] = pn; if (j == 0) pden[dg] = pd;
            __syncthreads();
            if (tid < 32) { float num = 0.f, den = 0.f;
#pragma unroll
                for (int g = 0; g < 16; ++g) { num += pnum[g * 32 + tid]; den += pden[g]; }
                const float h = num / fmaxf(fabsf(den), sc[2]);
                HDo[((size_t)dir * MT + row) * DML + hh * 128 + dvs * 32 + tid] = (bf16_t)f2bf(h); }
        }
        __syncthreads();
    }
}


#define LAS __attribute__((address_space(3)))
typedef short bf16x8 __attribute__((ext_vector_type(8)));
__device__ __forceinline__ float bflo(unsigned x) { return __uint_as_float(x << 16); }
__device__ __forceinline__ float bfhi(unsigned x) { return __uint_as_float(x & 0xffff0000u); }
__device__ __forceinline__ u32x4 ldg16_or_zero(const bf16_t* p, bool ok) { u32x4 z = {0u, 0u, 0u, 0u}; return ok ? *(const u32x4*)p : z; }


__device__ __forceinline__ void filt_item(const Args& a, int l, unsigned char* lds_, int fi);
__device__ __forceinline__ void phase_mprep(const Args& a, int l, unsigned char* lds_, int rep) {
    const int tid = opaque_tid(), lane = tid & 63, wave = __builtin_amdgcn_readfirstlane(tid >> 6), fr = lane & 15, fq = lane >> 4;
    LAS float* P = (LAS float*)lds_;
    LAS float* Gs = P + 2048;
    LAS bf16_t* WgS = (LAS bf16_t*)((LAS unsigned char*)lds_ + 32768);
    LAS unsigned* qslot = (LAS unsigned*)((LAS unsigned char*)lds_ + (LDS_BYTES - 32));
    const bf16_t* U1 = (const bf16_t*)(a.ws + WS_U1);
    const bf16_t* HB = (const bf16_t*)(a.ws + WS_HB);
    const bf16_t* WgT = (const bf16_t*)(a.ws + WS_WGT) + (size_t)l * 16 * 1024;
    bf16_t* QK = (bf16_t*)(a.ws + WS_YMIX);
    float* GP = (float*)(a.ws + WS_GP);
    const float* cw = a.in[10] + (size_t)l * 3072; const float* cb = a.in[11] + (size_t)l * 1024;
    unsigned* ctr = (unsigned*)(a.ws + WS_CTL) + CW_QUEUE + 64 * (16 + l * 8 + rep);
    const int co = tid & 127, rg4 = tid >> 7;
    __syncthreads();
    for (int i = tid; i < 16 * 128; i += NTHR) { const int g = i >> 7, c8 = (i & 127) * 8; *(LAS u32x4*)(WgS + g * 1032 + c8) = *(const u32x4*)(WgT + g * 1024 + c8); }
    for (;;) {
        __syncthreads();
        if (tid == 0) *qslot = __hip_atomic_fetch_add(ctr, 1u, __ATOMIC_RELAXED, __HIP_MEMORY_SCOPE_AGENT);
        __syncthreads();
        const int item = (int)*qslot;
        if (item >= 128 + MT / 64) break;
        if (item < 128) { filt_item(a, l, lds_, item); continue; }
        const int ch = item - 128;
        const int rowbase = ch * 64;
        const bool is_ctx = rowbase >= MLAT; const int cc = is_ctx ? ((rowbase - MLAT) >> 6) & 3 : 0;
        const bool has_lo = is_ctx && cc > 0, has_hi = is_ctx && cc < 3;
        {
            const int rt = wave & 3, kh = wave >> 2;
            f32x4 acc = {0.f, 0.f, 0.f, 0.f};
            const bf16_t* ap = HB + (size_t)(rowbase + rt * 16 + fr) * DM + kh * 512 + fq * 8;
            LAS const bf16_t* bp = WgS + fr * 1032 + kh * 512 + fq * 8;
            bf16x8 af[16];
#pragma unroll
            for (int ks = 0; ks < 16; ++ks) af[ks] = *(const bf16x8*)(ap + ks * 32);
#pragma unroll
            for (int ks = 0; ks < 16; ++ks) { const bf16x8 bf = *(const LAS bf16x8*)(bp + ks * 32); acc = __builtin_amdgcn_mfma_f32_16x16x32_bf16(af[ks], bf, acc, 0, 0, 0); }
#pragma unroll
            for (int jj = 0; jj < 4; ++jj) P[(kh * 64 + rt * 16 + 4 * fq + jj) * 16 + fr] = acc[jj];
        }
        {
            float w0[8], w1[8], w2[8], bb[8];
#pragma unroll
            for (int e = 0; e < 8; ++e) { w0[e] = cw[co * 8 + e]; w1[e] = cw[1024 + co * 8 + e]; w2[e] = cw[2048 + co * 8 + e]; bb[e] = cb[co * 8 + e]; }
            u32x4 r0, r1, r2;
            { const int tt = rg4 * 16 - 1; r0 = ldg16_or_zero(U1 + (size_t)(rowbase + tt) * LDU1 + co * 8, tt >= 0 || has_lo); }
            r1 = *(const u32x4*)(U1 + (size_t)(rowbase + rg4 * 16) * LDU1 + co * 8);
            const int qb = is_ctx ? (rowbase - MLAT) >> 8 : rowbase >> 12, srow0 = is_ctx ? (rowbase - MLAT) & 255 : LCTX + (rowbase & 4095);
            unsigned char* qdst = (unsigned char*)QK + (size_t)(qb * 4 + ((co & 63) >> 4)) * QK8_STRIDE + (size_t)srow0 * 256 + (co >> 6) * 128 + (co & 15) * 8;
#pragma unroll 4
            for (int i = 0; i < 16; ++i) { const int tt = rg4 * 16 + i;
                r2 = ldg16_or_zero(U1 + (size_t)(rowbase + tt + 1) * LDU1 + co * 8, tt + 1 <= 63 || has_hi);
                float fv[8];
#pragma unroll
                for (int e2 = 0; e2 < 4; ++e2) {
                    fv[2 * e2] = silu_f(bflo(r0[e2]) * w0[2 * e2] + bflo(r1[e2]) * w1[2 * e2] + bflo(r2[e2]) * w2[2 * e2] + bb[2 * e2]);
                    fv[2 * e2 + 1] = silu_f(bfhi(r0[e2]) * w0[2 * e2 + 1] + bfhi(r1[e2]) * w1[2 * e2 + 1] + bfhi(r2[e2]) * w2[2 * e2 + 1] + bb[2 * e2 + 1]); }
                int p0 = 0, p1 = 0;
                p0 = __builtin_amdgcn_cvt_pk_fp8_f32(fv[0], fv[1], p0, false); p0 = __builtin_amdgcn_cvt_pk_fp8_f32(fv[2], fv[3], p0, true);
                p1 = __builtin_amdgcn_cvt_pk_fp8_f32(fv[4], fv[5], p1, false); p1 = __builtin_amdgcn_cvt_pk_fp8_f32(fv[6], fv[7], p1, true);
                *(u32x2*)(qdst + (size_t)tt * 256) = (u32x2){(unsigned)p0, (unsigned)p1};
                r0 = r1; r1 = r2; }
        }
        __syncthreads();
        for (int i = tid; i < 1024; i += NTHR) Gs[i] = P[i] + P[1024 + i] + a.in[9][l * 16 + (i & 15)];
        __syncthreads();
        {
            const int dir = wave >> 2, hh = wave & 3, tt = dir ? 63 - lane : lane;
            const float gi = Gs[tt * 16 + (2 * dir) * 4 + hh], gf = Gs[tt * 16 + (2 * dir + 1) * 4 + hh];
            const float logf = fminf(gf, 0.f) - log1pf(__expf(-fabsf(gf)));
            float bc = logf;
#pragma unroll
            for (int ofs = 1; ofs < 64; ofs <<= 1) { const float t = __shfl_up(bc, ofs); if (lane >= ofs) bc += t; }
            const float av = gi - bc;
            float cm = av;
#pragma unroll
            for (int ofs = 1; ofs < 64; ofs <<= 1) { const float t = __shfl_up(cm, ofs); if (lane >= ofs) cm = fmaxf(cm, t); }
            float* gp = GP + ((size_t)ch * 8 + wave) * 192;
            gp[lane] = bc; gp[64 + lane] = av; gp[128 + lane] = cm;
        }
    }
    __syncthreads();
}

__device__ __forceinline__ void dec16_fp8(const u32x4 raw, float (&f)[16]) {
#pragma unroll
    for (int e = 0; e < 4; ++e) { const f32x2 lo = __builtin_amdgcn_cvt_pk_f32_fp8((int)raw[e], false), hi = __builtin_amdgcn_cvt_pk_f32_fp8((int)raw[e], true);
        f[4 * e] = lo.x; f[4 * e + 1] = lo.y; f[4 * e + 2] = hi.x; f[4 * e + 3] = hi.y; }
}
__device__ __forceinline__ void mlstm_item(const Args& a, int l, unsigned char* lds_, int it, bool do_store) {
    const int tid = opaque_tid(), lane = tid & 63, wave = __builtin_amdgcn_readfirstlane(tid >> 6), fr = lane & 15, fq = lane >> 4;
    LAS unsigned char* lds = (LAS unsigned char*)lds_;
    LAS bf16_t* Qs = (LAS bf16_t*)(lds);
    LAS bf16_t* Ks = (LAS bf16_t*)(lds + 17408);
    LAS bf16_t* KTs = (LAS bf16_t*)(lds + 34816);
    LAS bf16_t* VTs = (LAS bf16_t*)(lds + 53248);
    LAS bf16_t* Ss = (LAS bf16_t*)(lds + 73984);
    LAS bf16_t* CTs = (LAS bf16_t*)(lds + 83200);
    LAS float* F = (LAS float*)(lds + 122368);
    LAS float* Aa = F; LAS float* Gg = F + 64; LAS float* WI = F + 128; LAS float* EM = F + 192;
    const unsigned char* QK8 = (const unsigned char*)(a.ws + WS_YMIX);
    const bf16_t* V2 = (const bf16_t*)(a.ws + WS_V2);
    const float* GP = (const float*)(a.ws + WS_GP);
    bf16_t* HDo = (bf16_t*)(a.ws + WS_HB);
    const int dir = it & 1, hh = (it >> 1) & 3, b = it >> 3;
    const int c16 = wave * 16;
    const int rpos = dir ? 63 - lane : lane;
    __syncthreads();
    for (int i = tid; i < 144 * 136 / 2; i += NTHR) ((LAS unsigned*)CTs)[i] = 0u;
    for (int i = tid; i < 16 * 72 / 2; i += NTHR) ((LAS unsigned*)(VTs + 128 * 72))[i] = (i < 36) ? 0x3f803f80u : 0u;
    f32x4 accC[9];
#pragma unroll
    for (int j = 0; j < 9; ++j) accC[j] = (f32x4){0.f, 0.f, 0.f, 0.f};
    float m_prev = 0.f;
    struct OpSet { u32x4 rq8, rk8, v0, v1; float ga, gbc, gav, gcm, g_bl, g_cm63; };
    auto chunk_rowbase = [&](int cs) -> int {
        const bool is_ctx = cs < 4; const int cc = is_ctx ? (dir ? 3 - cs : cs) : (dir ? 63 - (cs - 4) : cs - 4);
        return is_ctx ? MLAT + b * LCTX + cc * 64 : b * LSEQ + cc * 64; };
    auto prefetch = [&](int cs_, OpSet& o) {
        const int cs = cs_ < 68 ? cs_ : 67;
        const int rowbase = chunk_rowbase(cs);
        const int srow0 = (rowbase >= MLAT) ? (rowbase - MLAT) & 255 : LCTX + (rowbase & 4095);
        const unsigned char* qp = QK8 + (size_t)(b * 4 + hh) * QK8_STRIDE + (size_t)(srow0 + lane) * 256 + c16;
        o.rq8 = *(const u32x4*)qp; o.rk8 = *(const u32x4*)(qp + 128);
        const bf16_t* vp = V2 + ((size_t)(hh >> 1) * MT + rowbase + lane) * LDV2 + (hh & 1) * 128 + c16;
        o.v0 = *(const u32x4*)vp; o.v1 = *(const u32x4*)(vp + 8);
        const float* gp = GP + ((size_t)(rowbase >> 6) * 8 + dir * 4 + hh) * 192;
        o.g_bl = gp[63]; o.g_cm63 = gp[128 + 63]; o.ga = gp[64 + rpos];
        o.gbc = gp[lane]; o.gav = gp[64 + lane]; o.gcm = gp[128 + lane];
    };
    OpSet os0, os1, os2;
    prefetch(0, os0); prefetch(1, os1); prefetch(2, os2);
    __syncthreads();
    u32x2 hold[4]; int hold_row = -1;
#pragma unroll
    for (int j = 0; j < 4; ++j) hold[j] = (u32x2){0u, 0u};
    auto flush = [&]() {
        if (hold_row >= 0 && do_store) { bf16_t* op = HDo + ((size_t)dir * MT + hold_row) * DML + hh * 128 + (wave >> 2) * 64 + 4 * fq;
#pragma unroll
            for (int j = 0; j < 4; ++j) *(u32x2*)(op + j * 16) = hold[j]; } };
    auto step = [&](const int cs, OpSet& o) {
        const int rowbase = chunk_rowbase(cs);
        const u32x4 rq8 = o.rq8, rk8 = o.rk8; u32x4 vraw[2]; vraw[0] = o.v0; vraw[1] = o.v1;
        const float ga = o.ga, gbc = o.gbc, gav = o.gav, gcm = o.gcm, g_bl = o.g_bl, g_cm63 = o.g_cm63;
        const float g63 = fmaxf(m_prev, g_cm63), wc = __expf(m_prev - g63);
        {
            float f[16];
            dec16_fp8(rq8, f);
            { u32x4 w0, w1;
#pragma unroll
              for (int e = 0; e < 4; ++e) { w0[e] = pg8::cvt_pk_bf16(f[2 * e], f[2 * e + 1]); w1[e] = pg8::cvt_pk_bf16(f[8 + 2 * e], f[8 + 2 * e + 1]); }
              *(LAS u32x4*)(Qs + rpos * 136 + c16) = w0; *(LAS u32x4*)(Qs + rpos * 136 + c16 + 8) = w1; }
            dec16_fp8(rk8, f);
            { u32x4 w0, w1;
#pragma unroll
              for (int e = 0; e < 16; ++e) f[e] *= 0.08838834764831845f;
#pragma unroll
              for (int e = 0; e < 4; ++e) { w0[e] = pg8::cvt_pk_bf16(f[2 * e], f[2 * e + 1]); w1[e] = pg8::cvt_pk_bf16(f[8 + 2 * e], f[8 + 2 * e + 1]); }
              *(LAS u32x4*)(Ks + rpos * 136 + c16) = w0; *(LAS u32x4*)(Ks + rpos * 136 + c16 + 8) = w1;
              const float ws = __expf(ga - g63);
#pragma unroll
              for (int e = 0; e < 8; ++e) { const unsigned pw = pg8::cvt_pk_bf16(f[2 * e] * ws, f[2 * e + 1] * ws);
                  KTs[(c16 + 2 * e) * 72 + rpos] = (bf16_t)(pw & 0xffffu); KTs[(c16 + 2 * e + 1) * 72 + rpos] = (bf16_t)(pw >> 16); } }
#pragma unroll
            for (int h2 = 0; h2 < 2; ++h2)
#pragma unroll
                for (int e2 = 0; e2 < 4; ++e2) { VTs[(c16 + h2 * 8 + 2 * e2) * 72 + rpos] = (bf16_t)(vraw[h2][e2] & 0xffffu); VTs[(c16 + h2 * 8 + 2 * e2 + 1) * 72 + rpos] = (bf16_t)(vraw[h2][e2] >> 16); }
            if (wave == 7) { const float g = fmaxf(m_prev, gcm); Aa[lane] = gav; Gg[lane] = g; WI[lane] = __expf(m_prev - g); EM[lane] = __expf(-(gbc + g)); }
        }
        m_prev = g_bl + g63;
        flush();
        prefetch(cs + 3, o);
        __syncthreads();
        {
            const int tb = wave >> 1;
#pragma unroll
            for (int q2 = 0; q2 < 2; ++q2) {
                const int sb = (wave & 1) * 2 + q2;
                f32x4 acc = {0.f, 0.f, 0.f, 0.f};
                if (sb <= tb) {
                    bf16x8 kf[4], qf[4];
#pragma unroll
                    for (int ks = 0; ks < 4; ++ks) { kf[ks] = *(const LAS bf16x8*)(Ks + (sb * 16 + fr) * 136 + ks * 32 + fq * 8); qf[ks] = *(const LAS bf16x8*)(Qs + (tb * 16 + fr) * 136 + ks * 32 + fq * 8); }
#pragma unroll
                    for (int ks = 0; ks < 4; ++ks) acc = __builtin_amdgcn_mfma_f32_16x16x32_bf16(kf[ks], qf[ks], acc, 0, 0, 0);
                    const int t = tb * 16 + fr, s0 = sb * 16 + 4 * fq; const float g = Gg[t];
                    const f32x4 av = *(const LAS f32x4*)(Aa + s0);
#pragma unroll
                    for (int jj = 0; jj < 4; ++jj) acc[jj] = (s0 + jj <= t) ? acc[jj] * __expf(av[jj] - g) : 0.f;
                }
                u32x2 w; w.x = pg8::cvt_pk_bf16(acc[0], acc[1]); w.y = pg8::cvt_pk_bf16(acc[2], acc[3]);
                *(LAS u32x2*)(Ss + (tb * 16 + fr) * 72 + sb * 16 + 4 * fq) = w;
            }
        }
        __syncthreads();
        {
            const int tb = wave & 3, half = wave >> 2, t = tb * 16 + fr;
            f32x4 acc[5];
#pragma unroll
            for (int j = 0; j < 5; ++j) acc[j] = (f32x4){0.f, 0.f, 0.f, 0.f};
#pragma unroll
            for (int ks = 0; ks < 4; ++ks) {
                const bf16x8 qf = *(const LAS bf16x8*)(Qs + t * 136 + ks * 32 + fq * 8);
#pragma unroll
                for (int j = 0; j < 5; ++j) { const int jrow = (j < 4) ? (half * 4 + j) * 16 : 128;
                    const bf16x8 cf = *(const LAS bf16x8*)(CTs + (jrow + fr) * 136 + ks * 32 + fq * 8);
                    acc[j] = __builtin_amdgcn_mfma_f32_16x16x32_bf16(cf, qf, acc[j], 0, 0, 0); }
            }
            const float wi = WI[t];
#pragma unroll
            for (int j = 0; j < 5; ++j) acc[j] = acc[j] * wi;
#pragma unroll
            for (int ks = 0; ks < 2; ++ks) {
                const bf16x8 sf = *(const LAS bf16x8*)(Ss + t * 72 + ks * 32 + fq * 8);
#pragma unroll
                for (int j = 0; j < 5; ++j) { const int jrow = (j < 4) ? (half * 4 + j) * 16 : 128;
                    const bf16x8 vf = *(const LAS bf16x8*)(VTs + (jrow + fr) * 72 + ks * 32 + fq * 8);
                    acc[j] = __builtin_amdgcn_mfma_f32_16x16x32_bf16(vf, sf, acc[j], 0, 0, 0); }
            }
            const float den = __shfl(acc[4][0], fr);
            const float inv = 1.f / fmaxf(fabsf(den), EM[t]);
#pragma unroll
            for (int j = 0; j < 4; ++j) { hold[j].x = pg8::cvt_pk_bf16(acc[j][0] * inv, acc[j][1] * inv); hold[j].y = pg8::cvt_pk_bf16(acc[j][2] * inv, acc[j][3] * inv); }
            hold_row = rowbase + (dir ? 63 - t : t);
            const int d0 = wave * 16;
#pragma unroll
            for (int j = 0; j < 9; ++j) accC[j] = accC[j] * wc;
#pragma unroll
            for (int ks = 0; ks < 2; ++ks) {
                const bf16x8 kf = *(const LAS bf16x8*)(KTs + (d0 + fr) * 72 + ks * 32 + fq * 8);
#pragma unroll
                for (int j = 0; j < 9; ++j) { const bf16x8 vf = *(const LAS bf16x8*)(VTs + (j * 16 + fr) * 72 + ks * 32 + fq * 8);
                    accC[j] = __builtin_amdgcn_mfma_f32_16x16x32_bf16(kf, vf, accC[j], 0, 0, 0); }
            }
        }
        __syncthreads();
        {
            const int d0 = wave * 16;
#pragma unroll
            for (int j = 0; j < 9; ++j) { u32x2 w; w.x = pg8::cvt_pk_bf16(accC[j][0], accC[j][1]); w.y = pg8::cvt_pk_bf16(accC[j][2], accC[j][3]);
                *(LAS u32x2*)(CTs + (j * 16 + fr) * 136 + d0 + 4 * fq) = w; }
        }
    };
#pragma unroll 1
    for (int cs = 0; cs < 66; cs += 3) { step(cs, os0); step(cs + 1, os1); step(cs + 2, os2); }
    step(66, os0); step(67, os1);
    flush();
    __syncthreads();
}

__device__ __forceinline__ float conv3_at(const bf16_t* rowp, int t, int seglen, float w0, float w1, float w2, float bias) {
    const int tl = t % seglen;
    float v = bf2f(rowp[t]) * w1 + bias;
    if (tl > 0) v += bf2f(rowp[t - 1]) * w0;
    if (tl < seglen - 1) v += bf2f(rowp[t + 1]) * w2;
    return v;
}
__device__ __forceinline__ void hyena_naive(const Args& a, int l, unsigned char* lds, int pass_lo, bool do_store) {
    const int tid = opaque_tid(), G = gridDim.x;
    bf16_t* UT = (bf16_t*)(a.ws + WS_UT);
    float* H = (float*)lds;
    float* Ub = H + 8192;
    float* Zb = Ub + 4096;
    float* red = Zb + 4096;
    float* w3s = red + 64;
    const float* hw = a.in[13] + (size_t)l * 3 * 1536; const float* hb = a.in[14] + (size_t)l * 1536;
    const float MIN_DECAY = -3.0701134573253946f, MAX_DECAY = -15.350567286626973f;
    for (int c = blockIdx.x; c < DHY; c += G) {
        const float rate = fabsf(MIN_DECAY + (MAX_DECAY - MIN_DECAY) * (float)c / 511.f);
        const float fb0 = a.in[21][(l * 2 + 0) * 512 + c], fb1 = a.in[21][(l * 2 + 1) * 512 + c];
        float cwv[3][3], cbv[3];
#pragma unroll
        for (int g = 0; g < 3; ++g) { cbv[g] = hb[g * 512 + c];
#pragma unroll
            for (int t3 = 0; t3 < 3; ++t3) cwv[g][t3] = hw[t3 * 1536 + g * 512 + c]; }
        for (int pass = pass_lo; pass < (l == 0 ? 2 : 1); ++pass) {
            const int L = pass ? LCTX : LSEQ;
            const float* hdn = pass ? (const float*)(a.ws + WS_HDNC) : (const float*)(a.ws + WS_HDN) + (size_t)l * 4096 * 64;
            __syncthreads();
            if (tid < 128) w3s[tid] = a.in[20][(size_t)l * 64 * 1024 + (tid & 63) * 1024 + (tid >> 6) * 512 + c];
            __syncthreads();
            float ssq0 = 0.f, ssq1 = 0.f;
            for (int t = tid; t < L; t += 512) { float s0 = 0.f, s1 = 0.f;
                for (int jj = 0; jj < 64; ++jj) { const float hv = hdn[(size_t)t * 64 + jj]; s0 += hv * w3s[jj]; s1 += hv * w3s[64 + jj]; }
                const float off = fabsf((float)t - (float)(L / 2)) / (float)(L / 2); const float dec = __expf(-off * rate);
                s0 *= dec; s1 *= dec; H[t] = s0; H[4096 + t] = s1; ssq0 += s0 * s0; ssq1 += s1 * s1; }
            ssq0 = wave_sum(ssq0); ssq1 = wave_sum(ssq1);
            if ((tid & 63) == 0) { red[tid >> 6] = ssq0; red[8 + (tid >> 6)] = ssq1; }
            __syncthreads();
            float t0 = 0.f, t1 = 0.f;
            for (int w = 0; w < 8; ++w) { t0 += red[w]; t1 += red[8 + w]; }
            const float n0 = rsqrtf(t0 + RMS_EPS), n1 = rsqrtf(t1 + RMS_EPS);
            __syncthreads();
            for (int t = tid; t < L; t += 512) { H[t] *= n0; H[4096 + t] *= n1; }
            __syncthreads();
            for (int b = 0; b < NB; ++b) {
                const size_t col0 = pass ? (size_t)MLAT + (size_t)b * LCTX : (size_t)b * LSEQ;
                const int seglen = pass ? LCTX : 64;
                const bf16_t* rv = UT + (size_t)c * MT + col0; const bf16_t* r1 = UT + (size_t)(512 + c) * MT + col0;
                const bf16_t* r2 = UT + (size_t)(1024 + c) * MT + col0; const bf16_t* rz = UT + (size_t)(1536 + c) * MT + col0;
                for (int t = tid; t < L; t += 512) Ub[t] = conv3_at(rv, t, seglen, cwv[0][0], cwv[0][1], cwv[0][2], cbv[0]);
                __syncthreads();
                for (int t = tid; t < L; t += 512) { float y = 0.f;
                    int slo = t + L / 2 - (L - 1); if (slo < 0) slo = 0; int shi = t + L / 2; if (shi > L - 1) shi = L - 1;
                    for (int s = slo; s <= shi; ++s) y += Ub[s] * H[t + L / 2 - s];
                    const float x1 = conv3_at(r1, t, seglen, cwv[1][0], cwv[1][1], cwv[1][2], cbv[1]);
                    Zb[t] = x1 * (y + Ub[t] * fb0); }
                __syncthreads();
                for (int t = tid; t < L; t += 512) { float y = 0.f;
                    int slo = t + L / 2 - (L - 1); if (slo < 0) slo = 0; int shi = t + L / 2; if (shi > L - 1) shi = L - 1;
                    for (int s = slo; s <= shi; ++s) y += Zb[s] * H[4096 + t + L / 2 - s];
                    const float x2 = conv3_at(r2, t, seglen, cwv[2][0], cwv[2][1], cwv[2][2], cbv[2]);
                    const float o = x2 * (y + Zb[t] * fb1) * silu_f(bf2f(rz[t]));
                    Ub[t] = o; }
                __syncthreads();
                if (do_store) for (int t = tid; t < L; t += 512) UT[(size_t)c * MT + col0 + t] = (bf16_t)f2bf(Ub[t]);
                __syncthreads();
            }
        }
    }
    __syncthreads();
}


typedef float cf __attribute__((ext_vector_type(2)));
__device__ __forceinline__ cf cmul(cf a, cf b) { const cf sw = __builtin_shufflevector(a, a, 1, 0); return a * b.x + sw * cf{-b.y, b.y}; }
__host__ __device__ constexpr float tw32c(int e) { return e == 0 ? 1.f : e == 1 ? 0.98078528040323043f : e == 2 ? 0.92387953251128674f : e == 3 ? 0.83146961230254524f : e == 4 ? 0.70710678118654752f : e == 5 ? 0.55557023301960218f :
    e == 6 ? 0.38268343236508977f : e == 7 ? 0.19509032201612825f : e == 8 ? 0.f : e == 9 ? -0.19509032201612825f : e == 10 ? -0.38268343236508977f : e == 11 ? -0.55557023301960218f : e == 12 ? -0.70710678118654752f :
    e == 13 ? -0.83146961230254524f : e == 14 ? -0.92387953251128674f : -0.98078528040323043f; }
template <int E32> __device__ __forceinline__ cf twmul(cf d) {
    if (E32 == 0) return d;
    if (E32 == 8) return cf{d.y, -d.x};
    constexpr float c = tw32c(E32), sn = tw32c(E32 < 8 ? 8 - E32 : E32 - 8);
    const cf sw = __builtin_shufflevector(d, d, 1, 0);
    return d * c + sw * cf{sn, -sn};
}
template <int R, int HALF, int I> struct DftStage {
    static __device__ __forceinline__ void run(cf (&v)[R]) {
        if constexpr ((I & HALF) == 0) {
            constexpr int E32 = (I % HALF) * (R / (2 * HALF)) * (32 / R);
            const cf a = v[I], b = v[I + HALF];
            v[I] = a + b;
            v[I + HALF] = twmul<E32>(a - b);
        }
        if constexpr (I + 1 < R) DftStage<R, HALF, I + 1>::run(v);
    }
};
template <int R, int HALF> struct DftAll {
    static __device__ __forceinline__ void run(cf (&v)[R]) { DftStage<R, HALF, 0>::run(v); if constexpr (HALF > 1) DftAll<R, HALF / 2>::run(v); }
};
__host__ __device__ constexpr int bitrev_c(int x, int bits) { int r = 0; for (int i = 0; i < bits; ++i) r = (r << 1) | ((x >> i) & 1); return r; }
__device__ __forceinline__ int PADI(int i) { return i + (i >> 4); }
constexpr int FFT_W_ELEMS = 8192 + 512;
template <int R, int I> struct StoreRev {
    static __device__ __forceinline__ void run(LAS cf* Wp, int pstride, const cf (&v)[R]) {
        constexpr int bits = (R == 32) ? 5 : 4;
        Wp[I * pstride] = v[bitrev_c(I, bits)];
        if constexpr (I + 1 < R) StoreRev<R, I + 1>::run(Wp, pstride, v);
    }
};
template <int R, int NS> __device__ __forceinline__ void fft_pass(LAS cf* W, int tid_) {
    int tid = tid_; asm volatile("" : "+v"(tid));
    constexpr int NT = 8192 / R;
    cf v[R];
    const bool act = tid < NT;
    if (act) {
#pragma unroll
        for (int r = 0; r < R; ++r) v[r] = W[PADI(tid) + r * (NT + NT / 16)];
    }
    __syncthreads();
    if (act) {
        const int k = tid % NS;
        if (NS > 1) {
            const float fr_ = -(float)k * (1.f / (float)(NS * R)); const float sn = __builtin_amdgcn_sinf(fr_), cs = __builtin_amdgcn_cosf(fr_);
            const cf w = cf{cs, sn}; cf cur = w;
#pragma unroll
            for (int r = 1; r < R; ++r) { v[r] = cmul(v[r], cur); cur = cmul(cur, w); }
        }
        DftAll<R, R / 2>::run(v);
        const int idx = (tid / NS) * NS * R + k;
        StoreRev<R, 0>::run(W + PADI(idx), NS >= 16 ? NS + NS / 16 : 1, v);
    }
    __syncthreads();
}
__device__ __forceinline__ void fft_pass2(LAS cf* W, int tid_) {
    int tid = tid_; asm volatile("" : "+v"(tid));
#pragma unroll 2
    for (int m = 0; m < 8; ++m) { const int j = tid + 512 * m; const int pj = PADI(j); const cf a = W[pj]; cf b = W[pj + 4352];
        const float fr_ = -(float)j * (1.f / 8192.f); b = cmul(b, cf{__builtin_amdgcn_cosf(fr_), __builtin_amdgcn_sinf(fr_)});
        W[pj] = cf{a.x + b.x, a.y + b.y}; W[pj + 4352] = cf{a.x - b.x, a.y - b.y}; }
    __syncthreads();
}
__device__ __forceinline__ void fft8192(LAS cf* W, int tid) { fft_pass<16, 1>(W, tid); fft_pass<16, 16>(W, tid); fft_pass<16, 256>(W, tid); fft_pass2(W, tid); }

template <int NS> __device__ __forceinline__ void fft4k_pass(LAS cf* Wb, int j_) {
    int j = j_; asm volatile("" : "+v"(j));
    cf v[16];
#pragma unroll
    for (int r = 0; r < 16; ++r) v[r] = Wb[PADI(j) + r * 272];
    __syncthreads();
    const int k = j % NS;
    if (NS > 1) {
        const float fr_ = -(float)k * (1.f / (float)(NS * 16)); const float sn = __builtin_amdgcn_sinf(fr_), cs = __builtin_amdgcn_cosf(fr_);
        const cf w = cf{cs, sn}; cf cur = w;
#pragma unroll
        for (int r = 1; r < 16; ++r) { v[r] = cmul(v[r], cur); cur = cmul(cur, w); }
    }
    DftAll<16, 8>::run(v);
    const int idx = (j / NS) * NS * 16 + k;
    StoreRev<16, 0>::run(Wb + PADI(idx), NS >= 16 ? NS + NS / 16 : 1, v);
    __syncthreads();
}
__device__ __forceinline__ void fft4k_x2(LAS cf* Wb, int j) { fft4k_pass<1>(Wb, j); fft4k_pass<16>(Wb, j); fft4k_pass<256>(Wb, j); }

__device__ __forceinline__ void conv8(const u32x4 rv, int tid, float w0, float w1, float w2, float bias, float (&o)[8]) {
    float x[8];
#pragma unroll
    for (int e = 0; e < 4; ++e) { x[2 * e] = bflo(rv[e]); x[2 * e + 1] = bfhi(rv[e]); }
    float left = __shfl_up(x[7], 1), right = __shfl_down(x[0], 1);
    if ((tid & 7) == 0) left = 0.f;
    if ((tid & 7) == 7) right = 0.f;
#pragma unroll
    for (int e = 0; e < 8; ++e) { const float xm = (e == 0) ? left : x[e - 1], xp = (e == 7) ? right : x[e + 1]; o[e] = w0 * xm + w1 * x[e] + w2 * xp + bias; }
}

__device__ __forceinline__ void hyena_item(const Args& a, int l, unsigned char* lds_, int item, bool do_store) {
    const int tid = opaque_tid();
    const int c = item >> 1, half = item & 1;
    LAS unsigned char* lds = (LAS unsigned char*)lds_;
    LAS cf* W = (LAS cf*)lds;
    LAS cf* He0 = (LAS cf*)(lds + 69632);
    LAS cf* Ho0 = He0 + 2049;
    LAS cf* He1 = Ho0 + 2048;
    LAS cf* Ho1 = He1 + 2049;
    const int sel = tid >> 8, j = tid & 255;
    LAS cf* Wb = W + sel * 4352;
    bf16_t* UT = (bf16_t*)(a.ws + WS_UT);
    const float* FT = (const float*)(a.ws + WS_FT);
    const float* hw = a.in[13] + (size_t)l * 3 * 1536; const float* hb = a.in[14] + (size_t)l * 1536;
    const float fb0 = a.in[21][(l * 2 + 0) * 512 + c], fb1 = a.in[21][(l * 2 + 1) * 512 + c];
    const int pi0 = PADI(tid * 8);
    __syncthreads();
    {
        const f32x4 ha = *(const f32x4*)(FT + (size_t)c * 4096 + tid * 8), hb2 = *(const f32x4*)(FT + (size_t)c * 4096 + tid * 8 + 4);
        const f32x4 ga = *(const f32x4*)(FT + (size_t)(512 + c) * 4096 + tid * 8), gb2 = *(const f32x4*)(FT + (size_t)(512 + c) * 4096 + tid * 8 + 4);
        const float fn0 = FT[(size_t)1024 * 4096 + c], fn1 = FT[(size_t)1024 * 4096 + 512 + c];
#pragma unroll
        for (int e = 0; e < 8; ++e) { const cf f = cf{(e < 4 ? ha[e & 3] : hb2[e & 3]) * fn0, (e < 4 ? ga[e & 3] : gb2[e & 3]) * fn1};
            const float fr_ = -(float)(tid * 8 + e) * (1.f / 8192.f);
            W[pi0 + e] = f; W[4352 + pi0 + e] = cmul(f, cf{__builtin_amdgcn_cosf(fr_), __builtin_amdgcn_sinf(fr_)}); }
        __syncthreads();
        fft4k_x2(Wb, j);
        for (int m = tid; m <= 2048; m += NTHR) { const cf A = W[PADI(m & 4095)], Bm = W[PADI((4096 - m) & 4095)];
            He0[m] = cf{0.5f * (A.x + Bm.x), 0.5f * (A.y - Bm.y)}; He1[m] = cf{0.5f * (A.y + Bm.y), -0.5f * (A.x - Bm.x)}; }
        for (int m = tid; m < 2048; m += NTHR) { const cf A = W[4352 + PADI(m)], Bm = W[4352 + PADI(4095 - m)];
            Ho0[m] = cf{0.5f * (A.x + Bm.x), 0.5f * (A.y - Bm.y)}; Ho1[m] = cf{0.5f * (A.y + Bm.y), -0.5f * (A.x - Bm.x)}; }
        __syncthreads();
    }
    float cwv[3][3], cbv[3];
#pragma unroll
    for (int g = 0; g < 3; ++g) { cbv[g] = hb[g * 512 + c];
#pragma unroll
        for (int t3 = 0; t3 < 3; ++t3) cwv[g][t3] = hw[t3 * 1536 + g * 512 + c]; }
#pragma unroll 1
    for (int bp = half * 2; bp < half * 2 + 2; ++bp) {
        const size_t o0 = (size_t)(2 * bp) * LSEQ + tid * 8, o1 = o0 + LSEQ;
        bf16_t* rv = UT + (size_t)c * MT; const bf16_t* r1 = UT + (size_t)(512 + c) * MT; const bf16_t* r2 = UT + (size_t)(1024 + c) * MT; const bf16_t* rz = UT + (size_t)(1536 + c) * MT;
        const u32x4 qv0 = *(const u32x4*)(rv + o0), qv1 = *(const u32x4*)(rv + o1), qa0 = *(const u32x4*)(r1 + o0), qa1 = *(const u32x4*)(r1 + o1);
        const u32x4 qb0 = *(const u32x4*)(r2 + o0), qb1 = *(const u32x4*)(r2 + o1), qz0 = *(const u32x4*)(rz + o0), qz1 = *(const u32x4*)(rz + o1);
        float z0[8], z1[8];
        conv8(qv0, tid, cwv[0][0], cwv[0][1], cwv[0][2], cbv[0], z0);
        conv8(qv1, tid, cwv[0][0], cwv[0][1], cwv[0][2], cbv[0], z1);
#pragma unroll 1
        for (int ord = 0; ord < 2; ++ord) {
#pragma unroll
            for (int e = 0; e < 8; ++e) { const cf f = cf{z0[e], z1[e]}; const float fr_ = -(float)(tid * 8 + e) * (1.f / 8192.f);
                W[pi0 + e] = f; W[4352 + pi0 + e] = cmul(f, cf{__builtin_amdgcn_cosf(fr_), __builtin_amdgcn_sinf(fr_)}); }
            __syncthreads();
            fft4k_x2(Wb, j);
            {
                LAS const cf* Hs = sel ? (ord ? Ho1 : Ho0) : (ord ? He1 : He0);
                const int top = sel ? 4095 : 4096, lim = sel ? 2047 : 2048;
#pragma unroll 4
                for (int i = 0; i < 16; ++i) { const int m = j + 256 * i; const int pm = PADI(m); const cf zv = Wb[pm];
                    cf hk; if (m <= lim) hk = Hs[m]; else { hk = Hs[top - m]; hk.y = -hk.y; }
                    const cf y = cmul(zv, hk); Wb[pm] = cf{y.x, -y.y}; }
            }
            __syncthreads();
            fft4k_x2(Wb, j);
            float x0[8], x1[8];
            conv8(ord ? qb0 : qa0, tid, cwv[1 + ord][0], cwv[1 + ord][1], cwv[1 + ord][2], cbv[1 + ord], x0);
            conv8(ord ? qb1 : qa1, tid, cwv[1 + ord][0], cwv[1 + ord][1], cwv[1 + ord][2], cbv[1 + ord], x1);
            const float fb = ord ? fb1 : fb0;
            const int pr = PADI((2048 + tid * 8) & 4095);
#pragma unroll
            for (int e = 0; e < 8; ++e) { const float fr_ = -(float)(2048 + tid * 8 + e) * (1.f / 8192.f);
                const cf ev = W[pr + e], ov = cmul(W[4352 + pr + e], cf{__builtin_amdgcn_cosf(fr_), __builtin_amdgcn_sinf(fr_)});
                const float y0 = (ev.x + ov.x) * (1.f / 8192.f), y1 = -(ev.y + ov.y) * (1.f / 8192.f);
                z0[e] = x0[e] * (y0 + z0[e] * fb); z1[e] = x1[e] * (y1 + z1[e] * fb); }
            __syncthreads();
        }
        {
            u32x4 w0, w1;
#pragma unroll
            for (int e = 0; e < 4; ++e) { w0[e] = pg8::cvt_pk_bf16(z0[2 * e] * silu_f(bflo(qz0[e])), z0[2 * e + 1] * silu_f(bfhi(qz0[e])));
                w1[e] = pg8::cvt_pk_bf16(z1[2 * e] * silu_f(bflo(qz1[e])), z1[2 * e + 1] * silu_f(bfhi(qz1[e]))); }
            if (do_store) { *(u32x4*)(rv + o0) = w0; *(u32x4*)(rv + o1) = w1; } }
    }
    __syncthreads();
}

__device__ __forceinline__ void filt_item(const Args& a, int l, unsigned char* lds_, int fi) {
    const int tid = opaque_tid();
    LAS float* w3s = (LAS float*)lds_ + 4096;
    LAS float* red = w3s + 512;
    float* FT = (float*)(a.ws + WS_FT);
    const float* hdn = (const float*)(a.ws + WS_HDN) + (size_t)l * 4096 * 64;
    const float MIN_DECAY = -3.0701134573253946f, MAX_DECAY = -15.350567286626973f;
    __syncthreads();
    w3s[tid] = a.in[20][(size_t)l * 64 * 1024 + (size_t)(tid >> 3) * 1024 + fi * 8 + (tid & 7)];
    __syncthreads();
    float rate[8], ssq[8];
#pragma unroll
    for (int cc = 0; cc < 8; ++cc) { const int ch = (fi * 8 + cc) & 511; rate[cc] = fabsf(MIN_DECAY + (MAX_DECAY - MIN_DECAY) * (float)ch / 511.f); ssq[cc] = 0.f; }
#pragma unroll 1
    for (int it2 = 0; it2 < 2; ++it2) {
        float acc[4][8];
#pragma unroll
        for (int q = 0; q < 4; ++q)
#pragma unroll
            for (int cc = 0; cc < 8; ++cc) acc[q][cc] = 0.f;
        const f32x4* hp = (const f32x4*)(hdn + (size_t)(it2 * 2048 + tid) * 64);
        f32x4 hn[4];
#pragma unroll
        for (int q = 0; q < 4; ++q) hn[q] = hp[(size_t)q * 512 * 16];
#pragma unroll 1
        for (int j4 = 0; j4 < 16; ++j4) {
            f32x4 hv[4];
#pragma unroll
            for (int q = 0; q < 4; ++q) hv[q] = hn[q];
            if (j4 < 15) {
#pragma unroll
                for (int q = 0; q < 4; ++q) hn[q] = hp[(size_t)q * 512 * 16 + j4 + 1]; }
#pragma unroll
            for (int jj = 0; jj < 4; ++jj) { const f32x4 wa = *(const LAS f32x4*)(w3s + (4 * j4 + jj) * 8), wb = *(const LAS f32x4*)(w3s + (4 * j4 + jj) * 8 + 4);
#pragma unroll
                for (int q = 0; q < 4; ++q) { const float h = hv[q][jj];
                    acc[q][0] += h * wa.x; acc[q][1] += h * wa.y; acc[q][2] += h * wa.z; acc[q][3] += h * wa.w; acc[q][4] += h * wb.x; acc[q][5] += h * wb.y; acc[q][6] += h * wb.z; acc[q][7] += h * wb.w; } }
        }
#pragma unroll
        for (int q = 0; q < 4; ++q) { const int t = it2 * 2048 + tid + 512 * q; const float off = fabsf((float)t - 2048.f) * (1.f / 2048.f);
#pragma unroll
            for (int cc = 0; cc < 8; ++cc) { const float v = acc[q][cc] * __expf(-off * rate[cc]); ssq[cc] += v * v; FT[(size_t)(fi * 8 + cc) * 4096 + t] = v; } }
    }
#pragma unroll
    for (int cc = 0; cc < 8; ++cc) { const float sv = wave_sum(ssq[cc]); if ((tid & 63) == 0) red[(tid >> 6) * 8 + cc] = sv; }
    __syncthreads();
    if (tid < 8) { float tsum = 0.f;
#pragma unroll
        for (int w = 0; w < 8; ++w) tsum += red[w * 8 + tid];
        FT[(size_t)1024 * 4096 + fi * 8 + tid] = rsqrtf(tsum + RMS_EPS); }
}

__device__ __forceinline__ float ctx_conv3(const bf16_t* rowp, int t, float w0, float w1, float w2, float bias) {
    float v = bf2f(rowp[t]) * w1 + bias;
    if (t > 0) v += bf2f(rowp[t - 1]) * w0;
    if (t < LCTX - 1) v += bf2f(rowp[t + 1]) * w2;
    return v;
}
__device__ __forceinline__ void hyena_ctx_item(const Args& a, unsigned char* lds_, int c, bool do_store) {
    const int tid = opaque_tid();
    LAS float* Hc = (LAS float*)lds_;
    LAS float* U = Hc + 512;
    LAS float* Z = U + 2048;
    LAS float* red = Z + 2048;
    LAS float* w3s = red + 16;
    bf16_t* UT = (bf16_t*)(a.ws + WS_UT);
    const float* hdn = (const float*)(a.ws + WS_HDNC);
    const float* hw = a.in[13]; const float* hb = a.in[14];
    const float MIN_DECAY = -3.0701134573253946f, MAX_DECAY = -15.350567286626973f;
    const int t = tid & 255, bh = tid >> 8;
    {
        const float rate = fabsf(MIN_DECAY + (MAX_DECAY - MIN_DECAY) * (float)c / 511.f);
        const float fb0 = a.in[21][c], fb1 = a.in[21][512 + c];
        __syncthreads();
        if (tid < 128) w3s[tid] = a.in[20][(size_t)(tid & 63) * 1024 + (tid >> 6) * 512 + c];
        __syncthreads();
        {
            float sv = 0.f;
            const f32x4* hp = (const f32x4*)(hdn + (size_t)t * 64);
#pragma unroll 4
            for (int j4 = 0; j4 < 16; ++j4) { const f32x4 hv = hp[j4]; sv += hv.x * w3s[bh * 64 + 4 * j4] + hv.y * w3s[bh * 64 + 4 * j4 + 1] + hv.z * w3s[bh * 64 + 4 * j4 + 2] + hv.w * w3s[bh * 64 + 4 * j4 + 3]; }
            sv *= __expf(-fabsf((float)t - 128.f) * (1.f / 128.f) * rate);
            const float ss = wave_sum(sv * sv);
            if ((tid & 63) == 0) red[tid >> 6] = ss;
            __syncthreads();
            const float tot = red[bh * 4] + red[bh * 4 + 1] + red[bh * 4 + 2] + red[bh * 4 + 3];
            Hc[bh * 256 + t] = sv * rsqrtf(tot + RMS_EPS);
        }
        float vv[4];
#pragma unroll
        for (int i = 0; i < 4; ++i) { const bf16_t* rv = UT + (size_t)c * MT + MLAT + (size_t)(bh * 4 + i) * LCTX;
            vv[i] = ctx_conv3(rv, t, hw[c], hw[1536 + c], hw[3072 + c], hb[c]); }
        *(LAS f32x4*)(U + t * 8 + bh * 4) = (f32x4){vv[0], vv[1], vv[2], vv[3]};
        __syncthreads();
        const int slo = (t - 127 > 0) ? t - 127 : 0, shi = (t + 128 < 255) ? t + 128 : 255;
        f32x4 acc = {0.f, 0.f, 0.f, 0.f};
        for (int s2 = slo; s2 <= shi; ++s2) { const float h = Hc[t + 128 - s2]; const f32x4 u = *(const LAS f32x4*)(U + s2 * 8 + bh * 4); acc = acc + u * h; }
        float zz[4];
#pragma unroll
        for (int i = 0; i < 4; ++i) { const bf16_t* r1 = UT + (size_t)(512 + c) * MT + MLAT + (size_t)(bh * 4 + i) * LCTX;
            const float x1 = ctx_conv3(r1, t, hw[512 + c], hw[1536 + 512 + c], hw[3072 + 512 + c], hb[512 + c]);
            zz[i] = x1 * (acc[i] + vv[i] * fb0); }
        *(LAS f32x4*)(Z + t * 8 + bh * 4) = (f32x4){zz[0], zz[1], zz[2], zz[3]};
        __syncthreads();
        acc = (f32x4){0.f, 0.f, 0.f, 0.f};
        for (int s2 = slo; s2 <= shi; ++s2) { const float h = Hc[256 + t + 128 - s2]; const f32x4 u = *(const LAS f32x4*)(Z + s2 * 8 + bh * 4); acc = acc + u * h; }
#pragma unroll
        for (int i = 0; i < 4; ++i) { const size_t off = (size_t)MLAT + (size_t)(bh * 4 + i) * LCTX;
            const bf16_t* r2 = UT + (size_t)(1024 + c) * MT + off; const bf16_t* rz = UT + (size_t)(1536 + c) * MT + off;
            const float x2 = ctx_conv3(r2, t, hw[1024 + c], hw[1536 + 1024 + c], hw[3072 + 1024 + c], hb[1024 + c]);
            const float o = x2 * (acc[i] + zz[i] * fb1) * silu_f(bf2f(rz[t]));
            if (do_store) UT[(size_t)c * MT + off + t] = (bf16_t)f2bf(o); }
    }
    __syncthreads();
}


__device__ __forceinline__ void phase_mixers(const Args& a, int l, unsigned char* lds, int rep, bool do_mlstm, bool do_hy, bool do_hyctx) {
    LAS unsigned* qslot = (LAS unsigned*)((LAS unsigned char*)lds + (LDS_BYTES - 32));
    if (do_mlstm && (blockIdx.x & 3) == 0 && (blockIdx.x >> 2) < 64) mlstm_item(a, l, lds, blockIdx.x >> 2, rep == 0);
    unsigned* ctr = (unsigned*)(a.ws + WS_CTL) + CW_QUEUE + 64 * (l * 8 + rep);
    const int n_lat = do_hy ? 2 * DHY : 0, n_ctx = (l == 0 && do_hyctx) ? DHY : 0;
    for (;;) {
        __syncthreads();
        if (threadIdx.x == 0) *qslot = __hip_atomic_fetch_add(ctr, 1u, __ATOMIC_RELAXED, __HIP_MEMORY_SCOPE_AGENT);
        __syncthreads();
        const int item = (int)*qslot;
        if (item >= n_lat + n_ctx) break;
        if (item < n_lat) hyena_item(a, l, lds, item, rep == 0);
        else hyena_ctx_item(a, lds, item - n_lat, rep == 0);
    }
    __syncthreads();
}

__device__ __forceinline__ void phase_combine(const Args& a, int l, unsigned char* lds) {
    const int tid = opaque_tid(), G = gridDim.x, lane = tid & 63, wave = tid >> 6;
    const bf16_t* U1 = (const bf16_t*)(a.ws + WS_U1);
    const bf16_t* HDi = (const bf16_t*)(a.ws + WS_HB);
    const bf16_t* UT = (const bf16_t*)(a.ws + WS_UT);
    bf16_t* YM = (bf16_t*)(a.ws + WS_YMIX);
    bf16_t* T = (bf16_t*)lds;
    const int nblk = (l == 0 ? MT : MLAT) / 64;
    const float* mg = a.in[12] + l * 512;
    for (int blk = blockIdx.x; blk < nblk; blk += G) {
        const int r0 = blk * 64;
        __syncthreads();
#pragma unroll
        for (int i = 0; i < 8; ++i) { const int e = tid + i * 512, ch = e >> 3, p8 = (e & 7) * 8;
            *(u32x4*)(T + ch * 72 + p8) = *(const u32x4*)(UT + (size_t)ch * MT + r0 + p8); }
        for (int rr = wave; rr < 64; rr += 8) {
            const size_t row = r0 + rr;
            const u32x4 hf = *(const u32x4*)(HDi + row * DML + lane * 8), hb = *(const u32x4*)(HDi + ((size_t)MT + row) * DML + lane * 8);
            const u32x4 ov = *(const u32x4*)(U1 + row * LDU1 + 1024 + lane * 8), zv = *(const u32x4*)(U1 + row * LDU1 + 1536 + lane * 8);
            float hg[8]; float ss = 0.f;
#pragma unroll
            for (int i = 0; i < 4; ++i) { const unsigned f = hf[i], bb = hb[i], o = ov[i];
                hg[2 * i] = (bf2f(f & 0xffff) + bf2f(bb & 0xffff)) * sigmoid_f(bf2f(o & 0xffff));
                hg[2 * i + 1] = (bf2f(f >> 16) + bf2f(bb >> 16)) * sigmoid_f(bf2f(o >> 16));
                ss += hg[2 * i] * hg[2 * i] + hg[2 * i + 1] * hg[2 * i + 1]; }
            ss += __shfl_xor(ss, 1); ss += __shfl_xor(ss, 2); ss += __shfl_xor(ss, 4); ss += __shfl_xor(ss, 8);
            const float r = rsqrtf(ss * (1.f / 128.f) + RMS_EPS);
            u32x4 o4;
#pragma unroll
            for (int i = 0; i < 4; ++i) { const unsigned z = zv[i];
                const float v0 = hg[2 * i] * r * mg[lane * 8 + 2 * i] * silu_f(bf2f(z & 0xffff));
                const float v1 = hg[2 * i + 1] * r * mg[lane * 8 + 2 * i + 1] * silu_f(bf2f(z >> 16));
                o4[i] = pk2(v0, v1); }
            *(u32x4*)(YM + row * DM + lane * 8) = o4;
        }
        __syncthreads();
        for (int rr = wave; rr < 64; rr += 8) {
            u32x4 o4;
#pragma unroll
            for (int i = 0; i < 4; ++i) o4[i] = (unsigned)T[(lane * 8 + 2 * i) * 72 + rr] | ((unsigned)T[(lane * 8 + 2 * i + 1) * 72 + rr] << 16);
            *(u32x4*)(YM + (size_t)(r0 + rr) * DM + 512 + lane * 8) = o4;
        }
    }
    __syncthreads();
}


#define XB_TMO      128
#define XB_XCNT(j)  (256  + 64 * (j))
#define XB_XSUB(j)  (1280 + 64 * (j))
#define XB_XGEN(j)  (2304 + 64 * (j))
#define XB_TOP      3328
#define XB_TOPGEN   3392
#define XCD_BAR_WORDS 3456
#define XB_SPIN_CAP (1u << 18)
__device__ __forceinline__ unsigned xb_ld(unsigned* p)              { return __hip_atomic_load(p, __ATOMIC_RELAXED, __HIP_MEMORY_SCOPE_AGENT); }
__device__ __forceinline__ unsigned xb_add(unsigned* p, unsigned v) { return __hip_atomic_fetch_add(p, v, __ATOMIC_RELAXED, __HIP_MEMORY_SCOPE_AGENT); }
__device__ __forceinline__ unsigned xb_xcc_id() { return (unsigned)__builtin_amdgcn_s_getreg((3 << 11) | 20) & 0xFu; }
#define XB_SPIN(cond, bar) do { unsigned _sp = 0; while (cond) { __builtin_amdgcn_s_sleep(1); \
    if ((++_sp & 255u) == 0u) { if (xb_ld(&(bar)[XB_TMO])) break; if (_sp > XB_SPIN_CAP) { atomicAdd(&(bar)[XB_TMO], 1u); break; } } } } while (0)
struct XcdBarrier { unsigned* bar; unsigned x; volatile __attribute__((address_space(3))) unsigned* st; };
__device__ __forceinline__ XcdBarrier xcd_barrier_post(unsigned* bar, volatile __attribute__((address_space(3))) unsigned* st) {
    XcdBarrier b; b.bar = bar; b.x = xb_xcc_id(); b.st = st;
    if (threadIdx.x == 0) (void)xb_add(&bar[XB_XCNT(b.x)], 1u);
    return b;
}
__device__ __forceinline__ void xcd_barrier_complete(unsigned* bar, unsigned x, unsigned& nloc, unsigned& nx) {
    const unsigned G = gridDim.x * gridDim.y * gridDim.z;
    unsigned sum, cnt, mine, sp = 0u;
    for (;;) {
        sum = 0u; cnt = 0u; mine = 0u;
#pragma unroll
        for (unsigned j = 0; j < 16; ++j) { const unsigned c = xb_ld(&bar[XB_XCNT(j)]); sum += c; cnt += (c > 0u) ? 1u : 0u; mine = (j == x) ? c : mine; }
        if (sum == G) break;
        __builtin_amdgcn_s_sleep(1);
        if ((++sp & 255u) == 0u) { if (xb_ld(&bar[XB_TMO])) break; if (sp > XB_SPIN_CAP) { atomicAdd(&bar[XB_TMO], 1u); break; } }
    }
    nloc = mine > 0u ? mine : 1u; nx = cnt > 0u ? cnt : 1u;
}
__device__ __forceinline__ void xcd_barrier(const XcdBarrier& b) {
    asm volatile("s_waitcnt vmcnt(0)" ::: "memory");
    __syncthreads();
    if (threadIdx.x == 0) {
        unsigned* bar = b.bar;
        __builtin_amdgcn_s_waitcnt(0);
        unsigned nloc = b.st[0], nx = b.st[1];
        if (nloc == 0u) { xcd_barrier_complete(bar, b.x, nloc, nx); b.st[0] = nloc; b.st[1] = nx; }
        const unsigned old = xb_add(&bar[XB_XSUB(b.x)], 1u);
        const unsigned gen = old / nloc;
        if (old + 1u == (gen + 1u) * nloc) {
            __builtin_amdgcn_fence(__ATOMIC_RELEASE, "agent");
            asm volatile("s_waitcnt vmcnt(0)" ::: "memory");
            const unsigned og = xb_add(&bar[XB_TOP], 1u);
            const unsigned tg = og / nx;
            if (og + 1u == (tg + 1u) * nx) xb_add(&bar[XB_TOPGEN], 1u);
            else XB_SPIN(xb_ld(&bar[XB_TOPGEN]) == tg, bar);
            __builtin_amdgcn_fence(__ATOMIC_ACQUIRE, "agent");
            xb_add(&bar[XB_XGEN(b.x)], 1u);
            asm volatile("s_waitcnt vmcnt(0)" ::: "memory");
        } else {
            XB_SPIN(xb_ld(&bar[XB_XGEN(b.x)]) == gen, bar);
            __builtin_amdgcn_fence(__ATOMIC_ACQUIRE, "agent");
            asm volatile("s_waitcnt vmcnt(0)" ::: "memory");
        }
    }
    __syncthreads();
}

__global__ void __launch_bounds__(NTHR, 2) fwd(Args a_) {
    extern __shared__ __attribute__((aligned(16))) unsigned char lds[];
    cg::grid_group grid = cg::this_grid();
    const int lo = a_.ph_lo, hi = a_.ph_hi; const int rp_phase = a_.rep_phase, rp_count = a_.rep_count & 255;
#define IN(k) (lo <= (k) && (k) < hi)
    volatile __attribute__((address_space(3))) unsigned* bst = (volatile __attribute__((address_space(3))) unsigned*)((__attribute__((address_space(3))) unsigned char*)lds + (LDS_BYTES - 64));
    if (threadIdx.x < 2) bst[threadIdx.x] = 0u;
    __syncthreads();
    const XcdBarrier xbar = xcd_barrier_post((unsigned*)(a_.ws + WS_CTL), bst);
    if (lo < 0) grid.sync();
#define SEAM(k) do { if (IN(k) && IN((k) + 1)) xcd_barrier(xbar); } while (0)
    if (IN(0)) _Pragma("unroll 1") for (int rep = 0, nrep = (rp_phase == 0) ? rp_count : 1; rep < nrep; ++rep) phase_prep(kargs(), lds);
    SEAM(0);
    if (IN(1)) _Pragma("unroll 1") for (int rep = 0, nrep = (rp_phase == 1) ? rp_count : 1; rep < nrep; ++rep) phase_norm(kargs(), 0, false, true, lds);
    SEAM(1);
    for (int l = 0; l < DEPTH; ++l) {
        const int p = 2 + 6 * l;
        if (IN(p)) {
            unsigned char* ws = kargs().ws;
            const bf16_t* HB = (const bf16_t*)(ws + WS_HB);
            const bf16_t* WinT = (const bf16_t*)(ws + WS_WINT) + (size_t)l * NPK * DM;
#if NAIVE_GEMM
            gemm_naive(HB, WinT, MT, NU1, DM, ws + WS_U1, NU1, 0, lds);
            gemm_naive(HB, WinT + (size_t)NU1 * DM, MT, NU2, DM, ws + WS_UT, MT, 1, lds);
#else
            DecIn d{(const char*)HB, (const char*)WinT, (char*)(ws + WS_U1), (char*)(ws + WS_UT)};
            pg8::GridOrder<DecIn> S; S.init(MT / 256, NPK / 256, gridDim.x, blockIdx.x, d);
            _Pragma("unroll 1") for (int rep = 0, nrep = (rp_phase == 2) ? rp_count : 1; rep < nrep; ++rep) pg8::gemm_phase<true>((PG8_LAS unsigned char*)lds, DM, S);
#endif
        }
        SEAM(p);
        if (IN(p + 1)) _Pragma("unroll 1") for (int rep = 0, nrep = (rp_phase == 9) ? rp_count : 1; rep < nrep; ++rep) phase_mprep(kargs(), l, lds, rep);
        SEAM(p + 1);
        if (IN(p + 2)) {
            const int nrep = (rp_phase == 3 || rp_phase == 4 || rp_phase == 5 || rp_phase == 11) ? rp_count : 1;
            _Pragma("unroll 1") for (int rep = 0; rep < nrep; ++rep)
                phase_mixers(kargs(), l, lds, rep, rep == 0 || rp_phase == 3 || rp_phase == 11, rep == 0 || rp_phase == 4 || rp_phase == 11, rep == 0 || rp_phase == 5 || rp_phase == 11);
        }
        SEAM(p + 2);
        if (IN(p + 3)) _Pragma("unroll 1") for (int rep = 0, nrep = (rp_phase == 6) ? rp_count : 1; rep < nrep; ++rep) phase_combine(kargs(), l, lds);
        SEAM(p + 3);
        if (IN(p + 4)) {
            unsigned char* ws = kargs().ws;
            const bf16_t* WoutT = (const bf16_t*)(ws + WS_WOUTT) + (size_t)l * DM * DM;
#if NAIVE_GEMM
            gemm_naive((const bf16_t*)(ws + WS_YMIX), WoutT, (l == 0) ? MT : MLAT, DM, DM, ws + WS_U1, DM, 2, lds);
#else
            DecOut d{(const char*)(ws + WS_YMIX), (const char*)WoutT, (char*)(ws + WS_U1)};
            pg8::GridOrder<DecOut> S; S.init(((l == 0) ? MT : MLAT) / 256, DM / 256, gridDim.x, blockIdx.x, d);
            _Pragma("unroll 1") for (int rep = 0, nrep = (rp_phase == 7) ? rp_count : 1; rep < nrep; ++rep) pg8::gemm_phase<false>((PG8_LAS unsigned char*)lds, DM, S);
#endif
        }
        SEAM(p + 4);
        if (IN(p + 5)) _Pragma("unroll 1") for (int rep = 0, nrep = (rp_phase == 8 && l == 0) ? rp_count : 1; rep < nrep; ++rep) phase_norm(kargs(), l + 1, true, l + 1 < DEPTH, lds);
        SEAM(p + 5);
    }
    if (rp_phase == 10) for (int rep = 0; rep < rp_count; ++rep) xcd_barrier(xbar);
#undef IN
#undef SEAM
}

constexpr int NPHASES = 2 + 6 * DEPTH;

extern "C" void kernel_launch(void* const* d_in, const int* in_sizes, int n_in, void* d_out, int out_size, void* d_ws, size_t ws_size, hipStream_t stream) {
    static int grid = 0;
    if (grid == 0) {
        if (n_in != 23 || out_size != MLAT * DM || ws_size < WS_END) { fprintf(stderr, "kernel_launch: unexpected shapes n_in %d out %d ws %zu\n", n_in, out_size, ws_size); grid = -1; return; }
        int dev = 0, cus = 0, per_cu = 0;
        (void)hipGetDevice(&dev);
        (void)hipDeviceGetAttribute(&cus, hipDeviceAttributeMultiprocessorCount, dev);
        (void)hipFuncSetAttribute((const void*)fwd, hipFuncAttributeMaxDynamicSharedMemorySize, LDS_BYTES);
        (void)hipOccupancyMaxActiveBlocksPerMultiprocessor(&per_cu, (const void*)fwd, NTHR, LDS_BYTES);
        if (per_cu < 1) per_cu = 1;
        grid = cus * per_cu;
        fprintf(stderr, "kernel_launch: cus %d per_cu %d grid %d ws %zu\n", cus, per_cu, grid, ws_size);
    }
    if (grid < 0) return;
    Args a{};
    for (int i = 0; i < 23; ++i) a.in[i] = (const float*)d_in[i];
    a.out = (float*)d_out; a.ws = (unsigned char*)d_ws;
    (void)hipMemsetAsync((char*)d_ws + WS_CTL, 0, 32768, stream);
    a.ph_lo = 0; a.ph_hi = NPHASES; a.rep_phase = PROBE_PHASE; a.rep_count = PROBE_COUNT;
    void* kargs[] = {&a};
    hipError_t e = hipLaunchCooperativeKernel((const void*)fwd, dim3(grid), dim3(NTHR), kargs, LDS_BYTES, stream);
    if (e != hipSuccess) fprintf(stderr, "kernel_launch: cooperative launch failed: %s (grid %d)\n", hipGetErrorString(e), grid);
}
```

```cpp
#include <hip/hip_runtime.h>
#include <hip/hip_cooperative_groups.h>
#include <cstdio>
#include <cstdint>
namespace cg = cooperative_groups;

constexpr int NB = 8, LSEQ = 4096, DM = 1024, LCTX = 256, DEPTH = 2;
constexpr int MLAT = NB * LSEQ, MCTX = NB * LCTX, MT = MLAT + MCTX;
constexpr int DIN = 4624, NU1 = 2560, NU2 = 2048, NPK = NU1 + NU2;
constexpr int QK8_STRIDE = (LCTX + LSEQ) * 256 + 8192;
constexpr int LDU1 = 2048;
constexpr int NH = 4, HD = 128, DML = 512, DHY = 512;
constexpr float RMS_EPS = 1e-6f;
constexpr int NTHR = 512;
constexpr int LDS_BYTES = 147456;
#ifndef PROBE_PHASE
#define PROBE_PHASE -1
#endif
#ifndef PROBE_COUNT
#define PROBE_COUNT 1
#endif
#ifndef REP_PREP
#define REP_PREP 1
#endif
#ifndef REP_NORM
#define REP_NORM 1
#endif
#ifndef REP_GEMM1
#define REP_GEMM1 1
#endif
#ifndef REP_MLSTM
#define REP_MLSTM 1
#endif
#ifndef REP_HYENA
#define REP_HYENA 1
#endif
#ifndef REP_HYCTX
#define REP_HYCTX 1
#endif
#ifndef REP_COMB
#define REP_COMB 1
#endif
#ifndef REP_GEMM2
#define REP_GEMM2 1
#endif
#ifndef NAIVE_MLSTM
#define NAIVE_MLSTM 0
#endif
#ifndef NAIVE_HYENA
#define NAIVE_HYENA 0
#endif
#ifndef NAIVE_GEMM
#define NAIVE_GEMM 0
#endif

constexpr size_t MiB = 1u << 20;
constexpr size_t WS_CTL = 0;
constexpr size_t WS_MOD = 1 * MiB;
constexpr size_t WS_HDN = 2 * MiB;
constexpr size_t WS_HDNC = 4 * MiB;
constexpr size_t WS_GATES = 5 * MiB;
constexpr size_t WS_WGT = 512 * 1024;
constexpr size_t WS_GP = 4 * MiB + 256 * 1024;
constexpr size_t WS_XC1 = 8 * MiB;
constexpr size_t WS_WINT = 16 * MiB;
constexpr size_t WS_WOUTT = 34 * MiB;
constexpr size_t WS_HB = 40 * MiB;
constexpr size_t WS_U1 = 108 * MiB;
constexpr size_t WS_V2 = 244 * MiB;
constexpr size_t WS_UT = 280 * MiB;
constexpr size_t WS_YMIX = 416 * MiB;
constexpr size_t WS_FT = 485 * MiB;
constexpr size_t WS_END = 502 * MiB;

constexpr int CW_QUEUE = 4096;

typedef unsigned short bf16_t;
typedef float f32x4 __attribute__((ext_vector_type(4)));
typedef float f32x2 __attribute__((ext_vector_type(2)));
typedef unsigned u32x4 __attribute__((ext_vector_type(4)));
typedef unsigned u32x2 __attribute__((ext_vector_type(2)));

struct Args {
    const float* in[23];
    float* out;
    unsigned char* ws;
    int ph_lo, ph_hi;
    int rep_phase, rep_count;
};

__device__ __forceinline__ float bf2f(unsigned b) { return __uint_as_float(b << 16); }
__device__ __forceinline__ unsigned f2bf(float f) { unsigned u = __float_as_uint(f); return (u + 0x7fffu + ((u >> 16) & 1u)) >> 16; }
__device__ __forceinline__ unsigned pk2(float lo, float hi) { return f2bf(lo) | (f2bf(hi) << 16); }
__device__ __forceinline__ float bflo(unsigned x) { return __uint_as_float(x << 16); }
__device__ __forceinline__ float bfhi(unsigned x) { return __uint_as_float(x & 0xffff0000u); }
__device__ __forceinline__ float silu_f(float x) { return x / (1.f + __expf(-x)); }
__device__ __forceinline__ float sigmoid_f(float x) { return 1.f / (1.f + __expf(-x)); }
typedef const Args __attribute__((address_space(4)))* KArgsP;
__device__ __forceinline__ Args kargs() {
    int z = 0; asm volatile("" : "+s"(z));
    KArgsP p = (KArgsP)((const char __attribute__((address_space(4)))*)__builtin_amdgcn_kernarg_segment_ptr() + z);
    Args a;
#pragma unroll
    for (int i = 0; i < 23; ++i) a.in[i] = p->in[i];
    a.out = p->out; a.ws = p->ws; a.ph_lo = p->ph_lo; a.ph_hi = p->ph_hi; a.rep_phase = p->rep_phase; a.rep_count = p->rep_count;
    return a;
}
__device__ __forceinline__ int opaque_tid() { int t = threadIdx.x; asm volatile("" : "+v"(t)); return t; }
__device__ __forceinline__ float wave_sum(float v) {
#pragma unroll
    for (int o = 1; o < 64; o <<= 1) v += __shfl_xor(v, o);
    return v;
}

__device__ __forceinline__ void phase_prep(const Args& a, unsigned char* lds) {
    const int tid = opaque_tid(), G = gridDim.x;
    float* scr = (float*)lds;
    constexpr int IT_WIN = 2 * 16 * 72, IT_WOUT = 2 * 16 * 16, IT_MOD = 2 * 48, IT_HDN = 132, IT_WG = 2;
    constexpr int NIT = IT_WIN + IT_WOUT + IT_MOD + IT_HDN + IT_WG;
    bool s_loaded = false;
    for (int it = blockIdx.x; it < NIT; it += G) {
        int r = it;
        if (r < IT_WIN + IT_WOUT) {
            const float* W; bf16_t* WT; int N, kb, nb, srccol;
            if (r < IT_WIN) { const int l = r / (16 * 72); r %= 16 * 72; kb = r / 72; nb = r % 72; N = DIN;
                W = a.in[8] + (size_t)l * DM * DIN; WT = (bf16_t*)(a.ws + WS_WINT) + (size_t)l * NPK * DM; srccol = nb * 64 + (nb >= 40 ? 16 : 0); }
            else { r -= IT_WIN; const int l = r / 256; r %= 256; kb = r / 16; nb = r % 16; N = DM;
                W = a.in[22] + (size_t)l * DM * DM; WT = (bf16_t*)(a.ws + WS_WOUTT) + (size_t)l * DM * DM; srccol = nb * 64; }
            __syncthreads();
#pragma unroll
            for (int i = 0; i < 8; ++i) { const int e = tid + i * 512, kk = e >> 6, nn = e & 63; scr[kk * 65 + nn] = W[(size_t)(kb * 64 + kk) * N + srccol + nn]; }
            __syncthreads();
            { const int nn = tid >> 3, k8 = (tid & 7) * 8; u32x4 o;
              o.x = pk2(scr[(k8 + 0) * 65 + nn], scr[(k8 + 1) * 65 + nn]); o.y = pk2(scr[(k8 + 2) * 65 + nn], scr[(k8 + 3) * 65 + nn]);
              o.z = pk2(scr[(k8 + 4) * 65 + nn], scr[(k8 + 5) * 65 + nn]); o.w = pk2(scr[(k8 + 6) * 65 + nn], scr[(k8 + 7) * 65 + nn]);
              *(u32x4*)(WT + (size_t)(nb * 64 + nn) * DM + kb * 64 + k8) = o; }
            continue;
        }
        r -= IT_WIN + IT_WOUT;
        if (r < IT_MOD) {
            const int l = r / 48, cb = r % 48;
            float* S = scr + 8192;
            float* P = scr;
            __syncthreads();
            if (!s_loaded) {
                for (int i = tid; i < 9 * 1024; i += 512) { const int v = i >> 10, k = i & 1023; const float cv = (v < 8) ? a.in[1][v * 1024 + k] : a.in[3][k]; S[i] = silu_f(cv); }
                s_loaded = true;
            }
            __syncthreads();
            const int kg = tid >> 6, col = cb * 64 + (tid & 63);
            const float* W = a.in[4] + (size_t)l * DM * 3072;
            float acc[9];
#pragma unroll
            for (int v = 0; v < 9; ++v) acc[v] = 0.f;
            for (int k = kg * 128; k < kg * 128 + 128; ++k) { const float w = W[(size_t)k * 3072 + col];
#pragma unroll
                for (int v = 0; v < 9; ++v) acc[v] += S[v * 1024 + k] * w; }
#pragma unroll
            for (int v = 0; v < 9; ++v) P[(kg * 9 + v) * 64 + (tid & 63)] = acc[v];
            __syncthreads();
            for (int i = tid; i < 9 * 64; i += 512) { const int v = i >> 6, cc = i & 63; float s = a.in[5][l * 3072 + cb * 64 + cc];
#pragma unroll
                for (int g = 0; g < 8; ++g) s += P[(g * 9 + v) * 64 + cc];
                ((float*)(a.ws + WS_MOD))[(size_t)(l * 9 + v) * 3072 + cb * 64 + cc] = s; }
            continue;
        }
        r -= IT_MOD;
        if (r >= IT_HDN) {
            const int l = r - IT_HDN; const float* w = a.in[8] + (size_t)l * DM * DIN; bf16_t* wg = (bf16_t*)(a.ws + WS_WGT) + (size_t)l * 16 * 1024;
            for (int i = tid; i < 16384; i += 512) wg[(i & 15) * 1024 + (i >> 4)] = (bf16_t)f2bf(w[(size_t)(i >> 4) * DIN + 2560 + (i & 15)]);
            continue;
        }
        {
            __syncthreads();
            float* W1 = scr;
            float* W2 = scr + 17 * 64;
            float* B1 = W2 + 64 * 64; float* B2 = B1 + 64; float* F0 = B2 + 64; float* F1 = F0 + 64;
            float* FT = F1 + 64;
            float* H1 = FT + 8 * 17;
            const int lb = ((r * 64) < 8192) ? ((r * 64) >> 12) : 0;
            for (int i = tid; i < 17 * 64; i += 512) W1[i] = a.in[15][lb * 17 * 64 + i];
            for (int i = tid; i < 64 * 64; i += 512) W2[i] = a.in[18][lb * 64 * 64 + i];
            if (tid < 64) { B1[tid] = a.in[16][lb * 64 + tid]; B2[tid] = a.in[19][lb * 64 + tid]; F0[tid] = a.in[17][lb * 128 + tid]; F1[tid] = a.in[17][lb * 128 + 64 + tid]; }
            const int j = tid & 63, pg = tid >> 6;
            for (int sub = 0; sub < 8; ++sub) {
                const int p = r * 64 + sub * 8 + pg;
                const int L = (p < 8192) ? 4096 : 256; const int pos = (p < 8192) ? (p & 4095) : (p - 8192);
                __syncthreads();
                if (j < 17) { float f;
                    if (j == 0) f = (float)pos / (float)L;
                    else { const int bnd = (j <= 8) ? j : j - 8; const float ang = (6.283185307179586f / (float)L) * (float)pos * (float)bnd; f = (j <= 8) ? sinf(ang) : cosf(ang); }
                    FT[pg * 17 + j] = f; }
                __syncthreads();
                { float s = B1[j];
#pragma unroll
                  for (int f = 0; f < 17; ++f) s += FT[pg * 17 + f] * W1[f * 64 + j];
                  H1[pg * 64 + j] = sinf(F0[j] * s); }
                __syncthreads();
                { float s = B2[j];
#pragma unroll 8
                  for (int i = 0; i < 64; ++i) s += H1[pg * 64 + i] * W2[i * 64 + j];
                  float* dst = (p < 8192) ? (float*)(a.ws + WS_HDN) + (size_t)p * 64 : (float*)(a.ws + WS_HDNC) + (size_t)pos * 64;
                  dst[j] = sinf(F1[j] * s); }
            }
        }
    }
    __syncthreads();
}

__device__ __forceinline__ void phase_norm(const Args& a, int l, bool has_prev, bool do_next, unsigned char* lds) {
    const int tid = opaque_tid(), G = gridDim.x, lane = tid & 63, wave = tid >> 6;
    float* Wg = (float*)lds;
    __syncthreads();
#if NAIVE_MLSTM
    if (do_next) { const float* w = a.in[8] + (size_t)l * DM * DIN; for (int i = tid; i < 16384; i += 512) Wg[(i & 15) * 1024 + (i >> 4)] = w[(size_t)(i >> 4) * DIN + 2560 + (i & 15)]; }
#endif
    __syncthreads();
    const float* MOD = (const float*)(a.ws + WS_MOD);
    const bf16_t* Y = (const bf16_t*)(a.ws + WS_U1);
    bf16_t* HB = (bf16_t*)(a.ws + WS_HB);
    float* GATES = (float*)(a.ws + WS_GATES);
    float* XC1 = (float*)(a.ws + WS_XC1);
    const int nrows = do_next ? MT : MLAT;
    for (int row = blockIdx.x * 8 + wave; row < nrows; row += G * 8) {
        const bool is_ctx = row >= MLAT; const int mv = is_ctx ? 8 : (row >> 12);
        const float* xin; float* xout;
        if (l == 0 || (has_prev && l == 1)) xin = is_ctx ? a.in[2] + (size_t)(row - MLAT) * DM : a.in[0] + (size_t)row * DM;
        else xin = a.out + (size_t)row * DM;
        xout = is_ctx ? XC1 + (size_t)(row - MLAT) * DM : a.out + (size_t)row * DM;
        f32x4 xv[4];
#pragma unroll
        for (int j = 0; j < 4; ++j) xv[j] = ((const f32x4*)xin)[lane + 64 * j];
        if (has_prev) {
            const int lp = l - 1;
            f32x4 yv[4]; float ss = 0.f;
#pragma unroll
            for (int j = 0; j < 4; ++j) { const u32x2 yr = ((const u32x2*)(Y + (size_t)row * DM))[lane + 64 * j]; yv[j] = (f32x4){bflo(yr.x), bfhi(yr.x), bflo(yr.y), bfhi(yr.y)}; ss += yv[j].x * yv[j].x + yv[j].y * yv[j].y + yv[j].z * yv[j].z + yv[j].w * yv[j].w; }
            const float r = rsqrtf(wave_sum(ss) * (1.f / DM) + RMS_EPS);
#pragma unroll
            for (int j = 0; j < 4; ++j) { const f32x4 gt = ((const f32x4*)(MOD + (size_t)(lp * 9 + mv) * 3072 + 2048))[lane + 64 * j]; const f32x4 pg = ((const f32x4*)(a.in[7] + lp * DM))[lane + 64 * j];
                xv[j] = xv[j] + gt * (yv[j] * r * pg); ((f32x4*)xout)[lane + 64 * j] = xv[j]; }
        }
        if (do_next) {
            float ss = 0.f;
#pragma unroll
            for (int j = 0; j < 4; ++j) ss += xv[j].x * xv[j].x + xv[j].y * xv[j].y + xv[j].z * xv[j].z + xv[j].w * xv[j].w;
            const float r = rsqrtf(wave_sum(ss) * (1.f / DM) + RMS_EPS);
#if NAIVE_MLSTM
            float ga[16];
#pragma unroll
            for (int g = 0; g < 16; ++g) ga[g] = 0.f;
#endif
#pragma unroll
            for (int j = 0; j < 4; ++j) {
                const f32x4 pg = ((const f32x4*)(a.in[6] + l * DM))[lane + 64 * j];
                const f32x4 sh = ((const f32x4*)(MOD + (size_t)(l * 9 + mv) * 3072))[lane + 64 * j];
                const f32x4 sc = ((const f32x4*)(MOD + (size_t)(l * 9 + mv) * 3072 + 1024))[lane + 64 * j];
                const f32x4 h = xv[j] * r * pg * (sc + 1.f) + sh;
                u32x2 o; o.x = pk2(h.x, h.y); o.y = pk2(h.z, h.w);
                ((u32x2*)(HB + (size_t)row * DM))[lane + 64 * j] = o;
#if NAIVE_MLSTM
#pragma unroll
                for (int g = 0; g < 16; ++g) { const f32x4 wv = ((const f32x4*)(Wg + g * 1024))[lane + 64 * j]; ga[g] += h.x * wv.x + h.y * wv.y + h.z * wv.z + h.w * wv.w; if ((g & 3) == 3) asm volatile("" ::: "memory"); }
#endif
            }
#if NAIVE_MLSTM
#pragma unroll
            for (int g = 0; g < 16; ++g) ga[g] = wave_sum(ga[g]);
            float mine = 0.f;
#pragma unroll
            for (int g = 0; g < 16; ++g) mine = (lane == g) ? ga[g] : mine;
            if (lane < 16) GATES[(size_t)row * 16 + lane] = mine + a.in[9][l * 16 + lane];
#endif
        }
    }
    __syncthreads();
}

__device__ __forceinline__ void gemm_naive(const bf16_t* A, const bf16_t* Bt, int M, int N, int K, void* out, int ldo, int mode, unsigned char* lds) {
    const int tid = opaque_tid(), G = gridDim.x;
    float* As = (float*)lds;
    float* Bs = As + 64 * 33;
    const int ntm = M / 64, ntn = N / 64;
    const int ty = tid >> 4, tx = tid & 15;
    for (int t = blockIdx.x; t < ntm * ntn; t += G) {
        const int tm = t / ntn, tn = t % ntn;
        float acc[2][4] = {};
        for (int k0 = 0; k0 < K; k0 += 32) {
            __syncthreads();
            { const int r = tid >> 3, c4 = (tid & 7) * 4;
              const u32x2 va = *(const u32x2*)(A + (size_t)(tm * 64 + r) * K + k0 + c4);
              As[r * 33 + c4] = bf2f(va.x & 0xffff); As[r * 33 + c4 + 1] = bf2f(va.x >> 16); As[r * 33 + c4 + 2] = bf2f(va.y & 0xffff); As[r * 33 + c4 + 3] = bf2f(va.y >> 16);
              const u32x2 vb = *(const u32x2*)(Bt + (size_t)(tn * 64 + r) * K + k0 + c4);
              Bs[r * 33 + c4] = bf2f(vb.x & 0xffff); Bs[r * 33 + c4 + 1] = bf2f(vb.x >> 16); Bs[r * 33 + c4 + 2] = bf2f(vb.y & 0xffff); Bs[r * 33 + c4 + 3] = bf2f(vb.y >> 16); }
            __syncthreads();
#pragma unroll 8
            for (int kk = 0; kk < 32; ++kk) {
                const float a0 = As[(ty * 2) * 33 + kk], a1 = As[(ty * 2 + 1) * 33 + kk];
#pragma unroll
                for (int j = 0; j < 4; ++j) { const float b = Bs[(tx * 4 + j) * 33 + kk]; acc[0][j] += a0 * b; acc[1][j] += a1 * b; }
            }
        }
#pragma unroll
        for (int i = 0; i < 2; ++i)
#pragma unroll
            for (int j = 0; j < 4; ++j) { const size_t r = tm * 64 + ty * 2 + i, c = tn * 64 + tx * 4 + j;
                if (mode == 0) ((bf16_t*)out)[r * ldo + c] = (bf16_t)f2bf(acc[i][j]);
                else if (mode == 1) ((bf16_t*)out)[c * ldo + r] = (bf16_t)f2bf(acc[i][j]);
                else ((float*)out)[r * ldo + c] = acc[i][j]; }
    }
    __syncthreads();
}


namespace pg8 {
#define PG8_LAS __attribute__((address_space(3)))
typedef short bf16x8 __attribute__((ext_vector_type(8)));
constexpr int BM = 256, BK = 64, HALF = 128, HTB = HALF * BK * 2, STAGE_BYTES = 8 * HTB, NXCD = 8, WGM = 8;
__device__ __forceinline__ int lds_byte(int r, int c) { const int st = (r >> 4) * 2 + (c >> 5), rr = r & 15, cc = c & 31, ob = rr * 64 + cc * 2; return st * 1024 + (ob ^ (((ob >> 9) & 1) << 5)); }
__device__ __forceinline__ void stage_rc(int b, int& R, int& C) { const int st = b / 1024, sb = b % 1024, swz = sb ^ (((sb >> 9) & 1) << 5); R = (st >> 1) * 16 + swz / 64; C = (st & 1) * 32 + (swz % 64) / 2; }
__device__ __forceinline__ int perm32(int rho) { const int n = rho >> 4, i = rho & 15; return 8 * (i >> 2) + 4 * n + (i & 3); }
__device__ __forceinline__ unsigned cvt_pk_bf16(float lo, float hi) { unsigned r; asm volatile("v_cvt_pk_bf16_f32 %0, %1, %2" : "=v"(r) : "v"(lo), "v"(hi)); return r; }

struct Unit { const char* A; const char* B; char* out; int ldo, r0, c0, bjs; };

template <class Dec> struct GridOrder {
    int nM, nN, nwg, G, c; Dec dec;
    __device__ void init(int nM_, int nN_, int G_, int c_, const Dec& d) { nM = nM_; nN = nN_; nwg = nM * nN; G = G_; c = c_; dec = d; }
    __device__ bool next(int i, Unit& u) const {
        const long L = (long)i * G + c; if (L >= nwg) return false;
        int wgid = (int)L; { const int q = nwg / NXCD, r = nwg % NXCD, xcd = wgid % NXCD, off = wgid / NXCD; wgid = (xcd < r ? xcd * (q + 1) : r * (q + 1) + (xcd - r) * q) + off; }
        const int nig = WGM * nN, gid = wgid / nig, fm = gid * WGM, gsz = (nM - fm) < WGM ? (nM - fm) : WGM;
        const int pm = fm + ((wgid % nig) % gsz), pn = (wgid % nig) / gsz; dec(pm, pn, u); return true;
    }
};

template <bool PERM, class Sched>
__device__ __forceinline__ void gemm_phase(PG8_LAS unsigned char* lds, const int K, const Sched& S) {
    const int tid = opaque_tid(), wid = __builtin_amdgcn_readfirstlane(tid >> 6), lane = tid & 63, wr = wid >> 2, wc = wid & 3, fr = lane & 15, fq = lane >> 4;
    const int nt = K / BK;
    unsigned voffA[2], voffB[2];
#pragma unroll
    for (int i = 0; i < 2; ++i) { int R, C; stage_rc(tid * 16 + i * 8192, R, C); const int Rb = PERM ? ((R & ~31) + perm32(R & 31)) : R;
        voffA[i] = (unsigned)(R * K + C) * 2u; voffB[i] = (unsigned)(Rb * K + C) * 2u; }
    const size_t kstep = (size_t)(BK * 2);
    const size_t hstep = (size_t)HALF * K * 2;
    const unsigned ldsw = (unsigned)wid * 1024u;
    const int aoff = lds_byte(wr * 64 + fr, fq * 8), boff = lds_byte(wc * 32 + fr, fq * 8);
#define PG8_SA(b, h) (((b) * 2 + (h)) * HTB)
#define PG8_SB(b, h) ((4 + (b) * 2 + (h)) * HTB)
#define PG8_STAGE(bufoff, gbase, voff) do { _Pragma("unroll") for (int _i = 0; _i < 2; ++_i) \
        __builtin_amdgcn_global_load_lds((const unsigned*)((const char*)(gbase) + (voff)[_i]), (PG8_LAS unsigned*)(lds + (bufoff) + ldsw + _i * 8192), 16, 0, 0); } while (0)
#define PG8_LDA(dst, b, h) do { _Pragma("unroll") for (int m = 0; m < 4; ++m) _Pragma("unroll") for (int k = 0; k < 2; ++k) dst[m][k] = *(const PG8_LAS bf16x8*)(lds + PG8_SA(b, h) + aoff + m * 2048 + k * 1024); } while (0)
#define PG8_LDB(dst, b, h) do { _Pragma("unroll") for (int n = 0; n < 2; ++n) _Pragma("unroll") for (int k = 0; k < 2; ++k) dst[n][k] = *(const PG8_LAS bf16x8*)(lds + PG8_SB(b, h) + boff + n * 2048 + k * 1024); } while (0)
#define PG8_MMA(ai, bj, At, Bt) do { __builtin_amdgcn_s_setprio(1); _Pragma("unroll") for (int m = 0; m < 4; ++m) _Pragma("unroll") for (int n = 0; n < 2; ++n) _Pragma("unroll") for (int k = 0; k < 2; ++k) \
        acc[ai][bj][m][n] = __builtin_amdgcn_mfma_f32_16x16x32_bf16(Bt[n][k], At[m][k], acc[ai][bj][m][n], 0, 0, 0); __builtin_amdgcn_s_setprio(0); } while (0)
#define PG8_WAIT_V(n) asm volatile("s_waitcnt vmcnt(" #n ")" ::: "memory")
#define PG8_WAIT_L(n) asm volatile("s_waitcnt lgkmcnt(" #n ")" ::: "memory")
#define PG8_BAR __builtin_amdgcn_s_barrier()
#define PG8_SCHED __builtin_amdgcn_sched_barrier(0)
    Unit cur, nxt; int ui = 0;
    if (!S.next(0, cur)) return;
    f32x4 acc[2][2][4][2];
#pragma unroll
    for (int a = 0; a < 2; ++a)
#pragma unroll
        for (int b = 0; b < 2; ++b)
#pragma unroll
            for (int m = 0; m < 4; ++m)
#pragma unroll
                for (int n = 0; n < 2; ++n) acc[a][b][m][n] = (f32x4){0.f, 0.f, 0.f, 0.f};
    bf16x8 At[4][2], B0[2][2], B1[2][2];
    const char* cA = cur.A; const char* cB = cur.B;
    PG8_STAGE(PG8_SB(0, 0), cB, voffB); PG8_STAGE(PG8_SA(0, 0), cA, voffA); PG8_STAGE(PG8_SB(0, 1), cB + hstep, voffB); PG8_STAGE(PG8_SA(0, 1), cA + hstep, voffA);
    if (wr == 1) PG8_BAR;
    PG8_WAIT_V(4); PG8_BAR;
    PG8_STAGE(PG8_SB(1, 0), cB + kstep, voffB); PG8_STAGE(PG8_SA(1, 0), cA + kstep, voffA); PG8_STAGE(PG8_SB(1, 1), cB + hstep + kstep, voffB);
    PG8_WAIT_V(6); PG8_BAR;
    for (;;) {
        const bool has_next = S.next(ui + 1, nxt);
        const char* nA = has_next ? nxt.A : cA; const char* nB = has_next ? nxt.B : cB;
        for (int t = 0; t < nt; t += 2) {
            const bool last = (t == nt - 2);
            const char* a1 = cA + (size_t)(t + 1) * kstep;
            const char* a2 = last ? nA : cA + (size_t)(t + 2) * kstep; const char* b2 = last ? nB : cB + (size_t)(t + 2) * kstep;
            const char* a3 = a2 + kstep; const char* b3 = b2 + kstep;
            PG8_LDB(B0, 0, 0); PG8_SCHED; PG8_LDA(At, 0, 0); PG8_STAGE(PG8_SA(1, 1), a1 + hstep, voffA);
            PG8_WAIT_L(8); PG8_BAR; PG8_WAIT_L(0); PG8_MMA(0, 0, At, B0); PG8_BAR; PG8_SCHED;
            PG8_LDB(B1, 0, 1); PG8_STAGE(PG8_SB(0, 0), b2, voffB);
            PG8_BAR; PG8_WAIT_L(0); PG8_MMA(0, 1, At, B1); PG8_BAR;
            PG8_LDA(At, 0, 1); PG8_STAGE(PG8_SA(0, 0), a2, voffA);
            PG8_BAR; PG8_WAIT_L(0); PG8_MMA(1, 0, At, B0); PG8_BAR; PG8_SCHED;
            PG8_STAGE(PG8_SB(0, 1), b2 + hstep, voffB);
            PG8_WAIT_V(6); PG8_BAR; PG8_MMA(1, 1, At, B1); PG8_BAR;
            PG8_LDB(B0, 1, 0); PG8_SCHED; PG8_LDA(At, 1, 0); PG8_STAGE(PG8_SA(0, 1), a2 + hstep, voffA);
            PG8_WAIT_L(8); PG8_BAR; PG8_WAIT_L(0); PG8_MMA(0, 0, At, B0); PG8_BAR; PG8_SCHED;
            PG8_LDB(B1, 1, 1); PG8_STAGE(PG8_SB(1, 0), b3, voffB);
            PG8_BAR; PG8_WAIT_L(0); PG8_MMA(0, 1, At, B1); PG8_BAR;
            PG8_LDA(At, 1, 1); PG8_STAGE(PG8_SA(1, 0), a3, voffA);
            PG8_BAR; PG8_WAIT_L(0); PG8_MMA(1, 0, At, B0); PG8_BAR; PG8_SCHED;
            PG8_STAGE(PG8_SB(1, 1), b3 + hstep, voffB);
            PG8_WAIT_V(6); PG8_BAR; PG8_MMA(1, 1, At, B1); PG8_BAR;
        }
        {
            const int row0 = cur.r0 + wr * 64 + fr;
            if (PERM) {
                bf16_t* base = (bf16_t*)cur.out; const int col0 = cur.c0 + wc * 32 + 8 * fq;
#pragma unroll
                for (int ai = 0; ai < 2; ++ai)
#pragma unroll
                    for (int m = 0; m < 4; ++m) { bf16_t* rowp = base + (size_t)(row0 + ai * HALF + m * 16) * cur.ldo + col0;
#pragma unroll
                        for (int bj = 0; bj < 2; ++bj) { const f32x4 v0 = acc[ai][bj][m][0], v1 = acc[ai][bj][m][1];
                            u32x4 w; w.x = cvt_pk_bf16(v0[0], v0[1]); w.y = cvt_pk_bf16(v0[2], v0[3]); w.z = cvt_pk_bf16(v1[0], v1[1]); w.w = cvt_pk_bf16(v1[2], v1[3]);
                            *(u32x4*)(rowp + bj * cur.bjs) = w; } }
            } else {
                float* base = (float*)cur.out; const int col0 = cur.c0 + wc * 32 + 4 * fq;
#pragma unroll
                for (int ai = 0; ai < 2; ++ai)
#pragma unroll
                    for (int m = 0; m < 4; ++m) { float* rowp = base + (size_t)(row0 + ai * HALF + m * 16) * cur.ldo + col0;
#pragma unroll
                        for (int bj = 0; bj < 2; ++bj)
#pragma unroll
                            for (int n = 0; n < 2; ++n) *(f32x4*)(rowp + bj * cur.bjs + n * 16) = acc[ai][bj][m][n]; }
            }
        }
        if (!has_next) break;
#pragma unroll
        for (int a = 0; a < 2; ++a)
#pragma unroll
            for (int b = 0; b < 2; ++b)
#pragma unroll
                for (int m = 0; m < 4; ++m)
#pragma unroll
                    for (int n = 0; n < 2; ++n) acc[a][b][m][n] = (f32x4){0.f, 0.f, 0.f, 0.f};
        cur = nxt; cA = nA; cB = nB; ++ui;
    }
    PG8_WAIT_V(0);
    if (wr == 0) PG8_BAR;
    PG8_BAR;
#undef PG8_SA
#undef PG8_SB
#undef PG8_STAGE
#undef PG8_LDA
#undef PG8_LDB
#undef PG8_MMA
#undef PG8_WAIT_V
#undef PG8_WAIT_L
#undef PG8_BAR
#undef PG8_SCHED
}
}

struct DecIn {
    const char* HB; const char* W; char* U1; char* UT;
    __device__ void operator()(int pm, int pn, pg8::Unit& u) const {
        const char* tp = HB + (size_t)pm * 256 * DM * 2; const char* wp = W + (size_t)pn * 256 * DM * 2;
        u.bjs = 128;
        if (pn < 4) { u.A = tp; u.B = wp; u.out = U1; u.ldo = LDU1; u.r0 = pm * 256; u.c0 = pn * 256; }
        else if (pn < 6) {
            const int bb = pm < 128 ? pm >> 4 : pm - 128, srow0 = pm < 128 ? LCTX + (pm & 15) * 256 : 0;
            u.A = tp; u.B = wp; u.out = U1 + (WS_V2 - WS_U1) + ((size_t)(bb * 4 + 2 * (pn - 4)) * (LCTX + LSEQ) + srow0) * 128 * 2; u.ldo = 128; u.r0 = 0; u.c0 = 0; u.bjs = (LCTX + LSEQ) * 128; }
        else if (pn < 10) { u.A = tp; u.B = wp; u.out = U1; u.ldo = LDU1; u.r0 = pm * 256; u.c0 = (pn - 2) * 256; }
        else { u.A = wp; u.B = tp; u.out = UT; u.ldo = MT; u.r0 = (pn - 10) * 256; u.c0 = pm * 256; }
    }
};
struct DecOut {
    const char* YM; const char* W; char* Y;
    __device__ void operator()(int pm, int pn, pg8::Unit& u) const {
        u.A = YM + (size_t)pm * 256 * DM * 2; u.B = W + (size_t)pn * 256 * DM * 2; u.out = Y; u.ldo = DM; u.r0 = pm * 256; u.c0 = pn * 256; u.bjs = 128;
    }
};

__device__ __forceinline__ void mlstm_naive(const Args& a, int l, unsigned char* lds) {
    const int tid = opaque_tid(), G = gridDim.x;
    const bf16_t* U1 = (const bf16_t*)(a.ws + WS_U1);
    const float* GATES = (const float*)(a.ws + WS_GATES);
    bf16_t* HDo = (bf16_t*)(a.ws + WS_HB);
    float* qs = (float*)lds; float* ks = qs + 128; float* vs = ks + 128; float* sc = vs + 32;
    float* pnum = sc + 8;
    float* pden = pnum + 512;
    const float* cw = a.in[10] + (size_t)l * 3 * 1024; const float* cb = a.in[11] + (size_t)l * 1024;
    for (int it = blockIdx.x; it < 256; it += G) {
        const int dvs = it & 3, dir = (it >> 2) & 1, hh = (it >> 3) & 3, b = it >> 5;
        float C[8], nn[8];
#pragma unroll
        for (int i = 0; i < 8; ++i) { C[i] = 0.f; nn[i] = 0.f; }
        float m = 0.f;
        const int j = tid & 31, dg = tid >> 5;
        for (int step = 0; step < LCTX + LSEQ; ++step) {
            int seqlen, tt, rowbase; bool is_ctx = step < LCTX;
            if (is_ctx) { seqlen = LCTX; tt = dir ? (LCTX - 1 - step) : step; rowbase = MLAT + b * LCTX; }
            else { seqlen = LSEQ; const int s2 = step - LCTX; tt = dir ? (LSEQ - 1 - s2) : s2; rowbase = b * LSEQ; }
            const int row = rowbase + tt;
            if (tid < 256) {
                const int ch = (tid < 128) ? (hh * 128 + tid) : (512 + hh * 128 + (tid - 128));
                bool has_l, has_r;
                if (is_ctx) { has_l = tt > 0; has_r = tt < seqlen - 1; } else { has_l = (tt & 63) != 0; has_r = (tt & 63) != 63; }
                float v = bf2f(U1[(size_t)row * NU1 + ch]) * cw[1024 + ch] + cb[ch];
                if (has_l) v += bf2f(U1[(size_t)(row - 1) * NU1 + ch]) * cw[ch];
                if (has_r) v += bf2f(U1[(size_t)(row + 1) * NU1 + ch]) * cw[2048 + ch];
                v = silu_f(v);
                if (tid < 128) qs[tid] = v; else ks[tid - 128] = v * 0.08838834764831845f;
            } else if (tid < 288) {
                vs[tid - 256] = bf2f(U1[(size_t)row * NU1 + 1024 + hh * 128 + dvs * 32 + (tid - 256)]);
            } else if (tid == 288) {
                const float ip = GATES[(size_t)row * 16 + (2 * dir) * 4 + hh], fp = GATES[(size_t)row * 16 + (2 * dir + 1) * 4 + hh];
                const float logf = fminf(fp, 0.f) - log1pf(__expf(-fabsf(fp)));
                const float mn = fmaxf(logf + m, ip);
                sc[0] = __expf(logf + m - mn); sc[1] = __expf(ip - mn); sc[2] = __expf(-mn);
                m = mn;
            }
            __syncthreads();
            const float fw = sc[0], iw = sc[1];
            float pn = 0.f, pd = 0.f;
#pragma unroll
            for (int dd = 0; dd < 8; ++dd) { const int d = dg * 8 + dd; const float kk = ks[d], qq = qs[d];
                C[dd] = fw * C[dd] + iw * kk * vs[j]; nn[dd] = fw * nn[dd] + iw * kk; pn += qq * C[dd]; pd += qq * nn[dd]; }
            pnum[dg * 32 + j] = pn; if (j == 0) pden[dg] = pd;
            __syncthreads();
            if (tid < 32) { float num = 0.f, den = 0.f;
#pragma unroll
                for (int g = 0; g < 16; ++g) { num += pnum[g * 32 + tid]; den += pden[g]; }
                const float h = num / fmaxf(fabsf(den), sc[2]);
                HDo[((size_t)dir * MT + row) * DML + hh * 128 + dvs * 32 + tid] = (bf16_t)f2bf(h); }
        }
        __syncthreads();
    }
}


#define LAS __attribute__((address_space(3)))
typedef short bf16x8 __attribute__((ext_vector_type(8)));
__device__ __forceinline__ u32x4 ldg16_or_zero(const bf16_t* p, bool ok) { u32x4 z = {0u, 0u, 0u, 0u}; return ok ? *(const u32x4*)p : z; }


__device__ __forceinline__ void filt_item(const Args& a, int l, unsigned char* lds_, int fi);
__device__ __forceinline__ void phase_mprep(const Args& a, int l, unsigned char* lds_, int rep) {
    const int tid = opaque_tid(), lane = tid & 63, wave = __builtin_amdgcn_readfirstlane(tid >> 6), fr = lane & 15, fq = lane >> 4;
    LAS float* P = (LAS float*)lds_;
    LAS float* Gs = P + 2048;
    LAS bf16_t* WgS = (LAS bf16_t*)((LAS unsigned char*)lds_ + 32768);
    LAS unsigned* qslot = (LAS unsigned*)((LAS unsigned char*)lds_ + (LDS_BYTES - 32));
    const bf16_t* U1 = (const bf16_t*)(a.ws + WS_U1);
    const bf16_t* HB = (const bf16_t*)(a.ws + WS_HB);
    const bf16_t* WgT = (const bf16_t*)(a.ws + WS_WGT) + (size_t)l * 16 * 1024;
    bf16_t* QK = (bf16_t*)(a.ws + WS_YMIX);
    float* GP = (float*)(a.ws + WS_GP);
    const float* cw = a.in[10] + (size_t)l * 3072; const float* cb = a.in[11] + (size_t)l * 1024;
    unsigned* ctr = (unsigned*)(a.ws + WS_CTL) + CW_QUEUE + 64 * (16 + l * 8 + rep);
    const int co = tid & 127, rg4 = tid >> 7;
    __syncthreads();
    for (int i = tid; i < 16 * 128; i += NTHR) { const int g = i >> 7, c8 = (i & 127) * 8; *(LAS u32x4*)(WgS + g * 1032 + c8) = *(const u32x4*)(WgT + g * 1024 + c8); }
    for (;;) {
        __syncthreads();
        if (tid == 0) *qslot = __hip_atomic_fetch_add(ctr, 1u, __ATOMIC_RELAXED, __HIP_MEMORY_SCOPE_AGENT);
        __syncthreads();
        const int item = (int)*qslot;
        if (item >= 128 + MT / 64) break;
        if (item < 128) { filt_item(a, l, lds_, item); continue; }
        const int ch = item - 128;
        const int rowbase = ch * 64;
        const bool is_ctx = rowbase >= MLAT; const int cc = is_ctx ? ((rowbase - MLAT) >> 6) & 3 : 0;
        const bool has_lo = is_ctx && cc > 0, has_hi = is_ctx && cc < 3;
        {
            const int rt = wave & 3, kh = wave >> 2;
            f32x4 acc = {0.f, 0.f, 0.f, 0.f};
            const bf16_t* ap = HB + (size_t)(rowbase + rt * 16 + fr) * DM + kh * 512 + fq * 8;
            LAS const bf16_t* bp = WgS + fr * 1032 + kh * 512 + fq * 8;
            bf16x8 af[16];
#pragma unroll
            for (int ks = 0; ks < 16; ++ks) af[ks] = *(const bf16x8*)(ap + ks * 32);
#pragma unroll
            for (int ks = 0; ks < 16; ++ks) { const bf16x8 bf = *(const LAS bf16x8*)(bp + ks * 32); acc = __builtin_amdgcn_mfma_f32_16x16x32_bf16(af[ks], bf, acc, 0, 0, 0); }
#pragma unroll
            for (int jj = 0; jj < 4; ++jj) P[(kh * 64 + rt * 16 + 4 * fq + jj) * 16 + fr] = acc[jj];
        }
        {
            float w0[8], w1[8], w2[8], bb[8];
#pragma unroll
            for (int e = 0; e < 8; ++e) { w0[e] = cw[co * 8 + e]; w1[e] = cw[1024 + co * 8 + e]; w2[e] = cw[2048 + co * 8 + e]; bb[e] = cb[co * 8 + e]; }
            u32x4 r0, r1, r2;
            { const int tt = rg4 * 16 - 1; r0 = ldg16_or_zero(U1 + (size_t)(rowbase + tt) * LDU1 + co * 8, tt >= 0 || has_lo); }
            r1 = *(const u32x4*)(U1 + (size_t)(rowbase + rg4 * 16) * LDU1 + co * 8);
            const int qb = is_ctx ? (rowbase - MLAT) >> 8 : rowbase >> 12, srow0 = is_ctx ? (rowbase - MLAT) & 255 : LCTX + (rowbase & 4095);
            unsigned char* qdst = (unsigned char*)QK + (size_t)(qb * 4 + ((co & 63) >> 4)) * QK8_STRIDE + (size_t)srow0 * 256 + (co >> 6) * 128 + (co & 15) * 8;
#pragma unroll 4
            for (int i = 0; i < 16; ++i) { const int tt = rg4 * 16 + i;
                r2 = ldg16_or_zero(U1 + (size_t)(rowbase + tt + 1) * LDU1 + co * 8, tt + 1 <= 63 || has_hi);
                float fv[8];
#pragma unroll
                for (int e2 = 0; e2 < 4; ++e2) {
                    fv[2 * e2] = silu_f(bflo(r0[e2]) * w0[2 * e2] + bflo(r1[e2]) * w1[2 * e2] + bflo(r2[e2]) * w2[2 * e2] + bb[2 * e2]);
                    fv[2 * e2 + 1] = silu_f(bfhi(r0[e2]) * w0[2 * e2 + 1] + bfhi(r1[e2]) * w1[2 * e2 + 1] + bfhi(r2[e2]) * w2[2 * e2 + 1] + bb[2 * e2 + 1]); }
                int p0 = 0, p1 = 0;
                p0 = __builtin_amdgcn_cvt_pk_fp8_f32(fv[0], fv[1], p0, false); p0 = __builtin_amdgcn_cvt_pk_fp8_f32(fv[2], fv[3], p0, true);
                p1 = __builtin_amdgcn_cvt_pk_fp8_f32(fv[4], fv[5], p1, false); p1 = __builtin_amdgcn_cvt_pk_fp8_f32(fv[6], fv[7], p1, true);
                *(u32x2*)(qdst + (size_t)tt * 256) = (u32x2){(unsigned)p0, (unsigned)p1};
                r0 = r1; r1 = r2; }
        }
        __syncthreads();
        for (int i = tid; i < 1024; i += NTHR) Gs[i] = P[i] + P[1024 + i] + a.in[9][l * 16 + (i & 15)];
        __syncthreads();
        {
            const int dir = wave >> 2, hh = wave & 3, tt = dir ? 63 - lane : lane;
            const float gi = Gs[tt * 16 + (2 * dir) * 4 + hh], gf = Gs[tt * 16 + (2 * dir + 1) * 4 + hh];
            const float logf = fminf(gf, 0.f) - log1pf(__expf(-fabsf(gf)));
            float bc = logf;
#pragma unroll
            for (int ofs = 1; ofs < 64; ofs <<= 1) { const float t = __shfl_up(bc, ofs); if (lane >= ofs) bc += t; }
            const float av = gi - bc;
            float cm = av;
#pragma unroll
            for (int ofs = 1; ofs < 64; ofs <<= 1) { const float t = __shfl_up(cm, ofs); if (lane >= ofs) cm = fmaxf(cm, t); }
            float* gp = GP + ((size_t)ch * 8 + wave) * 192;
            gp[lane] = bc; gp[64 + lane] = av; gp[128 + lane] = cm;
        }
    }
    __syncthreads();
}

__device__ __forceinline__ void dec16_fp8(const u32x4 raw, float (&f)[16]) {
#pragma unroll
    for (int e = 0; e < 4; ++e) { const f32x2 lo = __builtin_amdgcn_cvt_pk_f32_fp8((int)raw[e], false), hi = __builtin_amdgcn_cvt_pk_f32_fp8((int)raw[e], true);
        f[4 * e] = lo.x; f[4 * e + 1] = lo.y; f[4 * e + 2] = hi.x; f[4 * e + 3] = hi.y; }
}
__device__ __forceinline__ void mlstm_item(const Args& a, int l, unsigned char* lds_, int it, bool do_store) {
    const int tid = opaque_tid(), lane = tid & 63, wave = __builtin_amdgcn_readfirstlane(tid >> 6), fr = lane & 15, fq = lane >> 4;
    LAS unsigned char* lds = (LAS unsigned char*)lds_;
    LAS bf16_t* Qs = (LAS bf16_t*)(lds);
    LAS bf16_t* Ks = (LAS bf16_t*)(lds + 17408);
    LAS bf16_t* KTs = (LAS bf16_t*)(lds + 34816);
    LAS bf16_t* VTs = (LAS bf16_t*)(lds + 53248);
    LAS bf16_t* Ss = (LAS bf16_t*)(lds + 73984);
    LAS bf16_t* CTs = (LAS bf16_t*)(lds + 83200);
    LAS float* F = (LAS float*)(lds + 122368);
    LAS float* Aa = F; LAS float* Gg = F + 64; LAS float* WI = F + 128; LAS float* EM = F + 192;
    const unsigned char* QK8 = (const unsigned char*)(a.ws + WS_YMIX);
    const bf16_t* V2 = (const bf16_t*)(a.ws + WS_V2);
    const float* GP = (const float*)(a.ws + WS_GP);
    bf16_t* HDo = (bf16_t*)(a.ws + WS_HB);
    const int dir = it & 1, hh = (it >> 1) & 3, b = it >> 3;
    const int c16 = wave * 16;
    const int rpos = dir ? 63 - lane : lane;
    __syncthreads();
    for (int i = tid; i < 144 * 136 / 2; i += NTHR) ((LAS unsigned*)CTs)[i] = 0u;
    for (int i = tid; i < 16 * 72 / 2; i += NTHR) ((LAS unsigned*)(VTs + 128 * 72))[i] = (i < 36) ? 0x3f803f80u : 0u;
    f32x4 accC[9];
#pragma unroll
    for (int j = 0; j < 9; ++j) accC[j] = (f32x4){0.f, 0.f, 0.f, 0.f};
    float m_prev = 0.f;
    struct OpSet { u32x4 rq8, rk8, v0, v1; float ga, gbc, gav, gcm, g_bl, g_cm63; };
    auto chunk_rowbase = [&](int cs) -> int {
        const bool is_ctx = cs < 4; const int cc = is_ctx ? (dir ? 3 - cs : cs) : (dir ? 63 - (cs - 4) : cs - 4);
        return is_ctx ? MLAT + b * LCTX + cc * 64 : b * LSEQ + cc * 64; };
    auto prefetch = [&](int cs_, OpSet& o) {
        const int cs = cs_ < 68 ? cs_ : 67;
        const int rowbase = chunk_rowbase(cs);
        const int srow0 = (rowbase >= MLAT) ? (rowbase - MLAT) & 255 : LCTX + (rowbase & 4095);
        const unsigned char* qp = QK8 + (size_t)(b * 4 + hh) * QK8_STRIDE + (size_t)(srow0 + lane) * 256 + c16;
        o.rq8 = *(const u32x4*)qp; o.rk8 = *(const u32x4*)(qp + 128);
        const bf16_t* vp = V2 + ((size_t)(b * 4 + hh) * (LCTX + LSEQ) + srow0 + lane) * 128 + c16;
        o.v0 = *(const u32x4*)vp; o.v1 = *(const u32x4*)(vp + 8);
        const float* gp = GP + ((size_t)(rowbase >> 6) * 8 + dir * 4 + hh) * 192;
        o.g_bl = gp[63]; o.g_cm63 = gp[128 + 63]; o.ga = gp[64 + rpos];
        o.gbc = gp[lane]; o.gav = gp[64 + lane]; o.gcm = gp[128 + lane];
    };
    OpSet os0, os1, os2;
    prefetch(0, os0); prefetch(1, os1); prefetch(2, os2);
    __syncthreads();
    u32x2 hold[4]; int hold_row = -1;
#pragma unroll
    for (int j = 0; j < 4; ++j) hold[j] = (u32x2){0u, 0u};
    auto flush = [&]() {
        if (hold_row >= 0 && do_store) { bf16_t* op = HDo + (((size_t)dir * 32 + b * 4 + hh) * (LCTX + LSEQ) + hold_row) * 128 + (wave >> 2) * 64 + 4 * fq;
#pragma unroll
            for (int j = 0; j < 4; ++j) *(u32x2*)(op + j * 16) = hold[j]; } };
    auto step = [&](const int cs, OpSet& o) {
        const int rowbase = chunk_rowbase(cs);
        const u32x4 rq8 = o.rq8, rk8 = o.rk8; u32x4 vraw[2]; vraw[0] = o.v0; vraw[1] = o.v1;
        const float ga = o.ga, gbc = o.gbc, gav = o.gav, gcm = o.gcm, g_bl = o.g_bl, g_cm63 = o.g_cm63;
        const float g63 = fmaxf(m_prev, g_cm63), wc = __expf(m_prev - g63);
        {
            float f[16];
            dec16_fp8(rq8, f);
            { u32x4 w0, w1;
#pragma unroll
              for (int e = 0; e < 4; ++e) { w0[e] = pg8::cvt_pk_bf16(f[2 * e], f[2 * e + 1]); w1[e] = pg8::cvt_pk_bf16(f[8 + 2 * e], f[8 + 2 * e + 1]); }
              *(LAS u32x4*)(Qs + rpos * 136 + c16) = w0; *(LAS u32x4*)(Qs + rpos * 136 + c16 + 8) = w1; }
            dec16_fp8(rk8, f);
            { u32x4 w0, w1;
#pragma unroll
              for (int e = 0; e < 16; ++e) f[e] *= 0.08838834764831845f;
#pragma unroll
              for (int e = 0; e < 4; ++e) { w0[e] = pg8::cvt_pk_bf16(f[2 * e], f[2 * e + 1]); w1[e] = pg8::cvt_pk_bf16(f[8 + 2 * e], f[8 + 2 * e + 1]); }
              *(LAS u32x4*)(Ks + rpos * 136 + c16) = w0; *(LAS u32x4*)(Ks + rpos * 136 + c16 + 8) = w1;
              const float ws = __expf(ga - g63);
#pragma unroll
              for (int e = 0; e < 8; ++e) { const unsigned pw = pg8::cvt_pk_bf16(f[2 * e] * ws, f[2 * e + 1] * ws);
                  KTs[(c16 + 2 * e) * 72 + rpos] = (bf16_t)(pw & 0xffffu); KTs[(c16 + 2 * e + 1) * 72 + rpos] = (bf16_t)(pw >> 16); } }
#pragma unroll
            for (int h2 = 0; h2 < 2; ++h2)
#pragma unroll
                for (int e2 = 0; e2 < 4; ++e2) { VTs[(c16 + h2 * 8 + 2 * e2) * 72 + rpos] = (bf16_t)(vraw[h2][e2] & 0xffffu); VTs[(c16 + h2 * 8 + 2 * e2 + 1) * 72 + rpos] = (bf16_t)(vraw[h2][e2] >> 16); }
            if (wave == 7) { const float g = fmaxf(m_prev, gcm); Aa[lane] = gav; Gg[lane] = g; WI[lane] = __expf(m_prev - g); EM[lane] = __expf(-(gbc + g)); }
        }
        m_prev = g_bl + g63;
        flush();
        prefetch(cs + 3, o);
        __syncthreads();
        {
            const int tb = wave >> 1;
#pragma unroll
            for (int q2 = 0; q2 < 2; ++q2) {
                const int sb = (wave & 1) * 2 + q2;
                f32x4 acc = {0.f, 0.f, 0.f, 0.f};
                if (sb <= tb) {
                    bf16x8 kf[4], qf[4];
#pragma unroll
                    for (int ks = 0; ks < 4; ++ks) { kf[ks] = *(const LAS bf16x8*)(Ks + (sb * 16 + fr) * 136 + ks * 32 + fq * 8); qf[ks] = *(const LAS bf16x8*)(Qs + (tb * 16 + fr) * 136 + ks * 32 + fq * 8); }
#pragma unroll
                    for (int ks = 0; ks < 4; ++ks) acc = __builtin_amdgcn_mfma_f32_16x16x32_bf16(kf[ks], qf[ks], acc, 0, 0, 0);
                    const int t = tb * 16 + fr, s0 = sb * 16 + 4 * fq; const float g = Gg[t];
                    const f32x4 av = *(const LAS f32x4*)(Aa + s0);
#pragma unroll
                    for (int jj = 0; jj < 4; ++jj) acc[jj] = (s0 + jj <= t) ? acc[jj] * __expf(av[jj] - g) : 0.f;
                }
                u32x2 w; w.x = pg8::cvt_pk_bf16(acc[0], acc[1]); w.y = pg8::cvt_pk_bf16(acc[2], acc[3]);
                *(LAS u32x2*)(Ss + (tb * 16 + fr) * 72 + sb * 16 + 4 * fq) = w;
            }
        }
        __syncthreads();
        {
            const int tb = wave & 3, half = wave >> 2, t = tb * 16 + fr;
            f32x4 acc[5];
#pragma unroll
            for (int j = 0; j < 5; ++j) acc[j] = (f32x4){0.f, 0.f, 0.f, 0.f};
#pragma unroll
            for (int ks = 0; ks < 4; ++ks) {
                const bf16x8 qf = *(const LAS bf16x8*)(Qs + t * 136 + ks * 32 + fq * 8);
#pragma unroll
                for (int j = 0; j < 5; ++j) { const int jrow = (j < 4) ? (half * 4 + j) * 16 : 128;
                    const bf16x8 cf = *(const LAS bf16x8*)(CTs + (jrow + fr) * 136 + ks * 32 + fq * 8);
                    acc[j] = __builtin_amdgcn_mfma_f32_16x16x32_bf16(cf, qf, acc[j], 0, 0, 0); }
            }
            const float wi = WI[t];
#pragma unroll
            for (int j = 0; j < 5; ++j) acc[j] = acc[j] * wi;
#pragma unroll
            for (int ks = 0; ks < 2; ++ks) {
                const bf16x8 sf = *(const LAS bf16x8*)(Ss + t * 72 + ks * 32 + fq * 8);
#pragma unroll
                for (int j = 0; j < 5; ++j) { const int jrow = (j < 4) ? (half * 4 + j) * 16 : 128;
                    const bf16x8 vf = *(const LAS bf16x8*)(VTs + (jrow + fr) * 72 + ks * 32 + fq * 8);
                    acc[j] = __builtin_amdgcn_mfma_f32_16x16x32_bf16(vf, sf, acc[j], 0, 0, 0); }
            }
            const float den = __shfl(acc[4][0], fr);
            const float inv = 1.f / fmaxf(fabsf(den), EM[t]);
#pragma unroll
            for (int j = 0; j < 4; ++j) { hold[j].x = pg8::cvt_pk_bf16(acc[j][0] * inv, acc[j][1] * inv); hold[j].y = pg8::cvt_pk_bf16(acc[j][2] * inv, acc[j][3] * inv); }
            hold_row = ((rowbase >= MLAT) ? (rowbase - MLAT) & 255 : LCTX + (rowbase & 4095)) + (dir ? 63 - t : t);
            const int d0 = wave * 16;
#pragma unroll
            for (int j = 0; j < 9; ++j) accC[j] = accC[j] * wc;
#pragma unroll
            for (int ks = 0; ks < 2; ++ks) {
                const bf16x8 kf = *(const LAS bf16x8*)(KTs + (d0 + fr) * 72 + ks * 32 + fq * 8);
#pragma unroll
                for (int j = 0; j < 9; ++j) { const bf16x8 vf = *(const LAS bf16x8*)(VTs + (j * 16 + fr) * 72 + ks * 32 + fq * 8);
                    accC[j] = __builtin_amdgcn_mfma_f32_16x16x32_bf16(kf, vf, accC[j], 0, 0, 0); }
            }
        }
        __syncthreads();
        {
            const int d0 = wave * 16;
#pragma unroll
            for (int j = 0; j < 9; ++j) { u32x2 w; w.x = pg8::cvt_pk_bf16(accC[j][0], accC[j][1]); w.y = pg8::cvt_pk_bf16(accC[j][2], accC[j][3]);
                *(LAS u32x2*)(CTs + (j * 16 + fr) * 136 + d0 + 4 * fq) = w; }
        }
    };
#pragma unroll 1
    for (int cs = 0; cs < 66; cs += 3) { step(cs, os0); step(cs + 1, os1); step(cs + 2, os2); }
    step(66, os0); step(67, os1);
    flush();
    __syncthreads();
}

__device__ __forceinline__ float conv3_at(const bf16_t* rowp, int t, int seglen, float w0, float w1, float w2, float bias) {
    const int tl = t % seglen;
    float v = bf2f(rowp[t]) * w1 + bias;
    if (tl > 0) v += bf2f(rowp[t - 1]) * w0;
    if (tl < seglen - 1) v += bf2f(rowp[t + 1]) * w2;
    return v;
}
__device__ __forceinline__ void hyena_naive(const Args& a, int l, unsigned char* lds, int pass_lo, bool do_store) {
    const int tid = opaque_tid(), G = gridDim.x;
    bf16_t* UT = (bf16_t*)(a.ws + WS_UT);
    float* H = (float*)lds;
    float* Ub = H + 8192;
    float* Zb = Ub + 4096;
    float* red = Zb + 4096;
    float* w3s = red + 64;
    const float* hw = a.in[13] + (size_t)l * 3 * 1536; const float* hb = a.in[14] + (size_t)l * 1536;
    const float MIN_DECAY = -3.0701134573253946f, MAX_DECAY = -15.350567286626973f;
    for (int c = blockIdx.x; c < DHY; c += G) {
        const float rate = fabsf(MIN_DECAY + (MAX_DECAY - MIN_DECAY) * (float)c / 511.f);
        const float fb0 = a.in[21][(l * 2 + 0) * 512 + c], fb1 = a.in[21][(l * 2 + 1) * 512 + c];
        float cwv[3][3], cbv[3];
#pragma unroll
        for (int g = 0; g < 3; ++g) { cbv[g] = hb[g * 512 + c];
#pragma unroll
            for (int t3 = 0; t3 < 3; ++t3) cwv[g][t3] = hw[t3 * 1536 + g * 512 + c]; }
        for (int pass = pass_lo; pass < (l == 0 ? 2 : 1); ++pass) {
            const int L = pass ? LCTX : LSEQ;
            const float* hdn = pass ? (const float*)(a.ws + WS_HDNC) : (const float*)(a.ws + WS_HDN) + (size_t)l * 4096 * 64;
            __syncthreads();
            if (tid < 128) w3s[tid] = a.in[20][(size_t)l * 64 * 1024 + (tid & 63) * 1024 + (tid >> 6) * 512 + c];
            __syncthreads();
            float ssq0 = 0.f, ssq1 = 0.f;
            for (int t = tid; t < L; t += 512) { float s0 = 0.f, s1 = 0.f;
                for (int jj = 0; jj < 64; ++jj) { const float hv = hdn[(size_t)t * 64 + jj]; s0 += hv * w3s[jj]; s1 += hv * w3s[64 + jj]; }
                const float off = fabsf((float)t - (float)(L / 2)) / (float)(L / 2); const float dec = __expf(-off * rate);
                s0 *= dec; s1 *= dec; H[t] = s0; H[4096 + t] = s1; ssq0 += s0 * s0; ssq1 += s1 * s1; }
            ssq0 = wave_sum(ssq0); ssq1 = wave_sum(ssq1);
            if ((tid & 63) == 0) { red[tid >> 6] = ssq0; red[8 + (tid >> 6)] = ssq1; }
            __syncthreads();
            float t0 = 0.f, t1 = 0.f;
            for (int w = 0; w < 8; ++w) { t0 += red[w]; t1 += red[8 + w]; }
            const float n0 = rsqrtf(t0 + RMS_EPS), n1 = rsqrtf(t1 + RMS_EPS);
            __syncthreads();
            for (int t = tid; t < L; t += 512) { H[t] *= n0; H[4096 + t] *= n1; }
            __syncthreads();
            for (int b = 0; b < NB; ++b) {
                const size_t col0 = pass ? (size_t)MLAT + (size_t)b * LCTX : (size_t)b * LSEQ;
                const int seglen = pass ? LCTX : 64;
                const bf16_t* rv = UT + (size_t)c * MT + col0; const bf16_t* r1 = UT + (size_t)(512 + c) * MT + col0;
                const bf16_t* r2 = UT + (size_t)(1024 + c) * MT + col0; const bf16_t* rz = UT + (size_t)(1536 + c) * MT + col0;
                for (int t = tid; t < L; t += 512) Ub[t] = conv3_at(rv, t, seglen, cwv[0][0], cwv[0][1], cwv[0][2], cbv[0]);
                __syncthreads();
                for (int t = tid; t < L; t += 512) { float y = 0.f;
                    int slo = t + L / 2 - (L - 1); if (slo < 0) slo = 0; int shi = t + L / 2; if (shi > L - 1) shi = L - 1;
                    for (int s = slo; s <= shi; ++s) y += Ub[s] * H[t + L / 2 - s];
                    const float x1 = conv3_at(r1, t, seglen, cwv[1][0], cwv[1][1], cwv[1][2], cbv[1]);
                    Zb[t] = x1 * (y + Ub[t] * fb0); }
                __syncthreads();
                for (int t = tid; t < L; t += 512) { float y = 0.f;
                    int slo = t + L / 2 - (L - 1); if (slo < 0) slo = 0; int shi = t + L / 2; if (shi > L - 1) shi = L - 1;
                    for (int s = slo; s <= shi; ++s) y += Zb[s] * H[4096 + t + L / 2 - s];
                    const float x2 = conv3_at(r2, t, seglen, cwv[2][0], cwv[2][1], cwv[2][2], cbv[2]);
                    const float o = x2 * (y + Zb[t] * fb1) * silu_f(bf2f(rz[t]));
                    Ub[t] = o; }
                __syncthreads();
                if (do_store) for (int t = tid; t < L; t += 512) UT[(size_t)c * MT + col0 + t] = (bf16_t)f2bf(Ub[t]);
                __syncthreads();
            }
        }
    }
    __syncthreads();
}


typedef float cf __attribute__((ext_vector_type(2)));
__device__ __forceinline__ cf cmul(cf a, cf b) { const cf sw = __builtin_shufflevector(a, a, 1, 0); return a * b.x + sw * cf{-b.y, b.y}; }
__host__ __device__ constexpr float tw32c(int e) { return e == 0 ? 1.f : e == 1 ? 0.98078528040323043f : e == 2 ? 0.92387953251128674f : e == 3 ? 0.83146961230254524f : e == 4 ? 0.70710678118654752f : e == 5 ? 0.55557023301960218f :
    e == 6 ? 0.38268343236508977f : e == 7 ? 0.19509032201612825f : e == 8 ? 0.f : e == 9 ? -0.19509032201612825f : e == 10 ? -0.38268343236508977f : e == 11 ? -0.55557023301960218f : e == 12 ? -0.70710678118654752f :
    e == 13 ? -0.83146961230254524f : e == 14 ? -0.92387953251128674f : -0.98078528040323043f; }
template <int E32> __device__ __forceinline__ cf twmul(cf d) {
    if (E32 == 0) return d;
    if (E32 == 8) return cf{d.y, -d.x};
    constexpr float c = tw32c(E32), sn = tw32c(E32 < 8 ? 8 - E32 : E32 - 8);
    const cf sw = __builtin_shufflevector(d, d, 1, 0);
    return d * c + sw * cf{sn, -sn};
}
template <int R, int HALF, int I> struct DftStage {
    static __device__ __forceinline__ void run(cf (&v)[R]) {
        if constexpr ((I & HALF) == 0) {
            constexpr int E32 = (I % HALF) * (R / (2 * HALF)) * (32 / R);
            const cf a = v[I], b = v[I + HALF];
            v[I] = a + b;
            v[I + HALF] = twmul<E32>(a - b);
        }
        if constexpr (I + 1 < R) DftStage<R, HALF, I + 1>::run(v);
    }
};
template <int R, int HALF> struct DftAll {
    static __device__ __forceinline__ void run(cf (&v)[R]) { DftStage<R, HALF, 0>::run(v); if constexpr (HALF > 1) DftAll<R, HALF / 2>::run(v); }
};
__host__ __device__ constexpr int bitrev_c(int x, int bits) { int r = 0; for (int i = 0; i < bits; ++i) r = (r << 1) | ((x >> i) & 1); return r; }
__device__ __forceinline__ int PADI(int i) { return i + (i >> 4); }
constexpr int FFT_W_ELEMS = 8192 + 512;
template <int R, int I> struct StoreRev {
    static __device__ __forceinline__ void run(LAS cf* Wp, int pstride, const cf (&v)[R]) {
        constexpr int bits = (R == 32) ? 5 : 4;
        Wp[I * pstride] = v[bitrev_c(I, bits)];
        if constexpr (I + 1 < R) StoreRev<R, I + 1>::run(Wp, pstride, v);
    }
};
template <int R, int NS> __device__ __forceinline__ void fft_pass(LAS cf* W, int tid_) {
    int tid = tid_; asm volatile("" : "+v"(tid));
    constexpr int NT = 8192 / R;
    cf v[R];
    const bool act = tid < NT;
    if (act) {
#pragma unroll
        for (int r = 0; r < R; ++r) v[r] = W[PADI(tid) + r * (NT + NT / 16)];
    }
    __syncthreads();
    if (act) {
        const int k = tid % NS;
        if (NS > 1) {
            const float fr_ = -(float)k * (1.f / (float)(NS * R)); const float sn = __builtin_amdgcn_sinf(fr_), cs = __builtin_amdgcn_cosf(fr_);
            const cf w = cf{cs, sn}; cf cur = w;
#pragma unroll
            for (int r = 1; r < R; ++r) { v[r] = cmul(v[r], cur); cur = cmul(cur, w); }
        }
        DftAll<R, R / 2>::run(v);
        const int idx = (tid / NS) * NS * R + k;
        StoreRev<R, 0>::run(W + PADI(idx), NS >= 16 ? NS + NS / 16 : 1, v);
    }
    __syncthreads();
}
__device__ __forceinline__ void fft_pass2(LAS cf* W, int tid_) {
    int tid = tid_; asm volatile("" : "+v"(tid));
#pragma unroll 2
    for (int m = 0; m < 8; ++m) { const int j = tid + 512 * m; const int pj = PADI(j); const cf a = W[pj]; cf b = W[pj + 4352];
        const float fr_ = -(float)j * (1.f / 8192.f); b = cmul(b, cf{__builtin_amdgcn_cosf(fr_), __builtin_amdgcn_sinf(fr_)});
        W[pj] = cf{a.x + b.x, a.y + b.y}; W[pj + 4352] = cf{a.x - b.x, a.y - b.y}; }
    __syncthreads();
}
__device__ __forceinline__ void fft8192(LAS cf* W, int tid) { fft_pass<16, 1>(W, tid); fft_pass<16, 16>(W, tid); fft_pass<16, 256>(W, tid); fft_pass2(W, tid); }

template <int NS> __device__ __forceinline__ void fft4k_pass(LAS cf* Wb, int j_) {
    int j = j_; asm volatile("" : "+v"(j));
    cf v[16];
#pragma unroll
    for (int r = 0; r < 16; ++r) v[r] = Wb[PADI(j) + r * 272];
    __syncthreads();
    const int k = j % NS;
    if (NS > 1) {
        const float fr_ = -(float)k * (1.f / (float)(NS * 16)); const float sn = __builtin_amdgcn_sinf(fr_), cs = __builtin_amdgcn_cosf(fr_);
        const cf w = cf{cs, sn}; cf cur = w;
#pragma unroll
        for (int r = 1; r < 16; ++r) { v[r] = cmul(v[r], cur); cur = cmul(cur, w); }
    }
    DftAll<16, 8>::run(v);
    const int idx = (j / NS) * NS * 16 + k;
    StoreRev<16, 0>::run(Wb + PADI(idx), NS >= 16 ? NS + NS / 16 : 1, v);
    __syncthreads();
}
__device__ __forceinline__ void fft4k_x2(LAS cf* Wb, int j) { fft4k_pass<1>(Wb, j); fft4k_pass<16>(Wb, j); fft4k_pass<256>(Wb, j); }

__device__ __forceinline__ void conv8(const u32x4 rv, int tid, float w0, float w1, float w2, float bias, float (&o)[8]) {
    float x[8];
#pragma unroll
    for (int e = 0; e < 4; ++e) { x[2 * e] = bflo(rv[e]); x[2 * e + 1] = bfhi(rv[e]); }
    float left = __shfl_up(x[7], 1), right = __shfl_down(x[0], 1);
    if ((tid & 7) == 0) left = 0.f;
    if ((tid & 7) == 7) right = 0.f;
#pragma unroll
    for (int e = 0; e < 8; ++e) { const float xm = (e == 0) ? left : x[e - 1], xp = (e == 7) ? right : x[e + 1]; o[e] = w0 * xm + w1 * x[e] + w2 * xp + bias; }
}

__device__ __forceinline__ void hyena_item(const Args& a, int l, unsigned char* lds_, int item, bool do_store) {
    const int tid = opaque_tid();
    const int c = item >> 1, half = item & 1;
    LAS unsigned char* lds = (LAS unsigned char*)lds_;
    LAS cf* W = (LAS cf*)lds;
    LAS cf* He0 = (LAS cf*)(lds + 69632);
    LAS cf* Ho0 = He0 + 2049;
    LAS cf* He1 = Ho0 + 2048;
    LAS cf* Ho1 = He1 + 2049;
    const int sel = tid >> 8, j = tid & 255;
    LAS cf* Wb = W + sel * 4352;
    bf16_t* UT = (bf16_t*)(a.ws + WS_UT);
    const float* FT = (const float*)(a.ws + WS_FT);
    const float* hw = a.in[13] + (size_t)l * 3 * 1536; const float* hb = a.in[14] + (size_t)l * 1536;
    const float fb0 = a.in[21][(l * 2 + 0) * 512 + c], fb1 = a.in[21][(l * 2 + 1) * 512 + c];
    const int pi0 = PADI(tid * 8);
    __syncthreads();
    {
        const f32x4 ha = *(const f32x4*)(FT + (size_t)c * 4096 + tid * 8), hb2 = *(const f32x4*)(FT + (size_t)c * 4096 + tid * 8 + 4);
        const f32x4 ga = *(const f32x4*)(FT + (size_t)(512 + c) * 4096 + tid * 8), gb2 = *(const f32x4*)(FT + (size_t)(512 + c) * 4096 + tid * 8 + 4);
        const float fn0 = FT[(size_t)1024 * 4096 + c], fn1 = FT[(size_t)1024 * 4096 + 512 + c];
#pragma unroll
        for (int e = 0; e < 8; ++e) { const cf f = cf{(e < 4 ? ha[e & 3] : hb2[e & 3]) * fn0, (e < 4 ? ga[e & 3] : gb2[e & 3]) * fn1};
            const float fr_ = -(float)(tid * 8 + e) * (1.f / 8192.f);
            W[pi0 + e] = f; W[4352 + pi0 + e] = cmul(f, cf{__builtin_amdgcn_cosf(fr_), __builtin_amdgcn_sinf(fr_)}); }
        __syncthreads();
        fft4k_x2(Wb, j);
        for (int m = tid; m <= 2048; m += NTHR) { const cf A = W[PADI(m & 4095)], Bm = W[PADI((4096 - m) & 4095)];
            He0[m] = cf{0.5f * (A.x + Bm.x), 0.5f * (A.y - Bm.y)}; He1[m] = cf{0.5f * (A.y + Bm.y), -0.5f * (A.x - Bm.x)}; }
        for (int m = tid; m < 2048; m += NTHR) { const cf A = W[4352 + PADI(m)], Bm = W[4352 + PADI(4095 - m)];
            Ho0[m] = cf{0.5f * (A.x + Bm.x), 0.5f * (A.y - Bm.y)}; Ho1[m] = cf{0.5f * (A.y + Bm.y), -0.5f * (A.x - Bm.x)}; }
        __syncthreads();
    }
    float cwv[3][3], cbv[3];
#pragma unroll
    for (int g = 0; g < 3; ++g) { cbv[g] = hb[g * 512 + c];
#pragma unroll
        for (int t3 = 0; t3 < 3; ++t3) cwv[g][t3] = hw[t3 * 1536 + g * 512 + c]; }
#pragma unroll 1
    for (int bp = half * 2; bp < half * 2 + 2; ++bp) {
        const size_t o0 = (size_t)(2 * bp) * LSEQ + tid * 8, o1 = o0 + LSEQ;
        bf16_t* rv = UT + (size_t)c * MT; const bf16_t* r1 = UT + (size_t)(512 + c) * MT; const bf16_t* r2 = UT + (size_t)(1024 + c) * MT; const bf16_t* rz = UT + (size_t)(1536 + c) * MT;
        const u32x4 qv0 = *(const u32x4*)(rv + o0), qv1 = *(const u32x4*)(rv + o1), qa0 = *(const u32x4*)(r1 + o0), qa1 = *(const u32x4*)(r1 + o1);
        const u32x4 qb0 = *(const u32x4*)(r2 + o0), qb1 = *(const u32x4*)(r2 + o1), qz0 = *(const u32x4*)(rz + o0), qz1 = *(const u32x4*)(rz + o1);
        float z0[8], z1[8];
        conv8(qv0, tid, cwv[0][0], cwv[0][1], cwv[0][2], cbv[0], z0);
        conv8(qv1, tid, cwv[0][0], cwv[0][1], cwv[0][2], cbv[0], z1);
#pragma unroll 1
        for (int ord = 0; ord < 2; ++ord) {
#pragma unroll
            for (int e = 0; e < 8; ++e) { const cf f = cf{z0[e], z1[e]}; const float fr_ = -(float)(tid * 8 + e) * (1.f / 8192.f);
                W[pi0 + e] = f; W[4352 + pi0 + e] = cmul(f, cf{__builtin_amdgcn_cosf(fr_), __builtin_amdgcn_sinf(fr_)}); }
            __syncthreads();
            fft4k_x2(Wb, j);
            {
                LAS const cf* Hs = sel ? (ord ? Ho1 : Ho0) : (ord ? He1 : He0);
                const int top = sel ? 4095 : 4096, lim = sel ? 2047 : 2048;
#pragma unroll 4
                for (int i = 0; i < 16; ++i) { const int m = j + 256 * i; const int pm = PADI(m); const cf zv = Wb[pm];
                    cf hk; if (m <= lim) hk = Hs[m]; else { hk = Hs[top - m]; hk.y = -hk.y; }
                    const cf y = cmul(zv, hk); Wb[pm] = cf{y.x, -y.y}; }
            }
            __syncthreads();
            fft4k_x2(Wb, j);
            float x0[8], x1[8];
            conv8(ord ? qb0 : qa0, tid, cwv[1 + ord][0], cwv[1 + ord][1], cwv[1 + ord][2], cbv[1 + ord], x0);
            conv8(ord ? qb1 : qa1, tid, cwv[1 + ord][0], cwv[1 + ord][1], cwv[1 + ord][2], cbv[1 + ord], x1);
            const float fb = ord ? fb1 : fb0;
            const int pr = PADI((2048 + tid * 8) & 4095);
#pragma unroll
            for (int e = 0; e < 8; ++e) { const float fr_ = -(float)(2048 + tid * 8 + e) * (1.f / 8192.f);
                const cf ev = W[pr + e], ov = cmul(W[4352 + pr + e], cf{__builtin_amdgcn_cosf(fr_), __builtin_amdgcn_sinf(fr_)});
                const float y0 = (ev.x + ov.x) * (1.f / 8192.f), y1 = -(ev.y + ov.y) * (1.f / 8192.f);
                z0[e] = x0[e] * (y0 + z0[e] * fb); z1[e] = x1[e] * (y1 + z1[e] * fb); }
            __syncthreads();
        }
        {
            u32x4 w0, w1;
#pragma unroll
            for (int e = 0; e < 4; ++e) { w0[e] = pg8::cvt_pk_bf16(z0[2 * e] * silu_f(bflo(qz0[e])), z0[2 * e + 1] * silu_f(bfhi(qz0[e])));
                w1[e] = pg8::cvt_pk_bf16(z1[2 * e] * silu_f(bflo(qz1[e])), z1[2 * e + 1] * silu_f(bfhi(qz1[e]))); }
            if (do_store) { *(u32x4*)(rv + o0) = w0; *(u32x4*)(rv + o1) = w1; } }
    }
    __syncthreads();
}

__device__ __forceinline__ void filt_item(const Args& a, int l, unsigned char* lds_, int fi) {
    const int tid = opaque_tid();
    LAS float* w3s = (LAS float*)lds_ + 4096;
    LAS float* red = w3s + 512;
    float* FT = (float*)(a.ws + WS_FT);
    const float* hdn = (const float*)(a.ws + WS_HDN) + (size_t)l * 4096 * 64;
    const float MIN_DECAY = -3.0701134573253946f, MAX_DECAY = -15.350567286626973f;
    __syncthreads();
    w3s[tid] = a.in[20][(size_t)l * 64 * 1024 + (size_t)(tid >> 3) * 1024 + fi * 8 + (tid & 7)];
    __syncthreads();
    float rate[8], ssq[8];
#pragma unroll
    for (int cc = 0; cc < 8; ++cc) { const int ch = (fi * 8 + cc) & 511; rate[cc] = fabsf(MIN_DECAY + (MAX_DECAY - MIN_DECAY) * (float)ch / 511.f); ssq[cc] = 0.f; }
#pragma unroll 1
    for (int it2 = 0; it2 < 2; ++it2) {
        float acc[4][8];
#pragma unroll
        for (int q = 0; q < 4; ++q)
#pragma unroll
            for (int cc = 0; cc < 8; ++cc) acc[q][cc] = 0.f;
        const f32x4* hp = (const f32x4*)(hdn + (size_t)(it2 * 2048 + tid) * 64);
        f32x4 hn[4];
#pragma unroll
        for (int q = 0; q < 4; ++q) hn[q] = hp[(size_t)q * 512 * 16];
#pragma unroll 1
        for (int j4 = 0; j4 < 16; ++j4) {
            f32x4 hv[4];
#pragma unroll
            for (int q = 0; q < 4; ++q) hv[q] = hn[q];
            if (j4 < 15) {
#pragma unroll
                for (int q = 0; q < 4; ++q) hn[q] = hp[(size_t)q * 512 * 16 + j4 + 1]; }
#pragma unroll
            for (int jj = 0; jj < 4; ++jj) { const f32x4 wa = *(const LAS f32x4*)(w3s + (4 * j4 + jj) * 8), wb = *(const LAS f32x4*)(w3s + (4 * j4 + jj) * 8 + 4);
#pragma unroll
                for (int q = 0; q < 4; ++q) { const float h = hv[q][jj];
                    acc[q][0] += h * wa.x; acc[q][1] += h * wa.y; acc[q][2] += h * wa.z; acc[q][3] += h * wa.w; acc[q][4] += h * wb.x; acc[q][5] += h * wb.y; acc[q][6] += h * wb.z; acc[q][7] += h * wb.w; } }
        }
#pragma unroll
        for (int q = 0; q < 4; ++q) { const int t = it2 * 2048 + tid + 512 * q; const float off = fabsf((float)t - 2048.f) * (1.f / 2048.f);
#pragma unroll
            for (int cc = 0; cc < 8; ++cc) { const float v = acc[q][cc] * __expf(-off * rate[cc]); ssq[cc] += v * v; FT[(size_t)(fi * 8 + cc) * 4096 + t] = v; } }
    }
#pragma unroll
    for (int cc = 0; cc < 8; ++cc) { const float sv = wave_sum(ssq[cc]); if ((tid & 63) == 0) red[(tid >> 6) * 8 + cc] = sv; }
    __syncthreads();
    if (tid < 8) { float tsum = 0.f;
#pragma unroll
        for (int w = 0; w < 8; ++w) tsum += red[w * 8 + tid];
        FT[(size_t)1024 * 4096 + fi * 8 + tid] = rsqrtf(tsum + RMS_EPS); }
}

__device__ __forceinline__ float ctx_conv3(const bf16_t* rowp, int t, float w0, float w1, float w2, float bias) {
    float v = bf2f(rowp[t]) * w1 + bias;
    if (t > 0) v += bf2f(rowp[t - 1]) * w0;
    if (t < LCTX - 1) v += bf2f(rowp[t + 1]) * w2;
    return v;
}
__device__ __forceinline__ void hyena_ctx_item(const Args& a, unsigned char* lds_, int c, bool do_store) {
    const int tid = opaque_tid();
    LAS float* Hc = (LAS float*)lds_;
    LAS float* U = Hc + 512;
    LAS float* Z = U + 2048;
    LAS float* red = Z + 2048;
    LAS float* w3s = red + 16;
    bf16_t* UT = (bf16_t*)(a.ws + WS_UT);
    const float* hdn = (const float*)(a.ws + WS_HDNC);
    const float* hw = a.in[13]; const float* hb = a.in[14];
    const float MIN_DECAY = -3.0701134573253946f, MAX_DECAY = -15.350567286626973f;
    const int t = tid & 255, bh = tid >> 8;
    {
        const float rate = fabsf(MIN_DECAY + (MAX_DECAY - MIN_DECAY) * (float)c / 511.f);
        const float fb0 = a.in[21][c], fb1 = a.in[21][512 + c];
        __syncthreads();
        if (tid < 128) w3s[tid] = a.in[20][(size_t)(tid & 63) * 1024 + (tid >> 6) * 512 + c];
        __syncthreads();
        {
            float sv = 0.f;
            const f32x4* hp = (const f32x4*)(hdn + (size_t)t * 64);
#pragma unroll 4
            for (int j4 = 0; j4 < 16; ++j4) { const f32x4 hv = hp[j4]; sv += hv.x * w3s[bh * 64 + 4 * j4] + hv.y * w3s[bh * 64 + 4 * j4 + 1] + hv.z * w3s[bh * 64 + 4 * j4 + 2] + hv.w * w3s[bh * 64 + 4 * j4 + 3]; }
            sv *= __expf(-fabsf((float)t - 128.f) * (1.f / 128.f) * rate);
            const float ss = wave_sum(sv * sv);
            if ((tid & 63) == 0) red[tid >> 6] = ss;
            __syncthreads();
            const float tot = red[bh * 4] + red[bh * 4 + 1] + red[bh * 4 + 2] + red[bh * 4 + 3];
            Hc[bh * 256 + t] = sv * rsqrtf(tot + RMS_EPS);
        }
        float vv[4];
#pragma unroll
        for (int i = 0; i < 4; ++i) { const bf16_t* rv = UT + (size_t)c * MT + MLAT + (size_t)(bh * 4 + i) * LCTX;
            vv[i] = ctx_conv3(rv, t, hw[c], hw[1536 + c], hw[3072 + c], hb[c]); }
        *(LAS f32x4*)(U + t * 8 + bh * 4) = (f32x4){vv[0], vv[1], vv[2], vv[3]};
        __syncthreads();
        const int slo = (t - 127 > 0) ? t - 127 : 0, shi = (t + 128 < 255) ? t + 128 : 255;
        f32x4 acc = {0.f, 0.f, 0.f, 0.f};
        for (int s2 = slo; s2 <= shi; ++s2) { const float h = Hc[t + 128 - s2]; const f32x4 u = *(const LAS f32x4*)(U + s2 * 8 + bh * 4); acc = acc + u * h; }
        float zz[4];
#pragma unroll
        for (int i = 0; i < 4; ++i) { const bf16_t* r1 = UT + (size_t)(512 + c) * MT + MLAT + (size_t)(bh * 4 + i) * LCTX;
            const float x1 = ctx_conv3(r1, t, hw[512 + c], hw[1536 + 512 + c], hw[3072 + 512 + c], hb[512 + c]);
            zz[i] = x1 * (acc[i] + vv[i] * fb0); }
        *(LAS f32x4*)(Z + t * 8 + bh * 4) = (f32x4){zz[0], zz[1], zz[2], zz[3]};
        __syncthreads();
        acc = (f32x4){0.f, 0.f, 0.f, 0.f};
        for (int s2 = slo; s2 <= shi; ++s2) { const float h = Hc[256 + t + 128 - s2]; const f32x4 u = *(const LAS f32x4*)(Z + s2 * 8 + bh * 4); acc = acc + u * h; }
#pragma unroll
        for (int i = 0; i < 4; ++i) { const size_t off = (size_t)MLAT + (size_t)(bh * 4 + i) * LCTX;
            const bf16_t* r2 = UT + (size_t)(1024 + c) * MT + off; const bf16_t* rz = UT + (size_t)(1536 + c) * MT + off;
            const float x2 = ctx_conv3(r2, t, hw[1024 + c], hw[1536 + 1024 + c], hw[3072 + 1024 + c], hb[1024 + c]);
            const float o = x2 * (acc[i] + zz[i] * fb1) * silu_f(bf2f(rz[t]));
            if (do_store) UT[(size_t)c * MT + off + t] = (bf16_t)f2bf(o); }
    }
    __syncthreads();
}


__device__ __forceinline__ void phase_mixers(const Args& a, int l, unsigned char* lds, int rep, bool do_mlstm, bool do_hy, bool do_hyctx) {
    LAS unsigned* qslot = (LAS unsigned*)((LAS unsigned char*)lds + (LDS_BYTES - 32));
    if (do_mlstm && (blockIdx.x & 3) == 0 && (blockIdx.x >> 2) < 64) mlstm_item(a, l, lds, blockIdx.x >> 2, rep == 0);
    unsigned* ctr = (unsigned*)(a.ws + WS_CTL) + CW_QUEUE + 64 * (l * 8 + rep);
    const int n_lat = do_hy ? 2 * DHY : 0, n_ctx = (l == 0 && do_hyctx) ? DHY : 0;
    for (;;) {
        __syncthreads();
        if (threadIdx.x == 0) *qslot = __hip_atomic_fetch_add(ctr, 1u, __ATOMIC_RELAXED, __HIP_MEMORY_SCOPE_AGENT);
        __syncthreads();
        const int item = (int)*qslot;
        if (item >= n_lat + n_ctx) break;
        if (item < n_lat) hyena_item(a, l, lds, item, rep == 0);
        else hyena_ctx_item(a, lds, item - n_lat, rep == 0);
    }
    __syncthreads();
}

__device__ __forceinline__ void phase_combine(const Args& a, int l, unsigned char* lds) {
    const int tid = opaque_tid(), G = gridDim.x, lane = tid & 63, wave = tid >> 6;
    const bf16_t* U1 = (const bf16_t*)(a.ws + WS_U1);
    const bf16_t* HDi = (const bf16_t*)(a.ws + WS_HB);
    const bf16_t* UT = (const bf16_t*)(a.ws + WS_UT);
    bf16_t* YM = (bf16_t*)(a.ws + WS_YMIX);
    bf16_t* T = (bf16_t*)lds;
    const int nblk = (l == 0 ? MT : MLAT) / 64;
    const float* mg = a.in[12] + l * 512;
    for (int blk = blockIdx.x; blk < nblk; blk += G) {
        const int r0 = blk * 64;
        __syncthreads();
#pragma unroll
        for (int i = 0; i < 8; ++i) { const int e = tid + i * 512, ch = e >> 3, p8 = (e & 7) * 8;
            *(u32x4*)(T + ch * 72 + p8) = *(const u32x4*)(UT + (size_t)ch * MT + r0 + p8); }
        for (int rr = wave; rr < 64; rr += 8) {
            const size_t row = r0 + rr;
            const int cb = row >= MLAT ? (int)(row - MLAT) >> 8 : (int)row >> 12, csr = row >= MLAT ? (int)(row - MLAT) & 255 : LCTX + ((int)row & 4095);
            const bf16_t* hp = HDi + ((size_t)(cb * 4 + (lane >> 4)) * (LCTX + LSEQ) + csr) * 128 + (lane & 15) * 8;
            const u32x4 hf = *(const u32x4*)hp, hb = *(const u32x4*)(hp + (size_t)32 * (LCTX + LSEQ) * 128);
            const u32x4 ov = *(const u32x4*)(U1 + row * LDU1 + 1024 + lane * 8), zv = *(const u32x4*)(U1 + row * LDU1 + 1536 + lane * 8);
            float hg[8]; float ss = 0.f;
#pragma unroll
            for (int i = 0; i < 4; ++i) { const unsigned f = hf[i], bb = hb[i], o = ov[i];
                hg[2 * i] = (bf2f(f & 0xffff) + bf2f(bb & 0xffff)) * sigmoid_f(bf2f(o & 0xffff));
                hg[2 * i + 1] = (bf2f(f >> 16) + bf2f(bb >> 16)) * sigmoid_f(bf2f(o >> 16));
                ss += hg[2 * i] * hg[2 * i] + hg[2 * i + 1] * hg[2 * i + 1]; }
            ss += __shfl_xor(ss, 1); ss += __shfl_xor(ss, 2); ss += __shfl_xor(ss, 4); ss += __shfl_xor(ss, 8);
            const float r = rsqrtf(ss * (1.f / 128.f) + RMS_EPS);
            u32x4 o4;
#pragma unroll
            for (int i = 0; i < 4; ++i) { const unsigned z = zv[i];
                const float v0 = hg[2 * i] * r * mg[lane * 8 + 2 * i] * silu_f(bf2f(z & 0xffff));
                const float v1 = hg[2 * i + 1] * r * mg[lane * 8 + 2 * i + 1] * silu_f(bf2f(z >> 16));
                o4[i] = pk2(v0, v1); }
            *(u32x4*)(YM + row * DM + lane * 8) = o4;
        }
        __syncthreads();
        for (int rr = wave; rr < 64; rr += 8) {
            u32x4 o4;
#pragma unroll
            for (int i = 0; i < 4; ++i) o4[i] = (unsigned)T[(lane * 8 + 2 * i) * 72 + rr] | ((unsigned)T[(lane * 8 + 2 * i + 1) * 72 + rr] << 16);
            *(u32x4*)(YM + (size_t)(r0 + rr) * DM + 512 + lane * 8) = o4;
        }
    }
    __syncthreads();
}


#define XB_TMO      128
#define XB_XCNT(j)  (256  + 64 * (j))
#define XB_XSUB(j)  (1280 + 64 * (j))
#define XB_XGEN(j)  (2304 + 64 * (j))
#define XB_TOP      3328
#define XB_TOPGEN   3392
#define XCD_BAR_WORDS 3456
#define XB_SPIN_CAP (1u << 18)
__device__ __forceinline__ unsigned xb_ld(unsigned* p)              { return __hip_atomic_load(p, __ATOMIC_RELAXED, __HIP_MEMORY_SCOPE_AGENT); }
__device__ __forceinline__ unsigned xb_add(unsigned* p, unsigned v) { return __hip_atomic_fetch_add(p, v, __ATOMIC_RELAXED, __HIP_MEMORY_SCOPE_AGENT); }
__device__ __forceinline__ unsigned xb_xcc_id() { return (unsigned)__builtin_amdgcn_s_getreg((3 << 11) | 20) & 0xFu; }
#define XB_SPIN(cond, bar) do { unsigned _sp = 0; while (cond) { __builtin_amdgcn_s_sleep(1); \
    if ((++_sp & 255u) == 0u) { if (xb_ld(&(bar)[XB_TMO])) break; if (_sp > XB_SPIN_CAP) { atomicAdd(&(bar)[XB_TMO], 1u); break; } } } } while (0)
struct XcdBarrier { unsigned* bar; unsigned x; volatile __attribute__((address_space(3))) unsigned* st; };
__device__ __forceinline__ XcdBarrier xcd_barrier_post(unsigned* bar, volatile __attribute__((address_space(3))) unsigned* st) {
    XcdBarrier b; b.bar = bar; b.x = xb_xcc_id(); b.st = st;
    if (threadIdx.x == 0) (void)xb_add(&bar[XB_XCNT(b.x)], 1u);
    return b;
}
__device__ __forceinline__ void xcd_barrier_complete(unsigned* bar, unsigned x, unsigned& nloc, unsigned& nx) {
    const unsigned G = gridDim.x * gridDim.y * gridDim.z;
    unsigned sum, cnt, mine, sp = 0u;
    for (;;) {
        sum = 0u; cnt = 0u; mine = 0u;
#pragma unroll
        for (unsigned j = 0; j < 16; ++j) { const unsigned c = xb_ld(&bar[XB_XCNT(j)]); sum += c; cnt += (c > 0u) ? 1u : 0u; mine = (j == x) ? c : mine; }
        if (sum == G) break;
        __builtin_amdgcn_s_sleep(1);
        if ((++sp & 255u) == 0u) { if (xb_ld(&bar[XB_TMO])) break; if (sp > XB_SPIN_CAP) { atomicAdd(&bar[XB_TMO], 1u); break; } }
    }
    nloc = mine > 0u ? mine : 1u; nx = cnt > 0u ? cnt : 1u;
}
__device__ __forceinline__ void xcd_barrier(const XcdBarrier& b) {
    asm volatile("s_waitcnt vmcnt(0)" ::: "memory");
    __syncthreads();
    if (threadIdx.x == 0) {
        unsigned* bar = b.bar;
        __builtin_amdgcn_s_waitcnt(0);
        unsigned nloc = b.st[0], nx = b.st[1];
        if (nloc == 0u) { xcd_barrier_complete(bar, b.x, nloc, nx); b.st[0] = nloc; b.st[1] = nx; }
        const unsigned old = xb_add(&bar[XB_XSUB(b.x)], 1u);
        const unsigned gen = old / nloc;
        if (old + 1u == (gen + 1u) * nloc) {
            __builtin_amdgcn_fence(__ATOMIC_RELEASE, "agent");
            asm volatile("s_waitcnt vmcnt(0)" ::: "memory");
            const unsigned og = xb_add(&bar[XB_TOP], 1u);
            const unsigned tg = og / nx;
            if (og + 1u == (tg + 1u) * nx) xb_add(&bar[XB_TOPGEN], 1u);
            else XB_SPIN(xb_ld(&bar[XB_TOPGEN]) == tg, bar);
            __builtin_amdgcn_fence(__ATOMIC_ACQUIRE, "agent");
            xb_add(&bar[XB_XGEN(b.x)], 1u);
            asm volatile("s_waitcnt vmcnt(0)" ::: "memory");
        } else {
            XB_SPIN(xb_ld(&bar[XB_XGEN(b.x)]) == gen, bar);
            __builtin_amdgcn_fence(__ATOMIC_ACQUIRE, "agent");
            asm volatile("s_waitcnt vmcnt(0)" ::: "memory");
        }
    }
    __syncthreads();
}

__global__ void __launch_bounds__(NTHR, 2) fwd(Args a_) {
    extern __shared__ __attribute__((aligned(16))) unsigned char lds[];
    cg::grid_group grid = cg::this_grid();
    const int lo = a_.ph_lo, hi = a_.ph_hi; const int rp_phase = a_.rep_phase, rp_count = a_.rep_count & 255;
#define IN(k) (lo <= (k) && (k) < hi)
    volatile __attribute__((address_space(3))) unsigned* bst = (volatile __attribute__((address_space(3))) unsigned*)((__attribute__((address_space(3))) unsigned char*)lds + (LDS_BYTES - 64));
    if (threadIdx.x < 2) bst[threadIdx.x] = 0u;
    __syncthreads();
    const XcdBarrier xbar = xcd_barrier_post((unsigned*)(a_.ws + WS_CTL), bst);
    if (lo < 0) grid.sync();
#define SEAM(k) do { if (IN(k) && IN((k) + 1)) xcd_barrier(xbar); } while (0)
    if (IN(0)) _Pragma("unroll 1") for (int rep = 0, nrep = (rp_phase == 0) ? rp_count : 1; rep < nrep; ++rep) phase_prep(kargs(), lds);
    SEAM(0);
    if (IN(1)) _Pragma("unroll 1") for (int rep = 0, nrep = (rp_phase == 1) ? rp_count : 1; rep < nrep; ++rep) phase_norm(kargs(), 0, false, true, lds);
    SEAM(1);
    for (int l = 0; l < DEPTH; ++l) {
        const int p = 2 + 6 * l;
        if (IN(p)) {
            unsigned char* ws = kargs().ws;
            const bf16_t* HB = (const bf16_t*)(ws + WS_HB);
            const bf16_t* WinT = (const bf16_t*)(ws + WS_WINT) + (size_t)l * NPK * DM;
#if NAIVE_GEMM
            gemm_naive(HB, WinT, MT, NU1, DM, ws + WS_U1, NU1, 0, lds);
            gemm_naive(HB, WinT + (size_t)NU1 * DM, MT, NU2, DM, ws + WS_UT, MT, 1, lds);
#else
            DecIn d{(const char*)HB, (const char*)WinT, (char*)(ws + WS_U1), (char*)(ws + WS_UT)};
            pg8::GridOrder<DecIn> S; S.init(MT / 256, NPK / 256, gridDim.x, blockIdx.x, d);
            _Pragma("unroll 1") for (int rep = 0, nrep = (rp_phase == 2) ? rp_count : 1; rep < nrep; ++rep) pg8::gemm_phase<true>((PG8_LAS unsigned char*)lds, DM, S);
#endif
        }
        SEAM(p);
        if (IN(p + 1)) _Pragma("unroll 1") for (int rep = 0, nrep = (rp_phase == 9) ? rp_count : 1; rep < nrep; ++rep) phase_mprep(kargs(), l, lds, rep);
        SEAM(p + 1);
        if (IN(p + 2)) {
            const int nrep = (rp_phase == 3 || rp_phase == 4 || rp_phase == 5 || rp_phase == 11) ? rp_count : 1;
            _Pragma("unroll 1") for (int rep = 0; rep < nrep; ++rep)
                phase_mixers(kargs(), l, lds, rep, rep == 0 || rp_phase == 3 || rp_phase == 11, rep == 0 || rp_phase == 4 || rp_phase == 11, rep == 0 || rp_phase == 5 || rp_phase == 11);
        }
        SEAM(p + 2);
        if (IN(p + 3)) _Pragma("unroll 1") for (int rep = 0, nrep = (rp_phase == 6) ? rp_count : 1; rep < nrep; ++rep) phase_combine(kargs(), l, lds);
        SEAM(p + 3);
        if (IN(p + 4)) {
            unsigned char* ws = kargs().ws;
            const bf16_t* WoutT = (const bf16_t*)(ws + WS_WOUTT) + (size_t)l * DM * DM;
#if NAIVE_GEMM
            gemm_naive((const bf16_t*)(ws + WS_YMIX), WoutT, (l == 0) ? MT : MLAT, DM, DM, ws + WS_U1, DM, 2, lds);
#else
            DecOut d{(const char*)(ws + WS_YMIX), (const char*)WoutT, (char*)(ws + WS_U1)};
            pg8::GridOrder<DecOut> S; S.init(((l == 0) ? MT : MLAT) / 256, DM / 256, gridDim.x, blockIdx.x, d);
            _Pragma("unroll 1") for (int rep = 0, nrep = (rp_phase == 7) ? rp_count : 1; rep < nrep; ++rep) pg8::gemm_phase<true>((PG8_LAS unsigned char*)lds, DM, S);
#endif
        }
        SEAM(p + 4);
        if (IN(p + 5)) _Pragma("unroll 1") for (int rep = 0, nrep = (rp_phase == 8 && l == 0) ? rp_count : 1; rep < nrep; ++rep) phase_norm(kargs(), l + 1, true, l + 1 < DEPTH, lds);
        SEAM(p + 5);
    }
    if (rp_phase == 10) for (int rep = 0; rep < rp_count; ++rep) xcd_barrier(xbar);
#undef IN
#undef SEAM
}

constexpr int NPHASES = 2 + 6 * DEPTH;

extern "C" void kernel_launch(void* const* d_in, const int* in_sizes, int n_in, void* d_out, int out_size, void* d_ws, size_t ws_size, hipStream_t stream) {
    static int grid = 0;
    if (grid == 0) {
        if (n_in != 23 || out_size != MLAT * DM || ws_size < WS_END) { fprintf(stderr, "kernel_launch: unexpected shapes n_in %d out %d ws %zu\n", n_in, out_size, ws_size); grid = -1; return; }
        int dev = 0, cus = 0, per_cu = 0;
        (void)hipGetDevice(&dev);
        (void)hipDeviceGetAttribute(&cus, hipDeviceAttributeMultiprocessorCount, dev);
        (void)hipFuncSetAttribute((const void*)fwd, hipFuncAttributeMaxDynamicSharedMemorySize, LDS_BYTES);
        (void)hipOccupancyMaxActiveBlocksPerMultiprocessor(&per_cu, (const void*)fwd, NTHR, LDS_BYTES);
        if (per_cu < 1) per_cu = 1;
        grid = cus * per_cu;
        fprintf(stderr, "kernel_launch: cus %d per_cu %d grid %d ws %zu\n", cus, per_cu, grid, ws_size);
    }
    if (grid < 0) return;
    Args a{};
    for (int i = 0; i < 23; ++i) a.in[i] = (const float*)d_in[i];
    a.out = (float*)d_out; a.ws = (unsigned char*)d_ws;
    (void)hipMemsetAsync((char*)d_ws + WS_CTL, 0, 32768, stream);
    a.ph_lo = 0; a.ph_hi = NPHASES; a.rep_phase = PROBE_PHASE; a.rep_count = PROBE_COUNT;
    void* kargs[] = {&a};
    hipError_t e = hipLaunchCooperativeKernel((const void*)fwd, dim3(grid), dim3(NTHR), kargs, LDS_BYTES, stream);
    if (e != hipSuccess) fprintf(stderr, "kernel_launch: cooperative launch failed: %s (grid %d)\n", hipGetErrorString(e), grid);
}
```

```cpp
#include <hip/hip_runtime.h>
#include <hip/hip_cooperative_groups.h>
#include <cstdio>
#include <cstdint>
namespace cg = cooperative_groups;

constexpr int NB = 8, LSEQ = 4096, DM = 1024, LCTX = 256, DEPTH = 2;
constexpr int MLAT = NB * LSEQ, MCTX = NB * LCTX, MT = MLAT + MCTX;
constexpr int DIN = 4624, NU1 = 2560, NU2 = 2048, NPK = NU1 + NU2;
constexpr int QK8_STRIDE = (LCTX + LSEQ) * 256 + 8192;
constexpr int LDU1 = 2048;
constexpr int NH = 4, HD = 128, DML = 512, DHY = 512;
constexpr float RMS_EPS = 1e-6f;
constexpr int NTHR = 512;
constexpr int LDS_BYTES = 147456;
#ifndef PROBE_PHASE
#define PROBE_PHASE -1
#endif
#ifndef PROBE_COUNT
#define PROBE_COUNT 1
#endif
#ifndef REP_PREP
#define REP_PREP 1
#endif
#ifndef REP_NORM
#define REP_NORM 1
#endif
#ifndef REP_GEMM1
#define REP_GEMM1 1
#endif
#ifndef REP_MLSTM
#define REP_MLSTM 1
#endif
#ifndef REP_HYENA
#define REP_HYENA 1
#endif
#ifndef REP_HYCTX
#define REP_HYCTX 1
#endif
#ifndef REP_COMB
#define REP_COMB 1
#endif
#ifndef REP_GEMM2
#define REP_GEMM2 1
#endif
#ifndef NAIVE_MLSTM
#define NAIVE_MLSTM 0
#endif
#ifndef NAIVE_HYENA
#define NAIVE_HYENA 0
#endif
#ifndef NAIVE_GEMM
#define NAIVE_GEMM 0
#endif

constexpr size_t MiB = 1u << 20;
constexpr size_t WS_CTL = 0;
constexpr size_t WS_MOD = 1 * MiB;
constexpr size_t WS_HDN = 2 * MiB;
constexpr size_t WS_HDNC = 4 * MiB;
constexpr size_t WS_GATES = 5 * MiB;
constexpr size_t WS_WGT = 512 * 1024;
constexpr size_t WS_GP = 4 * MiB + 256 * 1024;
constexpr size_t WS_XC1 = 8 * MiB;
constexpr size_t WS_WINT = 16 * MiB;
constexpr size_t WS_WOUTT = 34 * MiB;
constexpr size_t WS_HB = 40 * MiB;
constexpr size_t WS_U1 = 108 * MiB;
constexpr size_t WS_V2 = 244 * MiB;
constexpr size_t WS_UT = 280 * MiB;
constexpr size_t WS_YMIX = 416 * MiB;
constexpr size_t WS_FT = 485 * MiB;
constexpr size_t WS_END = 502 * MiB;

constexpr int CW_QUEUE = 4096;

typedef unsigned short bf16_t;
typedef float f32x4 __attribute__((ext_vector_type(4)));
typedef float f32x2 __attribute__((ext_vector_type(2)));
typedef unsigned u32x4 __attribute__((ext_vector_type(4)));
typedef unsigned u32x2 __attribute__((ext_vector_type(2)));

struct Args {
    const float* in[23];
    float* out;
    unsigned char* ws;
    int ph_lo, ph_hi;
    int rep_phase, rep_count;
};

__device__ __forceinline__ float bf2f(unsigned b) { return __uint_as_float(b << 16); }
__device__ __forceinline__ unsigned f2bf(float f) { unsigned u = __float_as_uint(f); return (u + 0x7fffu + ((u >> 16) & 1u)) >> 16; }
__device__ __forceinline__ unsigned pk2(float lo, float hi) { return f2bf(lo) | (f2bf(hi) << 16); }
__device__ __forceinline__ float bflo(unsigned x) { return __uint_as_float(x << 16); }
__device__ __forceinline__ float bfhi(unsigned x) { return __uint_as_float(x & 0xffff0000u); }
__device__ __forceinline__ float silu_f(float x) { return x / (1.f + __expf(-x)); }
__device__ __forceinline__ float sigmoid_f(float x) { return 1.f / (1.f + __expf(-x)); }
typedef const Args __attribute__((address_space(4)))* KArgsP;
__device__ __forceinline__ Args kargs() {
    int z = 0; asm volatile("" : "+s"(z));
    KArgsP p = (KArgsP)((const char __attribute__((address_space(4)))*)__builtin_amdgcn_kernarg_segment_ptr() + z);
    Args a;
#pragma unroll
    for (int i = 0; i < 23; ++i) a.in[i] = p->in[i];
    a.out = p->out; a.ws = p->ws; a.ph_lo = p->ph_lo; a.ph_hi = p->ph_hi; a.rep_phase = p->rep_phase; a.rep_count = p->rep_count;
    return a;
}
__device__ __forceinline__ int opaque_tid() { int t = threadIdx.x; asm volatile("" : "+v"(t)); return t; }
__device__ __forceinline__ float wave_sum(float v) {
#pragma unroll
    for (int o = 1; o < 64; o <<= 1) v += __shfl_xor(v, o);
    return v;
}

__device__ __forceinline__ void phase_prep(const Args& a, unsigned char* lds) {
    const int tid = opaque_tid(), G = gridDim.x;
    float* scr = (float*)lds;
    constexpr int IT_WIN = 2 * 16 * 72, IT_WOUT = 2 * 16 * 16, IT_MOD = 2 * 48, IT_HDN = 132, IT_WG = 2;
    constexpr int NIT = IT_WIN + IT_WOUT + IT_MOD + IT_HDN + IT_WG;
    bool s_loaded = false;
    for (int it = blockIdx.x; it < NIT; it += G) {
        int r = it;
        if (r < IT_WIN + IT_WOUT) {
            const float* W; bf16_t* WT; int N, kb, nb, srccol;
            if (r < IT_WIN) { const int l = r / (16 * 72); r %= 16 * 72; kb = r / 72; nb = r % 72; N = DIN;
                W = a.in[8] + (size_t)l * DM * DIN; WT = (bf16_t*)(a.ws + WS_WINT) + (size_t)l * NPK * DM; srccol = nb * 64 + (nb >= 40 ? 16 : 0); }
            else { r -= IT_WIN; const int l = r / 256; r %= 256; kb = r / 16; nb = r % 16; N = DM;
                W = a.in[22] + (size_t)l * DM * DM; WT = (bf16_t*)(a.ws + WS_WOUTT) + (size_t)l * DM * DM; srccol = nb * 64; }
            __syncthreads();
#pragma unroll
            for (int i = 0; i < 8; ++i) { const int e = tid + i * 512, kk = e >> 6, nn = e & 63; scr[kk * 65 + nn] = W[(size_t)(kb * 64 + kk) * N + srccol + nn]; }
            __syncthreads();
            { const int nn = tid >> 3, k8 = (tid & 7) * 8; u32x4 o;
              o.x = pk2(scr[(k8 + 0) * 65 + nn], scr[(k8 + 1) * 65 + nn]); o.y = pk2(scr[(k8 + 2) * 65 + nn], scr[(k8 + 3) * 65 + nn]);
              o.z = pk2(scr[(k8 + 4) * 65 + nn], scr[(k8 + 5) * 65 + nn]); o.w = pk2(scr[(k8 + 6) * 65 + nn], scr[(k8 + 7) * 65 + nn]);
              *(u32x4*)(WT + (size_t)(nb * 64 + nn) * DM + kb * 64 + k8) = o; }
            continue;
        }
        r -= IT_WIN + IT_WOUT;
        if (r < IT_MOD) {
            const int l = r / 48, cb = r % 48;
            float* S = scr + 8192;
            float* P = scr;
            __syncthreads();
            if (!s_loaded) {
                for (int i = tid; i < 9 * 1024; i += 512) { const int v = i >> 10, k = i & 1023; const float cv = (v < 8) ? a.in[1][v * 1024 + k] : a.in[3][k]; S[i] = silu_f(cv); }
                s_loaded = true;
            }
            __syncthreads();
            const int kg = tid >> 6, col = cb * 64 + (tid & 63);
            const float* W = a.in[4] + (size_t)l * DM * 3072;
            float acc[9];
#pragma unroll
            for (int v = 0; v < 9; ++v) acc[v] = 0.f;
            for (int k = kg * 128; k < kg * 128 + 128; ++k) { const float w = W[(size_t)k * 3072 + col];
#pragma unroll
                for (int v = 0; v < 9; ++v) acc[v] += S[v * 1024 + k] * w; }
#pragma unroll
            for (int v = 0; v < 9; ++v) P[(kg * 9 + v) * 64 + (tid & 63)] = acc[v];
            __syncthreads();
            for (int i = tid; i < 9 * 64; i += 512) { const int v = i >> 6, cc = i & 63; float s = a.in[5][l * 3072 + cb * 64 + cc];
#pragma unroll
                for (int g = 0; g < 8; ++g) s += P[(g * 9 + v) * 64 + cc];
                ((float*)(a.ws + WS_MOD))[(size_t)(l * 9 + v) * 3072 + cb * 64 + cc] = s; }
            continue;
        }
        r -= IT_MOD;
        if (r >= IT_HDN) {
            const int l = r - IT_HDN; const float* w = a.in[8] + (size_t)l * DM * DIN; bf16_t* wg = (bf16_t*)(a.ws + WS_WGT) + (size_t)l * 16 * 1024;
            for (int i = tid; i < 16384; i += 512) wg[(i & 15) * 1024 + (i >> 4)] = (bf16_t)f2bf(w[(size_t)(i >> 4) * DIN + 2560 + (i & 15)]);
            continue;
        }
        {
            __syncthreads();
            float* W1 = scr;
            float* W2 = scr + 17 * 64;
            float* B1 = W2 + 64 * 64; float* B2 = B1 + 64; float* F0 = B2 + 64; float* F1 = F0 + 64;
            float* FT = F1 + 64;
            float* H1 = FT + 8 * 17;
            const int lb = ((r * 64) < 8192) ? ((r * 64) >> 12) : 0;
            for (int i = tid; i < 17 * 64; i += 512) W1[i] = a.in[15][lb * 17 * 64 + i];
            for (int i = tid; i < 64 * 64; i += 512) W2[i] = a.in[18][lb * 64 * 64 + i];
            if (tid < 64) { B1[tid] = a.in[16][lb * 64 + tid]; B2[tid] = a.in[19][lb * 64 + tid]; F0[tid] = a.in[17][lb * 128 + tid]; F1[tid] = a.in[17][lb * 128 + 64 + tid]; }
            const int j = tid & 63, pg = tid >> 6;
            for (int sub = 0; sub < 8; ++sub) {
                const int p = r * 64 + sub * 8 + pg;
                const int L = (p < 8192) ? 4096 : 256; const int pos = (p < 8192) ? (p & 4095) : (p - 8192);
                __syncthreads();
                if (j < 17) { float f;
                    if (j == 0) f = (float)pos / (float)L;
                    else { const int bnd = (j <= 8) ? j : j - 8; const float ang = (6.283185307179586f / (float)L) * (float)pos * (float)bnd; f = (j <= 8) ? sinf(ang) : cosf(ang); }
                    FT[pg * 17 + j] = f; }
                __syncthreads();
                { float s = B1[j];
#pragma unroll
                  for (int f = 0; f < 17; ++f) s += FT[pg * 17 + f] * W1[f * 64 + j];
                  H1[pg * 64 + j] = sinf(F0[j] * s); }
                __syncthreads();
                { float s = B2[j];
#pragma unroll 8
                  for (int i = 0; i < 64; ++i) s += H1[pg * 64 + i] * W2[i * 64 + j];
                  float* dst = (p < 8192) ? (float*)(a.ws + WS_HDN) + (size_t)p * 64 : (float*)(a.ws + WS_HDNC) + (size_t)pos * 64;
                  dst[j] = sinf(F1[j] * s); }
            }
        }
    }
    __syncthreads();
}

__device__ __forceinline__ void phase_norm(const Args& a, int l, bool has_prev, bool do_next, unsigned char* lds) {
    const int tid = opaque_tid(), G = gridDim.x, lane = tid & 63, wave = tid >> 6;
    const float* MOD = (const float*)(a.ws + WS_MOD);
    const bf16_t* Y = (const bf16_t*)(a.ws + WS_U1);
    bf16_t* HB = (bf16_t*)(a.ws + WS_HB);
    float* XC1 = (float*)(a.ws + WS_XC1);
    const int nrows = do_next ? MT : MLAT;
    const bool from_out = !(l == 0 || (has_prev && l == 1));
    const float* xlat = from_out ? (const float*)a.out : a.in[0]; const float* xctx = a.in[2];
#define XSRC(row) (((row) >= MLAT) ? xctx + (size_t)((row) - MLAT) * DM : xlat + (size_t)(row) * DM)
    f32x4 nx[4]; u32x2 ny[4];
    int row = blockIdx.x * 8 + wave;
    if (row < nrows) {
#pragma unroll
        for (int j = 0; j < 4; ++j) { nx[j] = ((const f32x4*)XSRC(row))[lane + 64 * j]; ny[j] = has_prev ? ((const u32x2*)(Y + (size_t)row * DM))[lane + 64 * j] : (u32x2){0u, 0u}; }
    }
    for (; row < nrows; row += G * 8) {
        const bool is_ctx = row >= MLAT; const int mv = is_ctx ? 8 : (row >> 12);
        float* xout = is_ctx ? XC1 + (size_t)(row - MLAT) * DM : a.out + (size_t)row * DM;
        f32x4 xv[4]; u32x2 yr[4];
#pragma unroll
        for (int j = 0; j < 4; ++j) { xv[j] = nx[j]; yr[j] = ny[j]; }
        const int nrow = row + G * 8;
        if (nrow < nrows) {
#pragma unroll
            for (int j = 0; j < 4; ++j) { nx[j] = ((const f32x4*)XSRC(nrow))[lane + 64 * j]; ny[j] = has_prev ? ((const u32x2*)(Y + (size_t)nrow * DM))[lane + 64 * j] : (u32x2){0u, 0u}; }
        }
        if (has_prev) {
            const int lp = l - 1;
            f32x4 yv[4]; float ss = 0.f;
#pragma unroll
            for (int j = 0; j < 4; ++j) { yv[j] = (f32x4){bflo(yr[j].x), bfhi(yr[j].x), bflo(yr[j].y), bfhi(yr[j].y)}; ss += yv[j].x * yv[j].x + yv[j].y * yv[j].y + yv[j].z * yv[j].z + yv[j].w * yv[j].w; }
            const float r = rsqrtf(wave_sum(ss) * (1.f / DM) + RMS_EPS);
#pragma unroll
            for (int j = 0; j < 4; ++j) { const f32x4 gt = ((const f32x4*)(MOD + (size_t)(lp * 9 + mv) * 3072 + 2048))[lane + 64 * j]; const f32x4 pg = ((const f32x4*)(a.in[7] + lp * DM))[lane + 64 * j];
                xv[j] = xv[j] + gt * (yv[j] * r * pg); ((f32x4*)xout)[lane + 64 * j] = xv[j]; }
        }
        if (do_next) {
            float ss = 0.f;
#pragma unroll
            for (int j = 0; j < 4; ++j) ss += xv[j].x * xv[j].x + xv[j].y * xv[j].y + xv[j].z * xv[j].z + xv[j].w * xv[j].w;
            const float r = rsqrtf(wave_sum(ss) * (1.f / DM) + RMS_EPS);
#pragma unroll
            for (int j = 0; j < 4; ++j) {
                const f32x4 pg = ((const f32x4*)(a.in[6] + l * DM))[lane + 64 * j];
                const f32x4 sh = ((const f32x4*)(MOD + (size_t)(l * 9 + mv) * 3072))[lane + 64 * j];
                const f32x4 sc = ((const f32x4*)(MOD + (size_t)(l * 9 + mv) * 3072 + 1024))[lane + 64 * j];
                const f32x4 h = xv[j] * r * pg * (sc + 1.f) + sh;
                u32x2 o; o.x = pk2(h.x, h.y); o.y = pk2(h.z, h.w);
                ((u32x2*)(HB + (size_t)row * DM))[lane + 64 * j] = o;
            }
        }
    }
#undef XSRC
    __syncthreads();
}

__device__ __forceinline__ void gemm_naive(const bf16_t* A, const bf16_t* Bt, int M, int N, int K, void* out, int ldo, int mode, unsigned char* lds) {
    const int tid = opaque_tid(), G = gridDim.x;
    float* As = (float*)lds;
    float* Bs = As + 64 * 33;
    const int ntm = M / 64, ntn = N / 64;
    const int ty = tid >> 4, tx = tid & 15;
    for (int t = blockIdx.x; t < ntm * ntn; t += G) {
        const int tm = t / ntn, tn = t % ntn;
        float acc[2][4] = {};
        for (int k0 = 0; k0 < K; k0 += 32) {
            __syncthreads();
            { const int r = tid >> 3, c4 = (tid & 7) * 4;
              const u32x2 va = *(const u32x2*)(A + (size_t)(tm * 64 + r) * K + k0 + c4);
              As[r * 33 + c4] = bf2f(va.x & 0xffff); As[r * 33 + c4 + 1] = bf2f(va.x >> 16); As[r * 33 + c4 + 2] = bf2f(va.y & 0xffff); As[r * 33 + c4 + 3] = bf2f(va.y >> 16);
              const u32x2 vb = *(const u32x2*)(Bt + (size_t)(tn * 64 + r) * K + k0 + c4);
              Bs[r * 33 + c4] = bf2f(vb.x & 0xffff); Bs[r * 33 + c4 + 1] = bf2f(vb.x >> 16); Bs[r * 33 + c4 + 2] = bf2f(vb.y & 0xffff); Bs[r * 33 + c4 + 3] = bf2f(vb.y >> 16); }
            __syncthreads();
#pragma unroll 8
            for (int kk = 0; kk < 32; ++kk) {
                const float a0 = As[(ty * 2) * 33 + kk], a1 = As[(ty * 2 + 1) * 33 + kk];
#pragma unroll
                for (int j = 0; j < 4; ++j) { const float b = Bs[(tx * 4 + j) * 33 + kk]; acc[0][j] += a0 * b; acc[1][j] += a1 * b; }
            }
        }
#pragma unroll
        for (int i = 0; i < 2; ++i)
#pragma unroll
            for (int j = 0; j < 4; ++j) { const size_t r = tm * 64 + ty * 2 + i, c = tn * 64 + tx * 4 + j;
                if (mode == 0) ((bf16_t*)out)[r * ldo + c] = (bf16_t)f2bf(acc[i][j]);
                else if (mode == 1) ((bf16_t*)out)[c * ldo + r] = (bf16_t)f2bf(acc[i][j]);
                else ((float*)out)[r * ldo + c] = acc[i][j]; }
    }
    __syncthreads();
}


namespace pg8 {
#define PG8_LAS __attribute__((address_space(3)))
typedef short bf16x8 __attribute__((ext_vector_type(8)));
constexpr int BM = 256, BK = 64, HALF = 128, HTB = HALF * BK * 2, STAGE_BYTES = 8 * HTB, NXCD = 8, WGM = 8;
__device__ __forceinline__ int lds_byte(int r, int c) { const int st = (r >> 4) * 2 + (c >> 5), rr = r & 15, cc = c & 31, ob = rr * 64 + cc * 2; return st * 1024 + (ob ^ (((ob >> 9) & 1) << 5)); }
__device__ __forceinline__ void stage_rc(int b, int& R, int& C) { const int st = b / 1024, sb = b % 1024, swz = sb ^ (((sb >> 9) & 1) << 5); R = (st >> 1) * 16 + swz / 64; C = (st & 1) * 32 + (swz % 64) / 2; }
__device__ __forceinline__ int perm32(int rho) { const int n = rho >> 4, i = rho & 15; return 8 * (i >> 2) + 4 * n + (i & 3); }
__device__ __forceinline__ unsigned cvt_pk_bf16(float lo, float hi) { unsigned r; asm volatile("v_cvt_pk_bf16_f32 %0, %1, %2" : "=v"(r) : "v"(lo), "v"(hi)); return r; }

struct Unit { const char* A; const char* B; char* out; int ldo, r0, c0, bjs; };

template <class Dec> struct GridOrder {
    int nM, nN, nwg, G, c; Dec dec;
    __device__ void init(int nM_, int nN_, int G_, int c_, const Dec& d) { nM = nM_; nN = nN_; nwg = nM * nN; G = G_; c = c_; dec = d; }
    __device__ bool next(int i, Unit& u) const {
        const long L = (long)i * G + c; if (L >= nwg) return false;
        int wgid = (int)L; { const int q = nwg / NXCD, r = nwg % NXCD, xcd = wgid % NXCD, off = wgid / NXCD; wgid = (xcd < r ? xcd * (q + 1) : r * (q + 1) + (xcd - r) * q) + off; }
        const int nig = WGM * nN, gid = wgid / nig, fm = gid * WGM, gsz = (nM - fm) < WGM ? (nM - fm) : WGM;
        const int pm = fm + ((wgid % nig) % gsz), pn = (wgid % nig) / gsz; dec(pm, pn, u); return true;
    }
};

template <bool PERM, class Sched>
__device__ __forceinline__ void gemm_phase(PG8_LAS unsigned char* lds, const int K, const Sched& S) {
    const int tid = opaque_tid(), wid = __builtin_amdgcn_readfirstlane(tid >> 6), lane = tid & 63, wr = wid >> 2, wc = wid & 3, fr = lane & 15, fq = lane >> 4;
    const int nt = K / BK;
    unsigned voffA[2], voffB[2];
#pragma unroll
    for (int i = 0; i < 2; ++i) { int R, C; stage_rc(tid * 16 + i * 8192, R, C); const int Rb = PERM ? ((R & ~31) + perm32(R & 31)) : R;
        voffA[i] = (unsigned)(R * K + C) * 2u; voffB[i] = (unsigned)(Rb * K + C) * 2u; }
    const size_t kstep = (size_t)(BK * 2);
    const size_t hstep = (size_t)HALF * K * 2;
    const unsigned ldsw = (unsigned)wid * 1024u;
    const int aoff = lds_byte(wr * 64 + fr, fq * 8), boff = lds_byte(wc * 32 + fr, fq * 8);
#define PG8_SA(b, h) (((b) * 2 + (h)) * HTB)
#define PG8_SB(b, h) ((4 + (b) * 2 + (h)) * HTB)
#define PG8_STAGE(bufoff, gbase, voff) do { _Pragma("unroll") for (int _i = 0; _i < 2; ++_i) \
        __builtin_amdgcn_global_load_lds((const unsigned*)((const char*)(gbase) + (voff)[_i]), (PG8_LAS unsigned*)(lds + (bufoff) + ldsw + _i * 8192), 16, 0, 0); } while (0)
#define PG8_LDA(dst, b, h) do { _Pragma("unroll") for (int m = 0; m < 4; ++m) _Pragma("unroll") for (int k = 0; k < 2; ++k) dst[m][k] = *(const PG8_LAS bf16x8*)(lds + PG8_SA(b, h) + aoff + m * 2048 + k * 1024); } while (0)
#define PG8_LDB(dst, b, h) do { _Pragma("unroll") for (int n = 0; n < 2; ++n) _Pragma("unroll") for (int k = 0; k < 2; ++k) dst[n][k] = *(const PG8_LAS bf16x8*)(lds + PG8_SB(b, h) + boff + n * 2048 + k * 1024); } while (0)
#define PG8_MMA(ai, bj, At, Bt) do { __builtin_amdgcn_s_setprio(1); _Pragma("unroll") for (int m = 0; m < 4; ++m) _Pragma("unroll") for (int n = 0; n < 2; ++n) _Pragma("unroll") for (int k = 0; k < 2; ++k) \
        acc[ai][bj][m][n] = __builtin_amdgcn_mfma_f32_16x16x32_bf16(Bt[n][k], At[m][k], acc[ai][bj][m][n], 0, 0, 0); __builtin_amdgcn_s_setprio(0); } while (0)
#define PG8_WAIT_V(n) asm volatile("s_waitcnt vmcnt(" #n ")" ::: "memory")
#define PG8_WAIT_L(n) asm volatile("s_waitcnt lgkmcnt(" #n ")" ::: "memory")
#define PG8_BAR __builtin_amdgcn_s_barrier()
#define PG8_SCHED __builtin_amdgcn_sched_barrier(0)
    Unit cur, nxt; int ui = 0;
    if (!S.next(0, cur)) return;
    f32x4 acc[2][2][4][2];
#pragma unroll
    for (int a = 0; a < 2; ++a)
#pragma unroll
        for (int b = 0; b < 2; ++b)
#pragma unroll
            for (int m = 0; m < 4; ++m)
#pragma unroll
                for (int n = 0; n < 2; ++n) acc[a][b][m][n] = (f32x4){0.f, 0.f, 0.f, 0.f};
    bf16x8 At[4][2], B0[2][2], B1[2][2];
    const char* cA = cur.A; const char* cB = cur.B;
    PG8_STAGE(PG8_SB(0, 0), cB, voffB); PG8_STAGE(PG8_SA(0, 0), cA, voffA); PG8_STAGE(PG8_SB(0, 1), cB + hstep, voffB); PG8_STAGE(PG8_SA(0, 1), cA + hstep, voffA);
    if (wr == 1) PG8_BAR;
    PG8_WAIT_V(4); PG8_BAR;
    PG8_STAGE(PG8_SB(1, 0), cB + kstep, voffB); PG8_STAGE(PG8_SA(1, 0), cA + kstep, voffA); PG8_STAGE(PG8_SB(1, 1), cB + hstep + kstep, voffB);
    PG8_WAIT_V(6); PG8_BAR;
    for (;;) {
        const bool has_next = S.next(ui + 1, nxt);
        const char* nA = has_next ? nxt.A : cA; const char* nB = has_next ? nxt.B : cB;
        for (int t = 0; t < nt; t += 2) {
            const bool last = (t == nt - 2);
            const char* a1 = cA + (size_t)(t + 1) * kstep;
            const char* a2 = last ? nA : cA + (size_t)(t + 2) * kstep; const char* b2 = last ? nB : cB + (size_t)(t + 2) * kstep;
            const char* a3 = a2 + kstep; const char* b3 = b2 + kstep;
            PG8_LDB(B0, 0, 0); PG8_SCHED; PG8_LDA(At, 0, 0); PG8_STAGE(PG8_SA(1, 1), a1 + hstep, voffA);
            PG8_WAIT_L(8); PG8_BAR; PG8_WAIT_L(0); PG8_MMA(0, 0, At, B0); PG8_BAR; PG8_SCHED;
            PG8_LDB(B1, 0, 1); PG8_STAGE(PG8_SB(0, 0), b2, voffB);
            PG8_BAR; PG8_WAIT_L(0); PG8_MMA(0, 1, At, B1); PG8_BAR;
            PG8_LDA(At, 0, 1); PG8_STAGE(PG8_SA(0, 0), a2, voffA);
            PG8_BAR; PG8_WAIT_L(0); PG8_MMA(1, 0, At, B0); PG8_BAR; PG8_SCHED;
            PG8_STAGE(PG8_SB(0, 1), b2 + hstep, voffB);
            PG8_WAIT_V(6); PG8_BAR; PG8_MMA(1, 1, At, B1); PG8_BAR;
            PG8_LDB(B0, 1, 0); PG8_SCHED; PG8_LDA(At, 1, 0); PG8_STAGE(PG8_SA(0, 1), a2 + hstep, voffA);
            PG8_WAIT_L(8); PG8_BAR; PG8_WAIT_L(0); PG8_MMA(0, 0, At, B0); PG8_BAR; PG8_SCHED;
            PG8_LDB(B1, 1, 1); PG8_STAGE(PG8_SB(1, 0), b3, voffB);
            PG8_BAR; PG8_WAIT_L(0); PG8_MMA(0, 1, At, B1); PG8_BAR;
            PG8_LDA(At, 1, 1); PG8_STAGE(PG8_SA(1, 0), a3, voffA);
            PG8_BAR; PG8_WAIT_L(0); PG8_MMA(1, 0, At, B0); PG8_BAR; PG8_SCHED;
            PG8_STAGE(PG8_SB(1, 1), b3 + hstep, voffB);
            PG8_WAIT_V(6); PG8_BAR; PG8_MMA(1, 1, At, B1); PG8_BAR;
        }
        {
            const int row0 = cur.r0 + wr * 64 + fr;
            if (PERM) {
                bf16_t* base = (bf16_t*)cur.out; const int col0 = cur.c0 + wc * 32 + 8 * fq;
#pragma unroll
                for (int ai = 0; ai < 2; ++ai)
#pragma unroll
                    for (int m = 0; m < 4; ++m) { bf16_t* rowp = base + (size_t)(row0 + ai * HALF + m * 16) * cur.ldo + col0;
#pragma unroll
                        for (int bj = 0; bj < 2; ++bj) { const f32x4 v0 = acc[ai][bj][m][0], v1 = acc[ai][bj][m][1];
                            u32x4 w; w.x = cvt_pk_bf16(v0[0], v0[1]); w.y = cvt_pk_bf16(v0[2], v0[3]); w.z = cvt_pk_bf16(v1[0], v1[1]); w.w = cvt_pk_bf16(v1[2], v1[3]);
                            *(u32x4*)(rowp + bj * cur.bjs) = w; } }
            } else {
                float* base = (float*)cur.out; const int col0 = cur.c0 + wc * 32 + 4 * fq;
#pragma unroll
                for (int ai = 0; ai < 2; ++ai)
#pragma unroll
                    for (int m = 0; m < 4; ++m) { float* rowp = base + (size_t)(row0 + ai * HALF + m * 16) * cur.ldo + col0;
#pragma unroll
                        for (int bj = 0; bj < 2; ++bj)
#pragma unroll
                            for (int n = 0; n < 2; ++n) *(f32x4*)(rowp + bj * cur.bjs + n * 16) = acc[ai][bj][m][n]; }
            }
        }
        if (!has_next) break;
#pragma unroll
        for (int a = 0; a < 2; ++a)
#pragma unroll
            for (int b = 0; b < 2; ++b)
#pragma unroll
                for (int m = 0; m < 4; ++m)
#pragma unroll
                    for (int n = 0; n < 2; ++n) acc[a][b][m][n] = (f32x4){0.f, 0.f, 0.f, 0.f};
        cur = nxt; cA = nA; cB = nB; ++ui;
    }
    PG8_WAIT_V(0);
    if (wr == 0) PG8_BAR;
    PG8_BAR;
#undef PG8_SA
#undef PG8_SB
#undef PG8_STAGE
#undef PG8_LDA
#undef PG8_LDB
#undef PG8_MMA
#undef PG8_WAIT_V
#undef PG8_WAIT_L
#undef PG8_BAR
#undef PG8_SCHED
}
}

struct DecIn {
    const char* HB; const char* W; char* U1; char* UT;
    __device__ void operator()(int pm, int pn, pg8::Unit& u) const {
        const char* tp = HB + (size_t)pm * 256 * DM * 2; const char* wp = W + (size_t)pn * 256 * DM * 2;
        u.bjs = 128;
        if (pn < 4) { u.A = tp; u.B = wp; u.out = U1; u.ldo = LDU1; u.r0 = pm * 256; u.c0 = pn * 256; }
        else if (pn < 6) {
            const int bb = pm < 128 ? pm >> 4 : pm - 128, srow0 = pm < 128 ? LCTX + (pm & 15) * 256 : 0;
            u.A = tp; u.B = wp; u.out = U1 + (WS_V2 - WS_U1) + ((size_t)(bb * 4 + 2 * (pn - 4)) * (LCTX + LSEQ) + srow0) * 128 * 2; u.ldo = 128; u.r0 = 0; u.c0 = 0; u.bjs = (LCTX + LSEQ) * 128; }
        else if (pn < 10) { u.A = tp; u.B = wp; u.out = U1; u.ldo = LDU1; u.r0 = pm * 256; u.c0 = (pn - 2) * 256; }
        else { u.A = wp; u.B = tp; u.out = UT; u.ldo = MT; u.r0 = (pn - 10) * 256; u.c0 = pm * 256; }
    }
};
struct DecOut {
    const char* YM; const char* W; char* Y;
    __device__ void operator()(int pm, int pn, pg8::Unit& u) const {
        u.A = YM + (size_t)pm * 256 * DM * 2; u.B = W + (size_t)pn * 256 * DM * 2; u.out = Y; u.ldo = DM; u.r0 = pm * 256; u.c0 = pn * 256; u.bjs = 128;
    }
};

__device__ __forceinline__ void mlstm_naive(const Args& a, int l, unsigned char* lds) {
    const int tid = opaque_tid(), G = gridDim.x;
    const bf16_t* U1 = (const bf16_t*)(a.ws + WS_U1);
    const float* GATES = (const float*)(a.ws + WS_GATES);
    bf16_t* HDo = (bf16_t*)(a.ws + WS_HB);
    float* qs = (float*)lds; float* ks = qs + 128; float* vs = ks + 128; float* sc = vs + 32;
    float* pnum = sc + 8;
    float* pden = pnum + 512;
    const float* cw = a.in[10] + (size_t)l * 3 * 1024; const float* cb = a.in[11] + (size_t)l * 1024;
    for (int it = blockIdx.x; it < 256; it += G) {
        const int dvs = it & 3, dir = (it >> 2) & 1, hh = (it >> 3) & 3, b = it >> 5;
        float C[8], nn[8];
#pragma unroll
        for (int i = 0; i < 8; ++i) { C[i] = 0.f; nn[i] = 0.f; }
        float m = 0.f;
        const int j = tid & 31, dg = tid >> 5;
        for (int step = 0; step < LCTX + LSEQ; ++step) {
            int seqlen, tt, rowbase; bool is_ctx = step < LCTX;
            if (is_ctx) { seqlen = LCTX; tt = dir ? (LCTX - 1 - step) : step; rowbase = MLAT + b * LCTX; }
            else { seqlen = LSEQ; const int s2 = step - LCTX; tt = dir ? (LSEQ - 1 - s2) : s2; rowbase = b * LSEQ; }
            const int row = rowbase + tt;
            if (tid < 256) {
                const int ch = (tid < 128) ? (hh * 128 + tid) : (512 + hh * 128 + (tid - 128));
                bool has_l, has_r;
                if (is_ctx) { has_l = tt > 0; has_r = tt < seqlen - 1; } else { has_l = (tt & 63) != 0; has_r = (tt & 63) != 63; }
                float v = bf2f(U1[(size_t)row * NU1 + ch]) * cw[1024 + ch] + cb[ch];
                if (has_l) v += bf2f(U1[(size_t)(row - 1) * NU1 + ch]) * cw[ch];
                if (has_r) v += bf2f(U1[(size_t)(row + 1) * NU1 + ch]) * cw[2048 + ch];
                v = silu_f(v);
                if (tid < 128) qs[tid] = v; else ks[tid - 128] = v * 0.08838834764831845f;
            } else if (tid < 288) {
                vs[tid - 256] = bf2f(U1[(size_t)row * NU1 + 1024 + hh * 128 + dvs * 32 + (tid - 256)]);
            } else if (tid == 288) {
                const float ip = GATES[(size_t)row * 16 + (2 * dir) * 4 + hh], fp = GATES[(size_t)row * 16 + (2 * dir + 1) * 4 + hh];
                const float logf = fminf(fp, 0.f) - log1pf(__expf(-fabsf(fp)));
                const float mn = fmaxf(logf + m, ip);
                sc[0] = __expf(logf + m - mn); sc[1] = __expf(ip - mn); sc[2] = __expf(-mn);
                m = mn;
            }
            __syncthreads();
            const float fw = sc[0], iw = sc[1];
            float pn = 0.f, pd = 0.f;
#pragma unroll
            for (int dd = 0; dd < 8; ++dd) { const int d = dg * 8 + dd; const float kk = ks[d], qq = qs[d];
                C[dd] = fw * C[dd] + iw * kk * vs[j]; nn[dd] = fw * nn[dd] + iw * kk; pn += qq * C[dd]; pd += qq * nn[dd]; }
            pnum[dg * 32 + j] = pn; if (j == 0) pden[dg] = pd;
            __syncthreads();
            if (tid < 32) { float num = 0.f, den = 0.f;
#pragma unroll
                for (int g = 0; g < 16; ++g) { num += pnum[g * 32 + tid]; den += pden[g]; }
                const float h = num / fmaxf(fabsf(den), sc[2]);
                HDo[((size_t)dir * MT + row) * DML + hh * 128 + dvs * 32 + tid] = (bf16_t)f2bf(h); }
        }
        __syncthreads();
    }
}


#define LAS __attribute__((address_space(3)))
typedef short bf16x8 __attribute__((ext_vector_type(8)));
__device__ __forceinline__ u32x4 ldg16_or_zero(const bf16_t* p, bool ok) { u32x4 z = {0u, 0u, 0u, 0u}; return ok ? *(const u32x4*)p : z; }


__device__ __forceinline__ void filt_item(const Args& a, int l, unsigned char* lds_, int fi);
__device__ __forceinline__ void phase_mprep(const Args& a, int l, unsigned char* lds_, int rep) {
    const int tid = opaque_tid(), lane = tid & 63, wave = __builtin_amdgcn_readfirstlane(tid >> 6), fr = lane & 15, fq = lane >> 4;
    LAS float* P = (LAS float*)lds_;
    LAS float* Gs = P + 2048;
    LAS bf16_t* WgS = (LAS bf16_t*)((LAS unsigned char*)lds_ + 32768);
    LAS unsigned* qslot = (LAS unsigned*)((LAS unsigned char*)lds_ + (LDS_BYTES - 32));
    const bf16_t* U1 = (const bf16_t*)(a.ws + WS_U1);
    const bf16_t* HB = (const bf16_t*)(a.ws + WS_HB);
    const bf16_t* WgT = (const bf16_t*)(a.ws + WS_WGT) + (size_t)l * 16 * 1024;
    bf16_t* QK = (bf16_t*)(a.ws + WS_YMIX);
    float* GP = (float*)(a.ws + WS_GP);
    const float* cw = a.in[10] + (size_t)l * 3072; const float* cb = a.in[11] + (size_t)l * 1024;
    unsigned* ctr = (unsigned*)(a.ws + WS_CTL) + CW_QUEUE + 64 * (16 + l * 8 + rep);
    const int co = tid & 127, rg4 = tid >> 7;
    __syncthreads();
    for (int i = tid; i < 16 * 128; i += NTHR) { const int g = i >> 7, c8 = (i & 127) * 8; *(LAS u32x4*)(WgS + g * 1032 + c8) = *(const u32x4*)(WgT + g * 1024 + c8); }
    for (;;) {
        __syncthreads();
        if (tid == 0) *qslot = __hip_atomic_fetch_add(ctr, 1u, __ATOMIC_RELAXED, __HIP_MEMORY_SCOPE_AGENT);
        __syncthreads();
        const int item = (int)*qslot;
        if (item >= 128 + MT / 64) break;
        if (item < 128) { filt_item(a, l, lds_, item); continue; }
        const int ch = item - 128;
        const int rowbase = ch * 64;
        const bool is_ctx = rowbase >= MLAT; const int cc = is_ctx ? ((rowbase - MLAT) >> 6) & 3 : 0;
        const bool has_lo = is_ctx && cc > 0, has_hi = is_ctx && cc < 3;
        {
            const int rt = wave & 3, kh = wave >> 2;
            f32x4 acc = {0.f, 0.f, 0.f, 0.f};
            const bf16_t* ap = HB + (size_t)(rowbase + rt * 16 + fr) * DM + kh * 512 + fq * 8;
            LAS const bf16_t* bp = WgS + fr * 1032 + kh * 512 + fq * 8;
            bf16x8 af[16];
#pragma unroll
            for (int ks = 0; ks < 16; ++ks) af[ks] = *(const bf16x8*)(ap + ks * 32);
#pragma unroll
            for (int ks = 0; ks < 16; ++ks) { const bf16x8 bf = *(const LAS bf16x8*)(bp + ks * 32); acc = __builtin_amdgcn_mfma_f32_16x16x32_bf16(af[ks], bf, acc, 0, 0, 0); }
#pragma unroll
            for (int jj = 0; jj < 4; ++jj) P[(kh * 64 + rt * 16 + 4 * fq + jj) * 16 + fr] = acc[jj];
        }
        {
            float w0[8], w1[8], w2[8], bb[8];
#pragma unroll
            for (int e = 0; e < 8; ++e) { w0[e] = cw[co * 8 + e]; w1[e] = cw[1024 + co * 8 + e]; w2[e] = cw[2048 + co * 8 + e]; bb[e] = cb[co * 8 + e]; }
            u32x4 r0, r1, r2;
            { const int tt = rg4 * 16 - 1; r0 = ldg16_or_zero(U1 + (size_t)(rowbase + tt) * LDU1 + co * 8, tt >= 0 || has_lo); }
            r1 = *(const u32x4*)(U1 + (size_t)(rowbase + rg4 * 16) * LDU1 + co * 8);
            const int qb = is_ctx ? (rowbase - MLAT) >> 8 : rowbase >> 12, srow0 = is_ctx ? (rowbase - MLAT) & 255 : LCTX + (rowbase & 4095);
            unsigned char* qdst = (unsigned char*)QK + (size_t)(qb * 4 + ((co & 63) >> 4)) * QK8_STRIDE + (size_t)srow0 * 256 + (co >> 6) * 128 + (co & 15) * 8;
#pragma unroll 4
            for (int i = 0; i < 16; ++i) { const int tt = rg4 * 16 + i;
                r2 = ldg16_or_zero(U1 + (size_t)(rowbase + tt + 1) * LDU1 + co * 8, tt + 1 <= 63 || has_hi);
                float fv[8];
#pragma unroll
                for (int e2 = 0; e2 < 4; ++e2) {
                    fv[2 * e2] = silu_f(bflo(r0[e2]) * w0[2 * e2] + bflo(r1[e2]) * w1[2 * e2] + bflo(r2[e2]) * w2[2 * e2] + bb[2 * e2]);
                    fv[2 * e2 + 1] = silu_f(bfhi(r0[e2]) * w0[2 * e2 + 1] + bfhi(r1[e2]) * w1[2 * e2 + 1] + bfhi(r2[e2]) * w2[2 * e2 + 1] + bb[2 * e2 + 1]); }
                int p0 = 0, p1 = 0;
                p0 = __builtin_amdgcn_cvt_pk_fp8_f32(fv[0], fv[1], p0, false); p0 = __builtin_amdgcn_cvt_pk_fp8_f32(fv[2], fv[3], p0, true);
                p1 = __builtin_amdgcn_cvt_pk_fp8_f32(fv[4], fv[5], p1, false); p1 = __builtin_amdgcn_cvt_pk_fp8_f32(fv[6], fv[7], p1, true);
                *(u32x2*)(qdst + (size_t)tt * 256) = (u32x2){(unsigned)p0, (unsigned)p1};
                r0 = r1; r1 = r2; }
        }
        __syncthreads();
        for (int i = tid; i < 1024; i += NTHR) Gs[i] = P[i] + P[1024 + i] + a.in[9][l * 16 + (i & 15)];
        __syncthreads();
        {
            const int dir = wave >> 2, hh = wave & 3, tt = dir ? 63 - lane : lane;
            const float gi = Gs[tt * 16 + (2 * dir) * 4 + hh], gf = Gs[tt * 16 + (2 * dir + 1) * 4 + hh];
            const float logf = fminf(gf, 0.f) - log1pf(__expf(-fabsf(gf)));
            float bc = logf;
#pragma unroll
            for (int ofs = 1; ofs < 64; ofs <<= 1) { const float t = __shfl_up(bc, ofs); if (lane >= ofs) bc += t; }
            const float av = gi - bc;
            float cm = av;
#pragma unroll
            for (int ofs = 1; ofs < 64; ofs <<= 1) { const float t = __shfl_up(cm, ofs); if (lane >= ofs) cm = fmaxf(cm, t); }
            float* gp = GP + ((size_t)ch * 8 + wave) * 192;
            gp[lane] = bc; gp[64 + lane] = av; gp[128 + lane] = cm;
        }
    }
    __syncthreads();
}

__device__ __forceinline__ void dec16_fp8(const u32x4 raw, float (&f)[16]) {
#pragma unroll
    for (int e = 0; e < 4; ++e) { const f32x2 lo = __builtin_amdgcn_cvt_pk_f32_fp8((int)raw[e], false), hi = __builtin_amdgcn_cvt_pk_f32_fp8((int)raw[e], true);
        f[4 * e] = lo.x; f[4 * e + 1] = lo.y; f[4 * e + 2] = hi.x; f[4 * e + 3] = hi.y; }
}
__device__ __forceinline__ void mlstm_item(const Args& a, int l, unsigned char* lds_, int it, bool do_store) {
    const int tid = opaque_tid(), lane = tid & 63, wave = __builtin_amdgcn_readfirstlane(tid >> 6), fr = lane & 15, fq = lane >> 4;
    LAS unsigned char* lds = (LAS unsigned char*)lds_;
    LAS bf16_t* Qs = (LAS bf16_t*)(lds);
    LAS bf16_t* Ks = (LAS bf16_t*)(lds + 17408);
    LAS bf16_t* KTs = (LAS bf16_t*)(lds + 34816);
    LAS bf16_t* VTs = (LAS bf16_t*)(lds + 53248);
    LAS bf16_t* Ss = (LAS bf16_t*)(lds + 73984);
    LAS bf16_t* CTs = (LAS bf16_t*)(lds + 83200);
    LAS float* F = (LAS float*)(lds + 122368);
    LAS float* Aa = F; LAS float* Gg = F + 64; LAS float* WI = F + 128; LAS float* EM = F + 192;
    const unsigned char* QK8 = (const unsigned char*)(a.ws + WS_YMIX);
    const bf16_t* V2 = (const bf16_t*)(a.ws + WS_V2);
    const float* GP = (const float*)(a.ws + WS_GP);
    bf16_t* HDo = (bf16_t*)(a.ws + WS_HB);
    const int dir = it & 1, hh = (it >> 1) & 3, b = it >> 3;
    const int c16 = wave * 16;
    const int rpos = dir ? 63 - lane : lane;
    __syncthreads();
    for (int i = tid; i < 144 * 136 / 2; i += NTHR) ((LAS unsigned*)CTs)[i] = 0u;
    for (int i = tid; i < 16 * 72 / 2; i += NTHR) ((LAS unsigned*)(VTs + 128 * 72))[i] = (i < 36) ? 0x3f803f80u : 0u;
    f32x4 accC[9];
#pragma unroll
    for (int j = 0; j < 9; ++j) accC[j] = (f32x4){0.f, 0.f, 0.f, 0.f};
    float m_prev = 0.f;
    struct OpSet { u32x4 rq8, rk8, v0, v1; float ga, gbc, gav, gcm, g_bl, g_cm63; };
    auto chunk_rowbase = [&](int cs) -> int {
        const bool is_ctx = cs < 4; const int cc = is_ctx ? (dir ? 3 - cs : cs) : (dir ? 63 - (cs - 4) : cs - 4);
        return is_ctx ? MLAT + b * LCTX + cc * 64 : b * LSEQ + cc * 64; };
    auto prefetch = [&](int cs_, OpSet& o) {
        const int cs = cs_ < 68 ? cs_ : 67;
        const int rowbase = chunk_rowbase(cs);
        const int srow0 = (rowbase >= MLAT) ? (rowbase - MLAT) & 255 : LCTX + (rowbase & 4095);
        const unsigned char* qp = QK8 + (size_t)(b * 4 + hh) * QK8_STRIDE + (size_t)(srow0 + lane) * 256 + c16;
        o.rq8 = *(const u32x4*)qp; o.rk8 = *(const u32x4*)(qp + 128);
        const bf16_t* vp = V2 + ((size_t)(b * 4 + hh) * (LCTX + LSEQ) + srow0 + lane) * 128 + c16;
        o.v0 = *(const u32x4*)vp; o.v1 = *(const u32x4*)(vp + 8);
        const float* gp = GP + ((size_t)(rowbase >> 6) * 8 + dir * 4 + hh) * 192;
        o.g_bl = gp[63]; o.g_cm63 = gp[128 + 63]; o.ga = gp[64 + rpos];
        o.gbc = gp[lane]; o.gav = gp[64 + lane]; o.gcm = gp[128 + lane];
    };
    OpSet os0, os1, os2;
    prefetch(0, os0); prefetch(1, os1); prefetch(2, os2);
    __syncthreads();
    u32x2 hold[4]; int hold_row = -1;
#pragma unroll
    for (int j = 0; j < 4; ++j) hold[j] = (u32x2){0u, 0u};
    auto flush = [&]() {
        if (hold_row >= 0 && do_store) { bf16_t* op = HDo + (((size_t)dir * 32 + b * 4 + hh) * (LCTX + LSEQ) + hold_row) * 128 + (wave >> 2) * 64 + 4 * fq;
#pragma unroll
            for (int j = 0; j < 4; ++j) *(u32x2*)(op + j * 16) = hold[j]; } };
    auto step = [&](const int cs, OpSet& o) {
        const int rowbase = chunk_rowbase(cs);
        const u32x4 rq8 = o.rq8, rk8 = o.rk8; u32x4 vraw[2]; vraw[0] = o.v0; vraw[1] = o.v1;
        const float ga = o.ga, gbc = o.gbc, gav = o.gav, gcm = o.gcm, g_bl = o.g_bl, g_cm63 = o.g_cm63;
        const float g63 = fmaxf(m_prev, g_cm63), wc = __expf(m_prev - g63);
        {
            float f[16];
            dec16_fp8(rq8, f);
            { u32x4 w0, w1;
#pragma unroll
              for (int e = 0; e < 4; ++e) { w0[e] = pg8::cvt_pk_bf16(f[2 * e], f[2 * e + 1]); w1[e] = pg8::cvt_pk_bf16(f[8 + 2 * e], f[8 + 2 * e + 1]); }
              *(LAS u32x4*)(Qs + rpos * 136 + c16) = w0; *(LAS u32x4*)(Qs + rpos * 136 + c16 + 8) = w1; }
            dec16_fp8(rk8, f);
            { u32x4 w0, w1;
#pragma unroll
              for (int e = 0; e < 16; ++e) f[e] *= 0.08838834764831845f;
#pragma unroll
              for (int e = 0; e < 4; ++e) { w0[e] = pg8::cvt_pk_bf16(f[2 * e], f[2 * e + 1]); w1[e] = pg8::cvt_pk_bf16(f[8 + 2 * e], f[8 + 2 * e + 1]); }
              *(LAS u32x4*)(Ks + rpos * 136 + c16) = w0; *(LAS u32x4*)(Ks + rpos * 136 + c16 + 8) = w1;
              const float ws = __expf(ga - g63);
#pragma unroll
              for (int e = 0; e < 8; ++e) { const unsigned pw = pg8::cvt_pk_bf16(f[2 * e] * ws, f[2 * e + 1] * ws);
                  KTs[(c16 + 2 * e) * 72 + rpos] = (bf16_t)(pw & 0xffffu); KTs[(c16 + 2 * e + 1) * 72 + rpos] = (bf16_t)(pw >> 16); } }
#pragma unroll
            for (int h2 = 0; h2 < 2; ++h2)
#pragma unroll
                for (int e2 = 0; e2 < 4; ++e2) { VTs[(c16 + h2 * 8 + 2 * e2) * 72 + rpos] = (bf16_t)(vraw[h2][e2] & 0xffffu); VTs[(c16 + h2 * 8 + 2 * e2 + 1) * 72 + rpos] = (bf16_t)(vraw[h2][e2] >> 16); }
            if (wave == 7) { const float g = fmaxf(m_prev, gcm); Aa[lane] = gav; Gg[lane] = g; WI[lane] = __expf(m_prev - g); EM[lane] = __expf(-(gbc + g)); }
        }
        m_prev = g_bl + g63;
        flush();
        prefetch(cs + 3, o);
        __syncthreads();
        {
            const int tb = wave >> 1;
#pragma unroll
            for (int q2 = 0; q2 < 2; ++q2) {
                const int sb = (wave & 1) * 2 + q2;
                f32x4 acc = {0.f, 0.f, 0.f, 0.f};
                if (sb <= tb) {
                    bf16x8 kf[4], qf[4];
#pragma unroll
                    for (int ks = 0; ks < 4; ++ks) { kf[ks] = *(const LAS bf16x8*)(Ks + (sb * 16 + fr) * 136 + ks * 32 + fq * 8); qf[ks] = *(const LAS bf16x8*)(Qs + (tb * 16 + fr) * 136 + ks * 32 + fq * 8); }
#pragma unroll
                    for (int ks = 0; ks < 4; ++ks) acc = __builtin_amdgcn_mfma_f32_16x16x32_bf16(kf[ks], qf[ks], acc, 0, 0, 0);
                    const int t = tb * 16 + fr, s0 = sb * 16 + 4 * fq; const float g = Gg[t];
                    const f32x4 av = *(const LAS f32x4*)(Aa + s0);
#pragma unroll
                    for (int jj = 0; jj < 4; ++jj) acc[jj] = (s0 + jj <= t) ? acc[jj] * __expf(av[jj] - g) : 0.f;
                }
                u32x2 w; w.x = pg8::cvt_pk_bf16(acc[0], acc[1]); w.y = pg8::cvt_pk_bf16(acc[2], acc[3]);
                *(LAS u32x2*)(Ss + (tb * 16 + fr) * 72 + sb * 16 + 4 * fq) = w;
            }
        }
        __syncthreads();
        {
            const int tb = wave & 3, half = wave >> 2, t = tb * 16 + fr;
            f32x4 acc[5];
#pragma unroll
            for (int j = 0; j < 5; ++j) acc[j] = (f32x4){0.f, 0.f, 0.f, 0.f};
#pragma unroll
            for (int ks = 0; ks < 4; ++ks) {
                const bf16x8 qf = *(const LAS bf16x8*)(Qs + t * 136 + ks * 32 + fq * 8);
#pragma unroll
                for (int j = 0; j < 5; ++j) { const int jrow = (j < 4) ? (half * 4 + j) * 16 : 128;
                    const bf16x8 cf = *(const LAS bf16x8*)(CTs + (jrow + fr) * 136 + ks * 32 + fq * 8);
                    acc[j] = __builtin_amdgcn_mfma_f32_16x16x32_bf16(cf, qf, acc[j], 0, 0, 0); }
            }
            const float wi = WI[t];
#pragma unroll
            for (int j = 0; j < 5; ++j) acc[j] = acc[j] * wi;
#pragma unroll
            for (int ks = 0; ks < 2; ++ks) {
                const bf16x8 sf = *(const LAS bf16x8*)(Ss + t * 72 + ks * 32 + fq * 8);
#pragma unroll
                for (int j = 0; j < 5; ++j) { const int jrow = (j < 4) ? (half * 4 + j) * 16 : 128;
                    const bf16x8 vf = *(const LAS bf16x8*)(VTs + (jrow + fr) * 72 + ks * 32 + fq * 8);
                    acc[j] = __builtin_amdgcn_mfma_f32_16x16x32_bf16(vf, sf, acc[j], 0, 0, 0); }
            }
            const float den = __shfl(acc[4][0], fr);
            const float inv = 1.f / fmaxf(fabsf(den), EM[t]);
#pragma unroll
            for (int j = 0; j < 4; ++j) { hold[j].x = pg8::cvt_pk_bf16(acc[j][0] * inv, acc[j][1] * inv); hold[j].y = pg8::cvt_pk_bf16(acc[j][2] * inv, acc[j][3] * inv); }
            hold_row = ((rowbase >= MLAT) ? (rowbase - MLAT) & 255 : LCTX + (rowbase & 4095)) + (dir ? 63 - t : t);
            const int d0 = wave * 16;
#pragma unroll
            for (int j = 0; j < 9; ++j) accC[j] = accC[j] * wc;
#pragma unroll
            for (int ks = 0; ks < 2; ++ks) {
                const bf16x8 kf = *(const LAS bf16x8*)(KTs + (d0 + fr) * 72 + ks * 32 + fq * 8);
#pragma unroll
                for (int j = 0; j < 9; ++j) { const bf16x8 vf = *(const LAS bf16x8*)(VTs + (j * 16 + fr) * 72 + ks * 32 + fq * 8);
                    accC[j] = __builtin_amdgcn_mfma_f32_16x16x32_bf16(kf, vf, accC[j], 0, 0, 0); }
            }
        }
        __syncthreads();
        {
            const int d0 = wave * 16;
#pragma unroll
            for (int j = 0; j < 9; ++j) { u32x2 w; w.x = pg8::cvt_pk_bf16(accC[j][0], accC[j][1]); w.y = pg8::cvt_pk_bf16(accC[j][2], accC[j][3]);
                *(LAS u32x2*)(CTs + (j * 16 + fr) * 136 + d0 + 4 * fq) = w; }
        }
    };
#pragma unroll 1
    for (int cs = 0; cs < 66; cs += 3) { step(cs, os0); step(cs + 1, os1); step(cs + 2, os2); }
    step(66, os0); step(67, os1);
    flush();
    __syncthreads();
}

__device__ __forceinline__ float conv3_at(const bf16_t* rowp, int t, int seglen, float w0, float w1, float w2, float bias) {
    const int tl = t % seglen;
    float v = bf2f(rowp[t]) * w1 + bias;
    if (tl > 0) v += bf2f(rowp[t - 1]) * w0;
    if (tl < seglen - 1) v += bf2f(rowp[t + 1]) * w2;
    return v;
}
__device__ __forceinline__ void hyena_naive(const Args& a, int l, unsigned char* lds, int pass_lo, bool do_store) {
    const int tid = opaque_tid(), G = gridDim.x;
    bf16_t* UT = (bf16_t*)(a.ws + WS_UT);
    float* H = (float*)lds;
    float* Ub = H + 8192;
    float* Zb = Ub + 4096;
    float* red = Zb + 4096;
    float* w3s = red + 64;
    const float* hw = a.in[13] + (size_t)l * 3 * 1536; const float* hb = a.in[14] + (size_t)l * 1536;
    const float MIN_DECAY = -3.0701134573253946f, MAX_DECAY = -15.350567286626973f;
    for (int c = blockIdx.x; c < DHY; c += G) {
        const float rate = fabsf(MIN_DECAY + (MAX_DECAY - MIN_DECAY) * (float)c / 511.f);
        const float fb0 = a.in[21][(l * 2 + 0) * 512 + c], fb1 = a.in[21][(l * 2 + 1) * 512 + c];
        float cwv[3][3], cbv[3];
#pragma unroll
        for (int g = 0; g < 3; ++g) { cbv[g] = hb[g * 512 + c];
#pragma unroll
            for (int t3 = 0; t3 < 3; ++t3) cwv[g][t3] = hw[t3 * 1536 + g * 512 + c]; }
        for (int pass = pass_lo; pass < (l == 0 ? 2 : 1); ++pass) {
            const int L = pass ? LCTX : LSEQ;
            const float* hdn = pass ? (const float*)(a.ws + WS_HDNC) : (const float*)(a.ws + WS_HDN) + (size_t)l * 4096 * 64;
            __syncthreads();
            if (tid < 128) w3s[tid] = a.in[20][(size_t)l * 64 * 1024 + (tid & 63) * 1024 + (tid >> 6) * 512 + c];
            __syncthreads();
            float ssq0 = 0.f, ssq1 = 0.f;
            for (int t = tid; t < L; t += 512) { float s0 = 0.f, s1 = 0.f;
                for (int jj = 0; jj < 64; ++jj) { const float hv = hdn[(size_t)t * 64 + jj]; s0 += hv * w3s[jj]; s1 += hv * w3s[64 + jj]; }
                const float off = fabsf((float)t - (float)(L / 2)) / (float)(L / 2); const float dec = __expf(-off * rate);
                s0 *= dec; s1 *= dec; H[t] = s0; H[4096 + t] = s1; ssq0 += s0 * s0; ssq1 += s1 * s1; }
            ssq0 = wave_sum(ssq0); ssq1 = wave_sum(ssq1);
            if ((tid & 63) == 0) { red[tid >> 6] = ssq0; red[8 + (tid >> 6)] = ssq1; }
            __syncthreads();
            float t0 = 0.f, t1 = 0.f;
            for (int w = 0; w < 8; ++w) { t0 += red[w]; t1 += red[8 + w]; }
            const float n0 = rsqrtf(t0 + RMS_EPS), n1 = rsqrtf(t1 + RMS_EPS);
            __syncthreads();
            for (int t = tid; t < L; t += 512) { H[t] *= n0; H[4096 + t] *= n1; }
            __syncthreads();
            for (int b = 0; b < NB; ++b) {
                const size_t col0 = pass ? (size_t)MLAT + (size_t)b * LCTX : (size_t)b * LSEQ;
                const int seglen = pass ? LCTX : 64;
                const bf16_t* rv = UT + (size_t)c * MT + col0; const bf16_t* r1 = UT + (size_t)(512 + c) * MT + col0;
                const bf16_t* r2 = UT + (size_t)(1024 + c) * MT + col0; const bf16_t* rz = UT + (size_t)(1536 + c) * MT + col0;
                for (int t = tid; t < L; t += 512) Ub[t] = conv3_at(rv, t, seglen, cwv[0][0], cwv[0][1], cwv[0][2], cbv[0]);
                __syncthreads();
                for (int t = tid; t < L; t += 512) { float y = 0.f;
                    int slo = t + L / 2 - (L - 1); if (slo < 0) slo = 0; int shi = t + L / 2; if (shi > L - 1) shi = L - 1;
                    for (int s = slo; s <= shi; ++s) y += Ub[s] * H[t + L / 2 - s];
                    const float x1 = conv3_at(r1, t, seglen, cwv[1][0], cwv[1][1], cwv[1][2], cbv[1]);
                    Zb[t] = x1 * (y + Ub[t] * fb0); }
                __syncthreads();
                for (int t = tid; t < L; t += 512) { float y = 0.f;
                    int slo = t + L / 2 - (L - 1); if (slo < 0) slo = 0; int shi = t + L / 2; if (shi > L - 1) shi = L - 1;
                    for (int s = slo; s <= shi; ++s) y += Zb[s] * H[4096 + t + L / 2 - s];
                    const float x2 = conv3_at(r2, t, seglen, cwv[2][0], cwv[2][1], cwv[2][2], cbv[2]);
                    const float o = x2 * (y + Zb[t] * fb1) * silu_f(bf2f(rz[t]));
                    Ub[t] = o; }
                __syncthreads();
                if (do_store) for (int t = tid; t < L; t += 512) UT[(size_t)c * MT + col0 + t] = (bf16_t)f2bf(Ub[t]);
                __syncthreads();
            }
        }
    }
    __syncthreads();
}


typedef float cf __attribute__((ext_vector_type(2)));
__device__ __forceinline__ cf cmul(cf a, cf b) { const cf sw = __builtin_shufflevector(a, a, 1, 0); return a * b.x + sw * cf{-b.y, b.y}; }
__host__ __device__ constexpr float tw32c(int e) { return e == 0 ? 1.f : e == 1 ? 0.98078528040323043f : e == 2 ? 0.92387953251128674f : e == 3 ? 0.83146961230254524f : e == 4 ? 0.70710678118654752f : e == 5 ? 0.55557023301960218f :
    e == 6 ? 0.38268343236508977f : e == 7 ? 0.19509032201612825f : e == 8 ? 0.f : e == 9 ? -0.19509032201612825f : e == 10 ? -0.38268343236508977f : e == 11 ? -0.55557023301960218f : e == 12 ? -0.70710678118654752f :
    e == 13 ? -0.83146961230254524f : e == 14 ? -0.92387953251128674f : -0.98078528040323043f; }
template <int E32> __device__ __forceinline__ cf twmul(cf d) {
    if (E32 == 0) return d;
    if (E32 == 8) return cf{d.y, -d.x};
    constexpr float c = tw32c(E32), sn = tw32c(E32 < 8 ? 8 - E32 : E32 - 8);
    const cf sw = __builtin_shufflevector(d, d, 1, 0);
    return d * c + sw * cf{sn, -sn};
}
template <int R, int HALF, int I> struct DftStage {
    static __device__ __forceinline__ void run(cf (&v)[R]) {
        if constexpr ((I & HALF) == 0) {
            constexpr int E32 = (I % HALF) * (R / (2 * HALF)) * (32 / R);
            const cf a = v[I], b = v[I + HALF];
            v[I] = a + b;
            v[I + HALF] = twmul<E32>(a - b);
        }
        if constexpr (I + 1 < R) DftStage<R, HALF, I + 1>::run(v);
    }
};
template <int R, int HALF> struct DftAll {
    static __device__ __forceinline__ void run(cf (&v)[R]) { DftStage<R, HALF, 0>::run(v); if constexpr (HALF > 1) DftAll<R, HALF / 2>::run(v); }
};
__host__ __device__ constexpr int bitrev_c(int x, int bits) { int r = 0; for (int i = 0; i < bits; ++i) r = (r << 1) | ((x >> i) & 1); return r; }
__device__ __forceinline__ int PADI(int i) { return i + (i >> 4); }
constexpr int FFT_W_ELEMS = 8192 + 512;
template <int R, int I> struct StoreRev {
    static __device__ __forceinline__ void run(LAS cf* Wp, int pstride, const cf (&v)[R]) {
        constexpr int bits = (R == 32) ? 5 : 4;
        Wp[I * pstride] = v[bitrev_c(I, bits)];
        if constexpr (I + 1 < R) StoreRev<R, I + 1>::run(Wp, pstride, v);
    }
};
template <int R, int NS> __device__ __forceinline__ void fft_pass(LAS cf* W, int tid_) {
    int tid = tid_; asm volatile("" : "+v"(tid));
    constexpr int NT = 8192 / R;
    cf v[R];
    const bool act = tid < NT;
    if (act) {
#pragma unroll
        for (int r = 0; r < R; ++r) v[r] = W[PADI(tid) + r * (NT + NT / 16)];
    }
    __syncthreads();
    if (act) {
        const int k = tid % NS;
        if (NS > 1) {
            const float fr_ = -(float)k * (1.f / (float)(NS * R)); const float sn = __builtin_amdgcn_sinf(fr_), cs = __builtin_amdgcn_cosf(fr_);
            const cf w = cf{cs, sn}; cf cur = w;
#pragma unroll
            for (int r = 1; r < R; ++r) { v[r] = cmul(v[r], cur); cur = cmul(cur, w); }
        }
        DftAll<R, R / 2>::run(v);
        const int idx = (tid / NS) * NS * R + k;
        StoreRev<R, 0>::run(W + PADI(idx), NS >= 16 ? NS + NS / 16 : 1, v);
    }
    __syncthreads();
}
__device__ __forceinline__ void fft_pass2(LAS cf* W, int tid_) {
    int tid = tid_; asm volatile("" : "+v"(tid));
#pragma unroll 2
    for (int m = 0; m < 8; ++m) { const int j = tid + 512 * m; const int pj = PADI(j); const cf a = W[pj]; cf b = W[pj + 4352];
        const float fr_ = -(float)j * (1.f / 8192.f); b = cmul(b, cf{__builtin_amdgcn_cosf(fr_), __builtin_amdgcn_sinf(fr_)});
        W[pj] = cf{a.x + b.x, a.y + b.y}; W[pj + 4352] = cf{a.x - b.x, a.y - b.y}; }
    __syncthreads();
}
__device__ __forceinline__ void fft8192(LAS cf* W, int tid) { fft_pass<16, 1>(W, tid); fft_pass<16, 16>(W, tid); fft_pass<16, 256>(W, tid); fft_pass2(W, tid); }

template <int NS> __device__ __forceinline__ void fft4k_pass(LAS cf* Wb, int j_) {
    int j = j_; asm volatile("" : "+v"(j));
    cf v[16];
#pragma unroll
    for (int r = 0; r < 16; ++r) v[r] = Wb[PADI(j) + r * 272];
    __syncthreads();
    const int k = j % NS;
    if (NS > 1) {
        const float fr_ = -(float)k * (1.f / (float)(NS * 16)); const float sn = __builtin_amdgcn_sinf(fr_), cs = __builtin_amdgcn_cosf(fr_);
        const cf w = cf{cs, sn}; cf cur = w;
#pragma unroll
        for (int r = 1; r < 16; ++r) { v[r] = cmul(v[r], cur); cur = cmul(cur, w); }
    }
    DftAll<16, 8>::run(v);
    const int idx = (j / NS) * NS * 16 + k;
    StoreRev<16, 0>::run(Wb + PADI(idx), NS >= 16 ? NS + NS / 16 : 1, v);
    __syncthreads();
}
__device__ __forceinline__ void fft4k_x2(LAS cf* Wb, int j) { fft4k_pass<1>(Wb, j); fft4k_pass<16>(Wb, j); fft4k_pass<256>(Wb, j); }

__device__ __forceinline__ void conv8(const u32x4 rv, int tid, float w0, float w1, float w2, float bias, float (&o)[8]) {
    float x[8];
#pragma unroll
    for (int e = 0; e < 4; ++e) { x[2 * e] = bflo(rv[e]); x[2 * e + 1] = bfhi(rv[e]); }
    float left = __shfl_up(x[7], 1), right = __shfl_down(x[0], 1);
    if ((tid & 7) == 0) left = 0.f;
    if ((tid & 7) == 7) right = 0.f;
#pragma unroll
    for (int e = 0; e < 8; ++e) { const float xm = (e == 0) ? left : x[e - 1], xp = (e == 7) ? right : x[e + 1]; o[e] = w0 * xm + w1 * x[e] + w2 * xp + bias; }
}

__device__ __forceinline__ void hyena_item(const Args& a, int l, unsigned char* lds_, int item, bool do_store) {
    const int tid = opaque_tid();
    const int c = item >> 1, half = item & 1;
    LAS unsigned char* lds = (LAS unsigned char*)lds_;
    LAS cf* W = (LAS cf*)lds;
    LAS cf* He0 = (LAS cf*)(lds + 69632);
    LAS cf* Ho0 = He0 + 2049;
    LAS cf* He1 = Ho0 + 2048;
    LAS cf* Ho1 = He1 + 2049;
    const int sel = tid >> 8, j = tid & 255;
    LAS cf* Wb = W + sel * 4352;
    bf16_t* UT = (bf16_t*)(a.ws + WS_UT);
    const float* FT = (const float*)(a.ws + WS_FT);
    const float* hw = a.in[13] + (size_t)l * 3 * 1536; const float* hb = a.in[14] + (size_t)l * 1536;
    const float fb0 = a.in[21][(l * 2 + 0) * 512 + c], fb1 = a.in[21][(l * 2 + 1) * 512 + c];
    const int pi0 = PADI(tid * 8);
    __syncthreads();
    {
        const f32x4 ha = *(const f32x4*)(FT + (size_t)c * 4096 + tid * 8), hb2 = *(const f32x4*)(FT + (size_t)c * 4096 + tid * 8 + 4);
        const f32x4 ga = *(const f32x4*)(FT + (size_t)(512 + c) * 4096 + tid * 8), gb2 = *(const f32x4*)(FT + (size_t)(512 + c) * 4096 + tid * 8 + 4);
        const float fn0 = FT[(size_t)1024 * 4096 + c], fn1 = FT[(size_t)1024 * 4096 + 512 + c];
#pragma unroll
        for (int e = 0; e < 8; ++e) { const cf f = cf{(e < 4 ? ha[e & 3] : hb2[e & 3]) * fn0, (e < 4 ? ga[e & 3] : gb2[e & 3]) * fn1};
            const float fr_ = -(float)(tid * 8 + e) * (1.f / 8192.f);
            W[pi0 + e] = f; W[4352 + pi0 + e] = cmul(f, cf{__builtin_amdgcn_cosf(fr_), __builtin_amdgcn_sinf(fr_)}); }
        __syncthreads();
        fft4k_x2(Wb, j);
        for (int m = tid; m <= 2048; m += NTHR) { const cf A = W[PADI(m & 4095)], Bm = W[PADI((4096 - m) & 4095)];
            He0[m] = cf{0.5f * (A.x + Bm.x), 0.5f * (A.y - Bm.y)}; He1[m] = cf{0.5f * (A.y + Bm.y), -0.5f * (A.x - Bm.x)}; }
        for (int m = tid; m < 2048; m += NTHR) { const cf A = W[4352 + PADI(m)], Bm = W[4352 + PADI(4095 - m)];
            Ho0[m] = cf{0.5f * (A.x + Bm.x), 0.5f * (A.y - Bm.y)}; Ho1[m] = cf{0.5f * (A.y + Bm.y), -0.5f * (A.x - Bm.x)}; }
        __syncthreads();
    }
    float cwv[3][3], cbv[3];
#pragma unroll
    for (int g = 0; g < 3; ++g) { cbv[g] = hb[g * 512 + c];
#pragma unroll
        for (int t3 = 0; t3 < 3; ++t3) cwv[g][t3] = hw[t3 * 1536 + g * 512 + c]; }
#pragma unroll 1
    for (int bp = half * 2; bp < half * 2 + 2; ++bp) {
        const size_t o0 = (size_t)(2 * bp) * LSEQ + tid * 8, o1 = o0 + LSEQ;
        bf16_t* rv = UT + (size_t)c * MT; const bf16_t* r1 = UT + (size_t)(512 + c) * MT; const bf16_t* r2 = UT + (size_t)(1024 + c) * MT; const bf16_t* rz = UT + (size_t)(1536 + c) * MT;
        const u32x4 qv0 = *(const u32x4*)(rv + o0), qv1 = *(const u32x4*)(rv + o1), qa0 = *(const u32x4*)(r1 + o0), qa1 = *(const u32x4*)(r1 + o1);
        const u32x4 qb0 = *(const u32x4*)(r2 + o0), qb1 = *(const u32x4*)(r2 + o1), qz0 = *(const u32x4*)(rz + o0), qz1 = *(const u32x4*)(rz + o1);
        float z0[8], z1[8];
        conv8(qv0, tid, cwv[0][0], cwv[0][1], cwv[0][2], cbv[0], z0);
        conv8(qv1, tid, cwv[0][0], cwv[0][1], cwv[0][2], cbv[0], z1);
#pragma unroll 1
        for (int ord = 0; ord < 2; ++ord) {
#pragma unroll
            for (int e = 0; e < 8; ++e) { const cf f = cf{z0[e], z1[e]}; const float fr_ = -(float)(tid * 8 + e) * (1.f / 8192.f);
                W[pi0 + e] = f; W[4352 + pi0 + e] = cmul(f, cf{__builtin_amdgcn_cosf(fr_), __builtin_amdgcn_sinf(fr_)}); }
            __syncthreads();
            fft4k_x2(Wb, j);
            {
                LAS const cf* Hs = sel ? (ord ? Ho1 : Ho0) : (ord ? He1 : He0);
                const int top = sel ? 4095 : 4096, lim = sel ? 2047 : 2048;
#pragma unroll 4
                for (int i = 0; i < 16; ++i) { const int m = j + 256 * i; const int pm = PADI(m); const cf zv = Wb[pm];
                    cf hk; if (m <= lim) hk = Hs[m]; else { hk = Hs[top - m]; hk.y = -hk.y; }
                    const cf y = cmul(zv, hk); Wb[pm] = cf{y.x, -y.y}; }
            }
            __syncthreads();
            fft4k_x2(Wb, j);
            float x0[8], x1[8];
            conv8(ord ? qb0 : qa0, tid, cwv[1 + ord][0], cwv[1 + ord][1], cwv[1 + ord][2], cbv[1 + ord], x0);
            conv8(ord ? qb1 : qa1, tid, cwv[1 + ord][0], cwv[1 + ord][1], cwv[1 + ord][2], cbv[1 + ord], x1);
            const float fb = ord ? fb1 : fb0;
            const int pr = PADI((2048 + tid * 8) & 4095);
#pragma unroll
            for (int e = 0; e < 8; ++e) { const float fr_ = -(float)(2048 + tid * 8 + e) * (1.f / 8192.f);
                const cf ev = W[pr + e], ov = cmul(W[4352 + pr + e], cf{__builtin_amdgcn_cosf(fr_), __builtin_amdgcn_sinf(fr_)});
                const float y0 = (ev.x + ov.x) * (1.f / 8192.f), y1 = -(ev.y + ov.y) * (1.f / 8192.f);
                z0[e] = x0[e] * (y0 + z0[e] * fb); z1[e] = x1[e] * (y1 + z1[e] * fb); }
            __syncthreads();
        }
        {
            u32x4 w0, w1;
#pragma unroll
            for (int e = 0; e < 4; ++e) { w0[e] = pg8::cvt_pk_bf16(z0[2 * e] * silu_f(bflo(qz0[e])), z0[2 * e + 1] * silu_f(bfhi(qz0[e])));
                w1[e] = pg8::cvt_pk_bf16(z1[2 * e] * silu_f(bflo(qz1[e])), z1[2 * e + 1] * silu_f(bfhi(qz1[e]))); }
            if (do_store) { *(u32x4*)(rv + o0) = w0; *(u32x4*)(rv + o1) = w1; } }
    }
    __syncthreads();
}

__device__ __forceinline__ void filt_item(const Args& a, int l, unsigned char* lds_, int fi) {
    const int tid = opaque_tid();
    LAS float* w3s = (LAS float*)lds_ + 4096;
    LAS float* red = w3s + 512;
    float* FT = (float*)(a.ws + WS_FT);
    const float* hdn = (const float*)(a.ws + WS_HDN) + (size_t)l * 4096 * 64;
    const float MIN_DECAY = -3.0701134573253946f, MAX_DECAY = -15.350567286626973f;
    __syncthreads();
    w3s[tid] = a.in[20][(size_t)l * 64 * 1024 + (size_t)(tid >> 3) * 1024 + fi * 8 + (tid & 7)];
    __syncthreads();
    float rate[8], ssq[8];
#pragma unroll
    for (int cc = 0; cc < 8; ++cc) { const int ch = (fi * 8 + cc) & 511; rate[cc] = fabsf(MIN_DECAY + (MAX_DECAY - MIN_DECAY) * (float)ch / 511.f); ssq[cc] = 0.f; }
#pragma unroll 1
    for (int it2 = 0; it2 < 2; ++it2) {
        float acc[4][8];
#pragma unroll
        for (int q = 0; q < 4; ++q)
#pragma unroll
            for (int cc = 0; cc < 8; ++cc) acc[q][cc] = 0.f;
        const f32x4* hp = (const f32x4*)(hdn + (size_t)(it2 * 2048 + tid) * 64);
        f32x4 hn[4];
#pragma unroll
        for (int q = 0; q < 4; ++q) hn[q] = hp[(size_t)q * 512 * 16];
#pragma unroll 1
        for (int j4 = 0; j4 < 16; ++j4) {
            f32x4 hv[4];
#pragma unroll
            for (int q = 0; q < 4; ++q) hv[q] = hn[q];
            if (j4 < 15) {
#pragma unroll
                for (int q = 0; q < 4; ++q) hn[q] = hp[(size_t)q * 512 * 16 + j4 + 1]; }
#pragma unroll
            for (int jj = 0; jj < 4; ++jj) { const f32x4 wa = *(const LAS f32x4*)(w3s + (4 * j4 + jj) * 8), wb = *(const LAS f32x4*)(w3s + (4 * j4 + jj) * 8 + 4);
#pragma unroll
                for (int q = 0; q < 4; ++q) { const float h = hv[q][jj];
                    acc[q][0] += h * wa.x; acc[q][1] += h * wa.y; acc[q][2] += h * wa.z; acc[q][3] += h * wa.w; acc[q][4] += h * wb.x; acc[q][5] += h * wb.y; acc[q][6] += h * wb.z; acc[q][7] += h * wb.w; } }
        }
#pragma unroll
        for (int q = 0; q < 4; ++q) { const int t = it2 * 2048 + tid + 512 * q; const float off = fabsf((float)t - 2048.f) * (1.f / 2048.f);
#pragma unroll
            for (int cc = 0; cc < 8; ++cc) { const float v = acc[q][cc] * __expf(-off * rate[cc]); ssq[cc] += v * v; FT[(size_t)(fi * 8 + cc) * 4096 + t] = v; } }
    }
#pragma unroll
    for (int cc = 0; cc < 8; ++cc) { const float sv = wave_sum(ssq[cc]); if ((tid & 63) == 0) red[(tid >> 6) * 8 + cc] = sv; }
    __syncthreads();
    if (tid < 8) { float tsum = 0.f;
#pragma unroll
        for (int w = 0; w < 8; ++w) tsum += red[w * 8 + tid];
        FT[(size_t)1024 * 4096 + fi * 8 + tid] = rsqrtf(tsum + RMS_EPS); }
}

__device__ __forceinline__ float ctx_conv3(const bf16_t* rowp, int t, float w0, float w1, float w2, float bias) {
    float v = bf2f(rowp[t]) * w1 + bias;
    if (t > 0) v += bf2f(rowp[t - 1]) * w0;
    if (t < LCTX - 1) v += bf2f(rowp[t + 1]) * w2;
    return v;
}
__device__ __forceinline__ void hyena_ctx_item(const Args& a, unsigned char* lds_, int c, bool do_store) {
    const int tid = opaque_tid();
    LAS float* Hc = (LAS float*)lds_;
    LAS float* U = Hc + 512;
    LAS float* Z = U + 2048;
    LAS float* red = Z + 2048;
    LAS float* w3s = red + 16;
    bf16_t* UT = (bf16_t*)(a.ws + WS_UT);
    const float* hdn = (const float*)(a.ws + WS_HDNC);
    const float* hw = a.in[13]; const float* hb = a.in[14];
    const float MIN_DECAY = -3.0701134573253946f, MAX_DECAY = -15.350567286626973f;
    const int t = tid & 255, bh = tid >> 8;
    {
        const float rate = fabsf(MIN_DECAY + (MAX_DECAY - MIN_DECAY) * (float)c / 511.f);
        const float fb0 = a.in[21][c], fb1 = a.in[21][512 + c];
        __syncthreads();
        if (tid < 128) w3s[tid] = a.in[20][(size_t)(tid & 63) * 1024 + (tid >> 6) * 512 + c];
        __syncthreads();
        {
            float sv = 0.f;
            const f32x4* hp = (const f32x4*)(hdn + (size_t)t * 64);
#pragma unroll 4
            for (int j4 = 0; j4 < 16; ++j4) { const f32x4 hv = hp[j4]; sv += hv.x * w3s[bh * 64 + 4 * j4] + hv.y * w3s[bh * 64 + 4 * j4 + 1] + hv.z * w3s[bh * 64 + 4 * j4 + 2] + hv.w * w3s[bh * 64 + 4 * j4 + 3]; }
            sv *= __expf(-fabsf((float)t - 128.f) * (1.f / 128.f) * rate);
            const float ss = wave_sum(sv * sv);
            if ((tid & 63) == 0) red[tid >> 6] = ss;
            __syncthreads();
            const float tot = red[bh * 4] + red[bh * 4 + 1] + red[bh * 4 + 2] + red[bh * 4 + 3];
            Hc[bh * 256 + t] = sv * rsqrtf(tot + RMS_EPS);
        }
        float vv[4];
#pragma unroll
        for (int i = 0; i < 4; ++i) { const bf16_t* rv = UT + (size_t)c * MT + MLAT + (size_t)(bh * 4 + i) * LCTX;
            vv[i] = ctx_conv3(rv, t, hw[c], hw[1536 + c], hw[3072 + c], hb[c]); }
        *(LAS f32x4*)(U + t * 8 + bh * 4) = (f32x4){vv[0], vv[1], vv[2], vv[3]};
        __syncthreads();
        const int slo = (t - 127 > 0) ? t - 127 : 0, shi = (t + 128 < 255) ? t + 128 : 255;
        f32x4 acc = {0.f, 0.f, 0.f, 0.f};
        for (int s2 = slo; s2 <= shi; ++s2) { const float h = Hc[t + 128 - s2]; const f32x4 u = *(const LAS f32x4*)(U + s2 * 8 + bh * 4); acc = acc + u * h; }
        float zz[4];
#pragma unroll
        for (int i = 0; i < 4; ++i) { const bf16_t* r1 = UT + (size_t)(512 + c) * MT + MLAT + (size_t)(bh * 4 + i) * LCTX;
            const float x1 = ctx_conv3(r1, t, hw[512 + c], hw[1536 + 512 + c], hw[3072 + 512 + c], hb[512 + c]);
            zz[i] = x1 * (acc[i] + vv[i] * fb0); }
        *(LAS f32x4*)(Z + t * 8 + bh * 4) = (f32x4){zz[0], zz[1], zz[2], zz[3]};
        __syncthreads();
        acc = (f32x4){0.f, 0.f, 0.f, 0.f};
        for (int s2 = slo; s2 <= shi; ++s2) { const float h = Hc[256 + t + 128 - s2]; const f32x4 u = *(const LAS f32x4*)(Z + s2 * 8 + bh * 4); acc = acc + u * h; }
#pragma unroll
        for (int i = 0; i < 4; ++i) { const size_t off = (size_t)MLAT + (size_t)(bh * 4 + i) * LCTX;
            const bf16_t* r2 = UT + (size_t)(1024 + c) * MT + off; const bf16_t* rz = UT + (size_t)(1536 + c) * MT + off;
            const float x2 = ctx_conv3(r2, t, hw[1024 + c], hw[1536 + 1024 + c], hw[3072 + 1024 + c], hb[1024 + c]);
            const float o = x2 * (acc[i] + zz[i] * fb1) * silu_f(bf2f(rz[t]));
            if (do_store) UT[(size_t)c * MT + off + t] = (bf16_t)f2bf(o); }
    }
    __syncthreads();
}


__device__ __forceinline__ void phase_mixers(const Args& a, int l, unsigned char* lds, int rep, bool do_mlstm, bool do_hy, bool do_hyctx) {
    LAS unsigned* qslot = (LAS unsigned*)((LAS unsigned char*)lds + (LDS_BYTES - 32));
    if (do_mlstm && (blockIdx.x & 3) == 0 && (blockIdx.x >> 2) < 64) mlstm_item(a, l, lds, blockIdx.x >> 2, rep == 0);
    unsigned* ctr = (unsigned*)(a.ws + WS_CTL) + CW_QUEUE + 64 * (l * 8 + rep);
    const int n_lat = do_hy ? 2 * DHY : 0, n_ctx = (l == 0 && do_hyctx) ? DHY : 0;
    for (;;) {
        __syncthreads();
        if (threadIdx.x == 0) *qslot = __hip_atomic_fetch_add(ctr, 1u, __ATOMIC_RELAXED, __HIP_MEMORY_SCOPE_AGENT);
        __syncthreads();
        const int item = (int)*qslot;
        if (item >= n_lat + n_ctx) break;
        if (item < n_lat) hyena_item(a, l, lds, item, rep == 0);
        else hyena_ctx_item(a, lds, item - n_lat, rep == 0);
    }
    __syncthreads();
}

__device__ __forceinline__ void phase_combine(const Args& a, int l, unsigned char* lds) {
    const int tid = opaque_tid(), G = gridDim.x, lane = tid & 63, wave = tid >> 6;
    const bf16_t* U1 = (const bf16_t*)(a.ws + WS_U1);
    const bf16_t* HDi = (const bf16_t*)(a.ws + WS_HB);
    const bf16_t* UT = (const bf16_t*)(a.ws + WS_UT);
    bf16_t* YM = (bf16_t*)(a.ws + WS_YMIX);
    bf16_t* T = (bf16_t*)lds;
    const int nblk = (l == 0 ? MT : MLAT) / 64;
    float mgv[8];
#pragma unroll
    for (int i = 0; i < 8; ++i) mgv[i] = a.in[12][l * 512 + lane * 8 + i];
    const size_t dstride = (size_t)32 * (LCTX + LSEQ) * 128;
    for (int blk = blockIdx.x; blk < nblk; blk += G) {
        const int r0 = blk * 64;
        __syncthreads();
#pragma unroll
        for (int i = 0; i < 8; ++i) { const int e = tid + i * 512, ch = e >> 3, pc = e & 7;
            *(u32x4*)(T + ch * 72 + ((pc ^ ((ch >> 3) & 7)) * 8)) = *(const u32x4*)(UT + (size_t)ch * MT + r0 + pc * 8); }
        const int cb = r0 >= MLAT ? (r0 - MLAT) >> 8 : r0 >> 12, csr0 = r0 >= MLAT ? (r0 - MLAT) & 255 : LCTX + (r0 & 4095);
        const bf16_t* hbase = HDi + ((size_t)(cb * 4 + (lane >> 4)) * (LCTX + LSEQ) + csr0) * 128 + (lane & 15) * 8;
#pragma unroll 1
        for (int rr = wave; rr < 64; rr += 16) {
            u32x4 hf[2], hb[2], ov[2], zv[2];
#pragma unroll
            for (int q = 0; q < 2; ++q) { const int r1 = rr + 8 * q; const size_t row = r0 + r1;
                hf[q] = *(const u32x4*)(hbase + (size_t)r1 * 128); hb[q] = *(const u32x4*)(hbase + (size_t)r1 * 128 + dstride);
                ov[q] = *(const u32x4*)(U1 + row * LDU1 + 1024 + lane * 8); zv[q] = *(const u32x4*)(U1 + row * LDU1 + 1536 + lane * 8); }
#pragma unroll
            for (int q = 0; q < 2; ++q) { const size_t row = r0 + rr + 8 * q;
                float hg[8]; float ss = 0.f;
#pragma unroll
                for (int i = 0; i < 4; ++i) {
                    hg[2 * i] = (bflo(hf[q][i]) + bflo(hb[q][i])) * sigmoid_f(bflo(ov[q][i]));
                    hg[2 * i + 1] = (bfhi(hf[q][i]) + bfhi(hb[q][i])) * sigmoid_f(bfhi(ov[q][i]));
                    ss += hg[2 * i] * hg[2 * i] + hg[2 * i + 1] * hg[2 * i + 1]; }
                ss += __shfl_xor(ss, 1); ss += __shfl_xor(ss, 2); ss += __shfl_xor(ss, 4); ss += __shfl_xor(ss, 8);
                const float r = rsqrtf(ss * (1.f / 128.f) + RMS_EPS);
                u32x4 o4;
#pragma unroll
                for (int i = 0; i < 4; ++i) o4[i] = pk2(hg[2 * i] * r * mgv[2 * i] * silu_f(bflo(zv[q][i])), hg[2 * i + 1] * r * mgv[2 * i + 1] * silu_f(bfhi(zv[q][i])));
                *(u32x4*)(YM + row * DM + lane * 8) = o4; }
        }
        __syncthreads();
        for (int rr = wave; rr < 64; rr += 8) {
            const int col = (((rr >> 3) ^ (lane & 7)) << 3) | (rr & 7);
            u32x4 o4;
#pragma unroll
            for (int i = 0; i < 4; ++i) o4[i] = (unsigned)T[(lane * 8 + 2 * i) * 72 + col] | ((unsigned)T[(lane * 8 + 2 * i + 1) * 72 + col] << 16);
            *(u32x4*)(YM + (size_t)(r0 + rr) * DM + 512 + lane * 8) = o4;
        }
    }
    __syncthreads();
}


#define XB_TMO      128
#define XB_XCNT(j)  (256  + 64 * (j))
#define XB_XSUB(j)  (1280 + 64 * (j))
#define XB_XGEN(j)  (2304 + 64 * (j))
#define XB_TOP      3328
#define XB_TOPGEN   3392
#define XCD_BAR_WORDS 3456
#define XB_SPIN_CAP (1u << 18)
__device__ __forceinline__ unsigned xb_ld(unsigned* p)              { return __hip_atomic_load(p, __ATOMIC_RELAXED, __HIP_MEMORY_SCOPE_AGENT); }
__device__ __forceinline__ unsigned xb_add(unsigned* p, unsigned v) { return __hip_atomic_fetch_add(p, v, __ATOMIC_RELAXED, __HIP_MEMORY_SCOPE_AGENT); }
__device__ __forceinline__ unsigned xb_xcc_id() { return (unsigned)__builtin_amdgcn_s_getreg((3 << 11) | 20) & 0xFu; }
#define XB_SPIN(cond, bar) do { unsigned _sp = 0; while (cond) { __builtin_amdgcn_s_sleep(1); \
    if ((++_sp & 255u) == 0u) { if (xb_ld(&(bar)[XB_TMO])) break; if (_sp > XB_SPIN_CAP) { atomicAdd(&(bar)[XB_TMO], 1u); break; } } } } while (0)
struct XcdBarrier { unsigned* bar; unsigned x; volatile __attribute__((address_space(3))) unsigned* st; };
__device__ __forceinline__ XcdBarrier xcd_barrier_post(unsigned* bar, volatile __attribute__((address_space(3))) unsigned* st) {
    XcdBarrier b; b.bar = bar; b.x = xb_xcc_id(); b.st = st;
    if (threadIdx.x == 0) (void)xb_add(&bar[XB_XCNT(b.x)], 1u);
    return b;
}
__device__ __forceinline__ void xcd_barrier_complete(unsigned* bar, unsigned x, unsigned& nloc, unsigned& nx) {
    const unsigned G = gridDim.x * gridDim.y * gridDim.z;
    unsigned sum, cnt, mine, sp = 0u;
    for (;;) {
        sum = 0u; cnt = 0u; mine = 0u;
#pragma unroll
        for (unsigned j = 0; j < 16; ++j) { const unsigned c = xb_ld(&bar[XB_XCNT(j)]); sum += c; cnt += (c > 0u) ? 1u : 0u; mine = (j == x) ? c : mine; }
        if (sum == G) break;
        __builtin_amdgcn_s_sleep(1);
        if ((++sp & 255u) == 0u) { if (xb_ld(&bar[XB_TMO])) break; if (sp > XB_SPIN_CAP) { atomicAdd(&bar[XB_TMO], 1u); break; } }
    }
    nloc = mine > 0u ? mine : 1u; nx = cnt > 0u ? cnt : 1u;
}
__device__ __forceinline__ void xcd_barrier(const XcdBarrier& b) {
    asm volatile("s_waitcnt vmcnt(0)" ::: "memory");
    __syncthreads();
    if (threadIdx.x == 0) {
        unsigned* bar = b.bar;
        __builtin_amdgcn_s_waitcnt(0);
        unsigned nloc = b.st[0], nx = b.st[1];
        if (nloc == 0u) { xcd_barrier_complete(bar, b.x, nloc, nx); b.st[0] = nloc; b.st[1] = nx; }
        const unsigned old = xb_add(&bar[XB_XSUB(b.x)], 1u);
        const unsigned gen = old / nloc;
        if (old + 1u == (gen + 1u) * nloc) {
            __builtin_amdgcn_fence(__ATOMIC_RELEASE, "agent");
            asm volatile("s_waitcnt vmcnt(0)" ::: "memory");
            const unsigned og = xb_add(&bar[XB_TOP], 1u);
            const unsigned tg = og / nx;
            if (og + 1u == (tg + 1u) * nx) xb_add(&bar[XB_TOPGEN], 1u);
            else XB_SPIN(xb_ld(&bar[XB_TOPGEN]) == tg, bar);
            __builtin_amdgcn_fence(__ATOMIC_ACQUIRE, "agent");
            xb_add(&bar[XB_XGEN(b.x)], 1u);
            asm volatile("s_waitcnt vmcnt(0)" ::: "memory");
        } else {
            XB_SPIN(xb_ld(&bar[XB_XGEN(b.x)]) == gen, bar);
            __builtin_amdgcn_fence(__ATOMIC_ACQUIRE, "agent");
            asm volatile("s_waitcnt vmcnt(0)" ::: "memory");
        }
    }
    __syncthreads();
}

__global__ void __launch_bounds__(NTHR, 2) fwd(Args a_) {
    extern __shared__ __attribute__((aligned(16))) unsigned char lds[];
    cg::grid_group grid = cg::this_grid();
    const int lo = a_.ph_lo, hi = a_.ph_hi; const int rp_phase = a_.rep_phase, rp_count = a_.rep_count & 255;
#define IN(k) (lo <= (k) && (k) < hi)
    volatile __attribute__((address_space(3))) unsigned* bst = (volatile __attribute__((address_space(3))) unsigned*)((__attribute__((address_space(3))) unsigned char*)lds + (LDS_BYTES - 64));
    if (threadIdx.x < 2) bst[threadIdx.x] = 0u;
    __syncthreads();
    const XcdBarrier xbar = xcd_barrier_post((unsigned*)(a_.ws + WS_CTL), bst);
    if (lo < 0) grid.sync();
#define SEAM(k) do { if (IN(k) && IN((k) + 1)) xcd_barrier(xbar); } while (0)
    if (IN(0)) _Pragma("unroll 1") for (int rep = 0, nrep = (rp_phase == 0) ? rp_count : 1; rep < nrep; ++rep) phase_prep(kargs(), lds);
    SEAM(0);
    if (IN(1)) _Pragma("unroll 1") for (int rep = 0, nrep = (rp_phase == 1) ? rp_count : 1; rep < nrep; ++rep) phase_norm(kargs(), 0, false, true, lds);
    SEAM(1);
    for (int l = 0; l < DEPTH; ++l) {
        const int p = 2 + 6 * l;
        if (IN(p)) {
            unsigned char* ws = kargs().ws;
            const bf16_t* HB = (const bf16_t*)(ws + WS_HB);
            const bf16_t* WinT = (const bf16_t*)(ws + WS_WINT) + (size_t)l * NPK * DM;
#if NAIVE_GEMM
            gemm_naive(HB, WinT, MT, NU1, DM, ws + WS_U1, NU1, 0, lds);
            gemm_naive(HB, WinT + (size_t)NU1 * DM, MT, NU2, DM, ws + WS_UT, MT, 1, lds);
#else
            DecIn d{(const char*)HB, (const char*)WinT, (char*)(ws + WS_U1), (char*)(ws + WS_UT)};
            pg8::GridOrder<DecIn> S; S.init(MT / 256, NPK / 256, gridDim.x, blockIdx.x, d);
            _Pragma("unroll 1") for (int rep = 0, nrep = (rp_phase == 2) ? rp_count : 1; rep < nrep; ++rep) pg8::gemm_phase<true>((PG8_LAS unsigned char*)lds, DM, S);
#endif
        }
        SEAM(p);
        if (IN(p + 1)) _Pragma("unroll 1") for (int rep = 0, nrep = (rp_phase == 9) ? rp_count : 1; rep < nrep; ++rep) phase_mprep(kargs(), l, lds, rep);
        SEAM(p + 1);
        if (IN(p + 2)) {
            const int nrep = (rp_phase == 3 || rp_phase == 4 || rp_phase == 5 || rp_phase == 11) ? rp_count : 1;
            _Pragma("unroll 1") for (int rep = 0; rep < nrep; ++rep)
                phase_mixers(kargs(), l, lds, rep, rep == 0 || rp_phase == 3 || rp_phase == 11, rep == 0 || rp_phase == 4 || rp_phase == 11, rep == 0 || rp_phase == 5 || rp_phase == 11);
        }
        SEAM(p + 2);
        if (IN(p + 3)) _Pragma("unroll 1") for (int rep = 0, nrep = (rp_phase == 6) ? rp_count : 1; rep < nrep; ++rep) phase_combine(kargs(), l, lds);
        SEAM(p + 3);
        if (IN(p + 4)) {
            unsigned char* ws = kargs().ws;
            const bf16_t* WoutT = (const bf16_t*)(ws + WS_WOUTT) + (size_t)l * DM * DM;
#if NAIVE_GEMM
            gemm_naive((const bf16_t*)(ws + WS_YMIX), WoutT, (l == 0) ? MT : MLAT, DM, DM, ws + WS_U1, DM, 2, lds);
#else
            DecOut d{(const char*)(ws + WS_YMIX), (const char*)WoutT, (char*)(ws + WS_U1)};
            pg8::GridOrder<DecOut> S; S.init(((l == 0) ? MT : MLAT) / 256, DM / 256, gridDim.x, blockIdx.x, d);
            _Pragma("unroll 1") for (int rep = 0, nrep = (rp_phase == 7) ? rp_count : 1; rep < nrep; ++rep) pg8::gemm_phase<true>((PG8_LAS unsigned char*)lds, DM, S);
#endif
        }
        SEAM(p + 4);
        if (IN(p + 5)) _Pragma("unroll 1") for (int rep = 0, nrep = (rp_phase == 8 && l == 0) ? rp_count : 1; rep < nrep; ++rep) phase_norm(kargs(), l + 1, true, l + 1 < DEPTH, lds);
        SEAM(p + 5);
    }
    if (rp_phase == 10) for (int rep = 0; rep < rp_count; ++rep) xcd_barrier(xbar);
#undef IN
#undef SEAM
}

constexpr int NPHASES = 2 + 6 * DEPTH;

extern "C" void kernel_launch(void* const* d_in, const int* in_sizes, int n_in, void* d_out, int out_size, void* d_ws, size_t ws_size, hipStream_t stream) {
    static int grid = 0;
    if (grid == 0) {
        if (n_in != 23 || out_size != MLAT * DM || ws_size < WS_END) { fprintf(stderr, "kernel_launch: unexpected shapes n_in %d out %d ws %zu\n", n_in, out_size, ws_size); grid = -1; return; }
        int dev = 0, cus = 0, per_cu = 0;
        (void)hipGetDevice(&dev);
        (void)hipDeviceGetAttribute(&cus, hipDeviceAttributeMultiprocessorCount, dev);
        (void)hipFuncSetAttribute((const void*)fwd, hipFuncAttributeMaxDynamicSharedMemorySize, LDS_BYTES);
        (void)hipOccupancyMaxActiveBlocksPerMultiprocessor(&per_cu, (const void*)fwd, NTHR, LDS_BYTES);
        if (per_cu < 1) per_cu = 1;
        grid = cus * per_cu;
        fprintf(stderr, "kernel_launch: cus %d per_cu %d grid %d ws %zu\n", cus, per_cu, grid, ws_size);
    }
    if (grid < 0) return;
    Args a{};
    for (int i = 0; i < 23; ++i) a.in[i] = (const float*)d_in[i];
    a.out = (float*)d_out; a.ws = (unsigned char*)d_ws;
    (void)hipMemsetAsync((char*)d_ws + WS_CTL, 0, 32768, stream);
    a.ph_lo = 0; a.ph_hi = NPHASES; a.rep_phase = PROBE_PHASE; a.rep_count = PROBE_COUNT;
    void* kargs[] = {&a};
    hipError_t e = hipLaunchCooperativeKernel((const void*)fwd, dim3(grid), dim3(NTHR), kargs, LDS_BYTES, stream);
    if (e != hipSuccess) fprintf(stderr, "kernel_launch: cooperative launch failed: %s (grid %d)\n", hipGetErrorString(e), grid);
}
```

```cpp
#include <hip/hip_runtime.h>
#include <hip/hip_cooperative_groups.h>
#include <cstdio>
#include <cstdint>
namespace cg = cooperative_groups;

constexpr int NB = 8, LSEQ = 4096, DM = 1024, LCTX = 256, DEPTH = 2;
constexpr int MLAT = NB * LSEQ, MCTX = NB * LCTX, MT = MLAT + MCTX;
constexpr int DIN = 4624, NU1 = 2560, NU2 = 2048, NPK = NU1 + NU2;
constexpr int QK8_STRIDE = (LCTX + LSEQ) * 256 + 8192;
constexpr int LDU1 = 2048;
constexpr int NH = 4, HD = 128, DML = 512, DHY = 512;
constexpr float RMS_EPS = 1e-6f;
constexpr int NTHR = 512;
constexpr int LDS_BYTES = 147456;
#ifndef PROBE_PHASE
#define PROBE_PHASE -1
#endif
#ifndef PROBE_COUNT
#define PROBE_COUNT 1
#endif
#ifndef REP_PREP
#define REP_PREP 1
#endif
#ifndef REP_NORM
#define REP_NORM 1
#endif
#ifndef REP_GEMM1
#define REP_GEMM1 1
#endif
#ifndef REP_MLSTM
#define REP_MLSTM 1
#endif
#ifndef REP_HYENA
#define REP_HYENA 1
#endif
#ifndef REP_HYCTX
#define REP_HYCTX 1
#endif
#ifndef REP_COMB
#define REP_COMB 1
#endif
#ifndef REP_GEMM2
#define REP_GEMM2 1
#endif
#ifndef NAIVE_MLSTM
#define NAIVE_MLSTM 0
#endif
#ifndef NAIVE_HYENA
#define NAIVE_HYENA 0
#endif
#ifndef NAIVE_GEMM
#define NAIVE_GEMM 0
#endif

constexpr size_t MiB = 1u << 20;
constexpr size_t WS_CTL = 0;
constexpr size_t WS_MOD = 1 * MiB;
constexpr size_t WS_HDN = 2 * MiB;
constexpr size_t WS_HDNC = 4 * MiB;
constexpr size_t WS_GATES = 5 * MiB;
constexpr size_t WS_WGT = 512 * 1024;
constexpr size_t WS_GP = 4 * MiB + 256 * 1024;
constexpr size_t WS_XC1 = 8 * MiB;
constexpr size_t WS_WINT = 16 * MiB;
constexpr size_t WS_WOUTT = 34 * MiB;
constexpr size_t WS_HB = 40 * MiB;
constexpr size_t WS_U1 = 108 * MiB;
constexpr size_t WS_V2 = 244 * MiB;
constexpr size_t WS_UT = 280 * MiB;
constexpr size_t WS_YMIX = 416 * MiB;
constexpr size_t WS_FT = 485 * MiB;
constexpr size_t WS_END = 502 * MiB;

constexpr int CW_QUEUE = 4096;

typedef unsigned short bf16_t;
typedef float f32x4 __attribute__((ext_vector_type(4)));
typedef float f32x2 __attribute__((ext_vector_type(2)));
typedef unsigned u32x4 __attribute__((ext_vector_type(4)));
typedef unsigned u32x2 __attribute__((ext_vector_type(2)));

struct Args {
    const float* in[23];
    float* out;
    unsigned char* ws;
    int ph_lo, ph_hi;
    int rep_phase, rep_count;
};

__device__ __forceinline__ float bf2f(unsigned b) { return __uint_as_float(b << 16); }
__device__ __forceinline__ unsigned f2bf(float f) { unsigned u = __float_as_uint(f); return (u + 0x7fffu + ((u >> 16) & 1u)) >> 16; }
__device__ __forceinline__ unsigned pk2(float lo, float hi) { return f2bf(lo) | (f2bf(hi) << 16); }
__device__ __forceinline__ float bflo(unsigned x) { return __uint_as_float(x << 16); }
__device__ __forceinline__ float bfhi(unsigned x) { return __uint_as_float(x & 0xffff0000u); }
__device__ __forceinline__ float silu_f(float x) { return x / (1.f + __expf(-x)); }
__device__ __forceinline__ float sigmoid_f(float x) { return 1.f / (1.f + __expf(-x)); }
typedef const Args __attribute__((address_space(4)))* KArgsP;
__device__ __forceinline__ Args kargs() {
    int z = 0; asm volatile("" : "+s"(z));
    KArgsP p = (KArgsP)((const char __attribute__((address_space(4)))*)__builtin_amdgcn_kernarg_segment_ptr() + z);
    Args a;
#pragma unroll
    for (int i = 0; i < 23; ++i) a.in[i] = p->in[i];
    a.out = p->out; a.ws = p->ws; a.ph_lo = p->ph_lo; a.ph_hi = p->ph_hi; a.rep_phase = p->rep_phase; a.rep_count = p->rep_count;
    return a;
}
__device__ __forceinline__ int opaque_tid() { int t = threadIdx.x; asm volatile("" : "+v"(t)); return t; }
__device__ __forceinline__ float wave_sum(float v) {
#pragma unroll
    for (int o = 1; o < 64; o <<= 1) v += __shfl_xor(v, o);
    return v;
}

__device__ __forceinline__ void phase_prep(const Args& a, unsigned char* lds) {
    const int tid = opaque_tid(), G = gridDim.x;
    float* scr = (float*)lds;
    constexpr int IT_WIN = 2 * 16 * 72, IT_WOUT = 2 * 16 * 16, IT_MOD = 2 * 48, IT_HDN = 132, IT_WG = 2;
    constexpr int NIT = IT_WIN + IT_WOUT + IT_MOD + IT_HDN + IT_WG;
    bool s_loaded = false;
    for (int it = blockIdx.x; it < NIT; it += G) {
        int r = it;
        if (r < IT_WIN + IT_WOUT) {
            const float* W; bf16_t* WT; int N, kb, nb, srccol;
            if (r < IT_WIN) { const int l = r / (16 * 72); r %= 16 * 72; kb = r / 72; nb = r % 72; N = DIN;
                W = a.in[8] + (size_t)l * DM * DIN; WT = (bf16_t*)(a.ws + WS_WINT) + (size_t)l * NPK * DM; srccol = nb * 64 + (nb >= 40 ? 16 : 0); }
            else { r -= IT_WIN; const int l = r / 256; r %= 256; kb = r / 16; nb = r % 16; N = DM;
                W = a.in[22] + (size_t)l * DM * DM; WT = (bf16_t*)(a.ws + WS_WOUTT) + (size_t)l * DM * DM; srccol = nb * 64; }
            __syncthreads();
#pragma unroll
            for (int i = 0; i < 8; ++i) { const int e = tid + i * 512, kk = e >> 6, nn = e & 63; scr[kk * 65 + nn] = W[(size_t)(kb * 64 + kk) * N + srccol + nn]; }
            __syncthreads();
            { const int nn = tid >> 3, k8 = (tid & 7) * 8; u32x4 o;
              o.x = pk2(scr[(k8 + 0) * 65 + nn], scr[(k8 + 1) * 65 + nn]); o.y = pk2(scr[(k8 + 2) * 65 + nn], scr[(k8 + 3) * 65 + nn]);
              o.z = pk2(scr[(k8 + 4) * 65 + nn], scr[(k8 + 5) * 65 + nn]); o.w = pk2(scr[(k8 + 6) * 65 + nn], scr[(k8 + 7) * 65 + nn]);
              *(u32x4*)(WT + (size_t)(nb * 64 + nn) * DM + kb * 64 + k8) = o; }
            continue;
        }
        r -= IT_WIN + IT_WOUT;
        if (r < IT_MOD) {
            const int l = r / 48, cb = r % 48;
            float* S = scr + 8192;
            float* P = scr;
            __syncthreads();
            if (!s_loaded) {
                for (int i = tid; i < 9 * 1024; i += 512) { const int v = i >> 10, k = i & 1023; const float cv = (v < 8) ? a.in[1][v * 1024 + k] : a.in[3][k]; S[i] = silu_f(cv); }
                s_loaded = true;
            }
            __syncthreads();
            const int kg = tid >> 6, col = cb * 64 + (tid & 63);
            const float* W = a.in[4] + (size_t)l * DM * 3072;
            float acc[9];
#pragma unroll
            for (int v = 0; v < 9; ++v) acc[v] = 0.f;
            for (int k = kg * 128; k < kg * 128 + 128; ++k) { const float w = W[(size_t)k * 3072 + col];
#pragma unroll
                for (int v = 0; v < 9; ++v) acc[v] += S[v * 1024 + k] * w; }
#pragma unroll
            for (int v = 0; v < 9; ++v) P[(kg * 9 + v) * 64 + (tid & 63)] = acc[v];
            __syncthreads();
            for (int i = tid; i < 9 * 64; i += 512) { const int v = i >> 6, cc = i & 63; float s = a.in[5][l * 3072 + cb * 64 + cc];
#pragma unroll
                for (int g = 0; g < 8; ++g) s += P[(g * 9 + v) * 64 + cc];
                ((float*)(a.ws + WS_MOD))[(size_t)(l * 9 + v) * 3072 + cb * 64 + cc] = s; }
            continue;
        }
        r -= IT_MOD;
        if (r >= IT_HDN) {
            const int l = r - IT_HDN; const float* w = a.in[8] + (size_t)l * DM * DIN; bf16_t* wg = (bf16_t*)(a.ws + WS_WGT) + (size_t)l * 16 * 1024;
            for (int i = tid; i < 16384; i += 512) wg[(i & 15) * 1024 + (i >> 4)] = (bf16_t)f2bf(w[(size_t)(i >> 4) * DIN + 2560 + (i & 15)]);
            continue;
        }
        {
            __syncthreads();
            float* W1 = scr;
            float* W2 = scr + 17 * 64;
            float* B1 = W2 + 64 * 64; float* B2 = B1 + 64; float* F0 = B2 + 64; float* F1 = F0 + 64;
            float* FT = F1 + 64;
            float* H1 = FT + 8 * 17;
            const int lb = ((r * 64) < 8192) ? ((r * 64) >> 12) : 0;
            for (int i = tid; i < 17 * 64; i += 512) W1[i] = a.in[15][lb * 17 * 64 + i];
            for (int i = tid; i < 64 * 64; i += 512) W2[i] = a.in[18][lb * 64 * 64 + i];
            if (tid < 64) { B1[tid] = a.in[16][lb * 64 + tid]; B2[tid] = a.in[19][lb * 64 + tid]; F0[tid] = a.in[17][lb * 128 + tid]; F1[tid] = a.in[17][lb * 128 + 64 + tid]; }
            const int j = tid & 63, pg = tid >> 6;
            for (int sub = 0; sub < 8; ++sub) {
                const int p = r * 64 + sub * 8 + pg;
                const int L = (p < 8192) ? 4096 : 256; const int pos = (p < 8192) ? (p & 4095) : (p - 8192);
                __syncthreads();
                if (j < 17) { float f;
                    if (j == 0) f = (float)pos / (float)L;
                    else { const int bnd = (j <= 8) ? j : j - 8; const float ang = (6.283185307179586f / (float)L) * (float)pos * (float)bnd; f = (j <= 8) ? sinf(ang) : cosf(ang); }
                    FT[pg * 17 + j] = f; }
                __syncthreads();
                { float s = B1[j];
#pragma unroll
                  for (int f = 0; f < 17; ++f) s += FT[pg * 17 + f] * W1[f * 64 + j];
                  H1[pg * 64 + j] = sinf(F0[j] * s); }
                __syncthreads();
                { float s = B2[j];
#pragma unroll 8
                  for (int i = 0; i < 64; ++i) s += H1[pg * 64 + i] * W2[i * 64 + j];
                  float* dst = (p < 8192) ? (float*)(a.ws + WS_HDN) + (size_t)p * 64 : (float*)(a.ws + WS_HDNC) + (size_t)pos * 64;
                  dst[j] = sinf(F1[j] * s); }
            }
        }
    }
    __syncthreads();
}

__device__ __forceinline__ void phase_norm(const Args& a, int l, bool has_prev, bool do_next, unsigned char* lds) {
    const int tid = opaque_tid(), G = gridDim.x, lane = tid & 63, wave = tid >> 6;
    const float* MOD = (const float*)(a.ws + WS_MOD);
    const bf16_t* Y = (const bf16_t*)(a.ws + WS_U1);
    bf16_t* HB = (bf16_t*)(a.ws + WS_HB);
    float* XC1 = (float*)(a.ws + WS_XC1);
    const int nrows = do_next ? MT : MLAT;
    const bool from_out = !(l == 0 || (has_prev && l == 1));
    const float* xlat = from_out ? (const float*)a.out : a.in[0]; const float* xctx = a.in[2];
#define XSRC(row) (((row) >= MLAT) ? xctx + (size_t)((row) - MLAT) * DM : xlat + (size_t)(row) * DM)
    f32x4 nx[4]; u32x2 ny[4];
    int row = blockIdx.x * 8 + wave;
    if (row < nrows) {
#pragma unroll
        for (int j = 0; j < 4; ++j) { nx[j] = ((const f32x4*)XSRC(row))[lane + 64 * j]; ny[j] = has_prev ? ((const u32x2*)(Y + (size_t)row * DM))[lane + 64 * j] : (u32x2){0u, 0u}; }
    }
    for (; row < nrows; row += G * 8) {
        const bool is_ctx = row >= MLAT; const int mv = is_ctx ? 8 : (row >> 12);
        float* xout = is_ctx ? XC1 + (size_t)(row - MLAT) * DM : a.out + (size_t)row * DM;
        f32x4 xv[4]; u32x2 yr[4];
#pragma unroll
        for (int j = 0; j < 4; ++j) { xv[j] = nx[j]; yr[j] = ny[j]; }
        const int nrow = row + G * 8;
        if (nrow < nrows) {
#pragma unroll
            for (int j = 0; j < 4; ++j) { nx[j] = ((const f32x4*)XSRC(nrow))[lane + 64 * j]; ny[j] = has_prev ? ((const u32x2*)(Y + (size_t)nrow * DM))[lane + 64 * j] : (u32x2){0u, 0u}; }
        }
        if (has_prev) {
            const int lp = l - 1;
            f32x4 yv[4]; float ss = 0.f;
#pragma unroll
            for (int j = 0; j < 4; ++j) { yv[j] = (f32x4){bflo(yr[j].x), bfhi(yr[j].x), bflo(yr[j].y), bfhi(yr[j].y)}; ss += yv[j].x * yv[j].x + yv[j].y * yv[j].y + yv[j].z * yv[j].z + yv[j].w * yv[j].w; }
            const float r = rsqrtf(wave_sum(ss) * (1.f / DM) + RMS_EPS);
#pragma unroll
            for (int j = 0; j < 4; ++j) { const f32x4 gt = ((const f32x4*)(MOD + (size_t)(lp * 9 + mv) * 3072 + 2048))[lane + 64 * j]; const f32x4 pg = ((const f32x4*)(a.in[7] + lp * DM))[lane + 64 * j];
                xv[j] = xv[j] + gt * (yv[j] * r * pg); ((f32x4*)xout)[lane + 64 * j] = xv[j]; }
        }
        if (do_next) {
            float ss = 0.f;
#pragma unroll
            for (int j = 0; j < 4; ++j) ss += xv[j].x * xv[j].x + xv[j].y * xv[j].y + xv[j].z * xv[j].z + xv[j].w * xv[j].w;
            const float r = rsqrtf(wave_sum(ss) * (1.f / DM) + RMS_EPS);
#pragma unroll
            for (int j = 0; j < 4; ++j) {
                const f32x4 pg = ((const f32x4*)(a.in[6] + l * DM))[lane + 64 * j];
                const f32x4 sh = ((const f32x4*)(MOD + (size_t)(l * 9 + mv) * 3072))[lane + 64 * j];
                const f32x4 sc = ((const f32x4*)(MOD + (size_t)(l * 9 + mv) * 3072 + 1024))[lane + 64 * j];
                const f32x4 h = xv[j] * r * pg * (sc + 1.f) + sh;
                u32x2 o; o.x = pk2(h.x, h.y); o.y = pk2(h.z, h.w);
                ((u32x2*)(HB + (size_t)row * DM))[lane + 64 * j] = o;
            }
        }
    }
#undef XSRC
    __syncthreads();
}

__device__ __forceinline__ void gemm_naive(const bf16_t* A, const bf16_t* Bt, int M, int N, int K, void* out, int ldo, int mode, unsigned char* lds) {
    const int tid = opaque_tid(), G = gridDim.x;
    float* As = (float*)lds;
    float* Bs = As + 64 * 33;
    const int ntm = M / 64, ntn = N / 64;
    const int ty = tid >> 4, tx = tid & 15;
    for (int t = blockIdx.x; t < ntm * ntn; t += G) {
        const int tm = t / ntn, tn = t % ntn;
        float acc[2][4] = {};
        for (int k0 = 0; k0 < K; k0 += 32) {
            __syncthreads();
            { const int r = tid >> 3, c4 = (tid & 7) * 4;
              const u32x2 va = *(const u32x2*)(A + (size_t)(tm * 64 + r) * K + k0 + c4);
              As[r * 33 + c4] = bf2f(va.x & 0xffff); As[r * 33 + c4 + 1] = bf2f(va.x >> 16); As[r * 33 + c4 + 2] = bf2f(va.y & 0xffff); As[r * 33 + c4 + 3] = bf2f(va.y >> 16);
              const u32x2 vb = *(const u32x2*)(Bt + (size_t)(tn * 64 + r) * K + k0 + c4);
              Bs[r * 33 + c4] = bf2f(vb.x & 0xffff); Bs[r * 33 + c4 + 1] = bf2f(vb.x >> 16); Bs[r * 33 + c4 + 2] = bf2f(vb.y & 0xffff); Bs[r * 33 + c4 + 3] = bf2f(vb.y >> 16); }
            __syncthreads();
#pragma unroll 8
            for (int kk = 0; kk < 32; ++kk) {
                const float a0 = As[(ty * 2) * 33 + kk], a1 = As[(ty * 2 + 1) * 33 + kk];
#pragma unroll
                for (int j = 0; j < 4; ++j) { const float b = Bs[(tx * 4 + j) * 33 + kk]; acc[0][j] += a0 * b; acc[1][j] += a1 * b; }
            }
        }
#pragma unroll
        for (int i = 0; i < 2; ++i)
#pragma unroll
            for (int j = 0; j < 4; ++j) { const size_t r = tm * 64 + ty * 2 + i, c = tn * 64 + tx * 4 + j;
                if (mode == 0) ((bf16_t*)out)[r * ldo + c] = (bf16_t)f2bf(acc[i][j]);
                else if (mode == 1) ((bf16_t*)out)[c * ldo + r] = (bf16_t)f2bf(acc[i][j]);
                else ((float*)out)[r * ldo + c] = acc[i][j]; }
    }
    __syncthreads();
}


namespace pg8 {
#define PG8_LAS __attribute__((address_space(3)))
typedef short bf16x8 __attribute__((ext_vector_type(8)));
constexpr int BM = 256, BK = 64, HALF = 128, HTB = HALF * BK * 2, STAGE_BYTES = 8 * HTB, NXCD = 8, WGM = 8;
__device__ __forceinline__ int lds_byte(int r, int c) { const int st = (r >> 4) * 2 + (c >> 5), rr = r & 15, cc = c & 31, ob = rr * 64 + cc * 2; return st * 1024 + (ob ^ (((ob >> 9) & 1) << 5)); }
__device__ __forceinline__ void stage_rc(int b, int& R, int& C) { const int st = b / 1024, sb = b % 1024, swz = sb ^ (((sb >> 9) & 1) << 5); R = (st >> 1) * 16 + swz / 64; C = (st & 1) * 32 + (swz % 64) / 2; }
__device__ __forceinline__ int perm32(int rho) { const int n = rho >> 4, i = rho & 15; return 8 * (i >> 2) + 4 * n + (i & 3); }
__device__ __forceinline__ unsigned cvt_pk_bf16(float lo, float hi) { unsigned r; asm volatile("v_cvt_pk_bf16_f32 %0, %1, %2" : "=v"(r) : "v"(lo), "v"(hi)); return r; }

struct Unit { const char* A; const char* B; char* out; int ldo, r0, c0, bjs; };

template <class Dec> struct GridOrder {
    int nM, nN, nwg, G, c; Dec dec;
    __device__ void init(int nM_, int nN_, int G_, int c_, const Dec& d) { nM = nM_; nN = nN_; nwg = nM * nN; G = G_; c = c_; dec = d; }
    __device__ bool next(int i, Unit& u) const {
        const long L = (long)i * G + c; if (L >= nwg) return false;
        int wgid = (int)L; { const int q = nwg / NXCD, r = nwg % NXCD, xcd = wgid % NXCD, off = wgid / NXCD; wgid = (xcd < r ? xcd * (q + 1) : r * (q + 1) + (xcd - r) * q) + off; }
        const int nig = WGM * nN, gid = wgid / nig, fm = gid * WGM, gsz = (nM - fm) < WGM ? (nM - fm) : WGM;
        const int pm = fm + ((wgid % nig) % gsz), pn = (wgid % nig) / gsz; dec(pm, pn, u); return true;
    }
};

template <bool PERM, class Sched>
__device__ __forceinline__ void gemm_phase(PG8_LAS unsigned char* lds, const int K, const Sched& S) {
    const int tid = opaque_tid(), wid = __builtin_amdgcn_readfirstlane(tid >> 6), lane = tid & 63, wr = wid >> 2, wc = wid & 3, fr = lane & 15, fq = lane >> 4;
    const int nt = K / BK;
    unsigned voffA[2], voffB[2];
#pragma unroll
    for (int i = 0; i < 2; ++i) { int R, C; stage_rc(tid * 16 + i * 8192, R, C); const int Rb = PERM ? ((R & ~31) + perm32(R & 31)) : R;
        voffA[i] = (unsigned)(R * K + C) * 2u; voffB[i] = (unsigned)(Rb * K + C) * 2u; }
    const size_t kstep = (size_t)(BK * 2);
    const size_t hstep = (size_t)HALF * K * 2;
    const unsigned ldsw = (unsigned)wid * 1024u;
    const int aoff = lds_byte(wr * 64 + fr, fq * 8), boff = lds_byte(wc * 32 + fr, fq * 8);
#define PG8_SA(b, h) (((b) * 2 + (h)) * HTB)
#define PG8_SB(b, h) ((4 + (b) * 2 + (h)) * HTB)
#define PG8_STAGE(bufoff, gbase, voff) do { _Pragma("unroll") for (int _i = 0; _i < 2; ++_i) \
        __builtin_amdgcn_global_load_lds((const unsigned*)((const char*)(gbase) + (voff)[_i]), (PG8_LAS unsigned*)(lds + (bufoff) + ldsw + _i * 8192), 16, 0, 0); } while (0)
#define PG8_LDA(dst, b, h) do { _Pragma("unroll") for (int m = 0; m < 4; ++m) _Pragma("unroll") for (int k = 0; k < 2; ++k) dst[m][k] = *(const PG8_LAS bf16x8*)(lds + PG8_SA(b, h) + aoff + m * 2048 + k * 1024); } while (0)
#define PG8_LDB(dst, b, h) do { _Pragma("unroll") for (int n = 0; n < 2; ++n) _Pragma("unroll") for (int k = 0; k < 2; ++k) dst[n][k] = *(const PG8_LAS bf16x8*)(lds + PG8_SB(b, h) + boff + n * 2048 + k * 1024); } while (0)
#define PG8_MMA(ai, bj, At, Bt) do { __builtin_amdgcn_s_setprio(1); _Pragma("unroll") for (int m = 0; m < 4; ++m) _Pragma("unroll") for (int n = 0; n < 2; ++n) _Pragma("unroll") for (int k = 0; k < 2; ++k) \
        acc[ai][bj][m][n] = __builtin_amdgcn_mfma_f32_16x16x32_bf16(Bt[n][k], At[m][k], acc[ai][bj][m][n], 0, 0, 0); __builtin_amdgcn_s_setprio(0); } while (0)
#define PG8_WAIT_V(n) asm volatile("s_waitcnt vmcnt(" #n ")" ::: "memory")
#define PG8_WAIT_L(n) asm volatile("s_waitcnt lgkmcnt(" #n ")" ::: "memory")
#define PG8_BAR __builtin_amdgcn_s_barrier()
#define PG8_SCHED __builtin_amdgcn_sched_barrier(0)
    Unit cur, nxt; int ui = 0;
    if (!S.next(0, cur)) return;
    f32x4 acc[2][2][4][2];
#pragma unroll
    for (int a = 0; a < 2; ++a)
#pragma unroll
        for (int b = 0; b < 2; ++b)
#pragma unroll
            for (int m = 0; m < 4; ++m)
#pragma unroll
                for (int n = 0; n < 2; ++n) acc[a][b][m][n] = (f32x4){0.f, 0.f, 0.f, 0.f};
    bf16x8 At[4][2], B0[2][2], B1[2][2];
    const char* cA = cur.A; const char* cB = cur.B;
    PG8_STAGE(PG8_SB(0, 0), cB, voffB); PG8_STAGE(PG8_SA(0, 0), cA, voffA); PG8_STAGE(PG8_SB(0, 1), cB + hstep, voffB); PG8_STAGE(PG8_SA(0, 1), cA + hstep, voffA);
    if (wr == 1) PG8_BAR;
    PG8_WAIT_V(4); PG8_BAR;
    PG8_STAGE(PG8_SB(1, 0), cB + kstep, voffB); PG8_STAGE(PG8_SA(1, 0), cA + kstep, voffA); PG8_STAGE(PG8_SB(1, 1), cB + hstep + kstep, voffB);
    PG8_WAIT_V(6); PG8_BAR;
    for (;;) {
        const bool has_next = S.next(ui + 1, nxt);
        const char* nA = has_next ? nxt.A : cA; const char* nB = has_next ? nxt.B : cB;
        for (int t = 0; t < nt; t += 2) {
            const bool last = (t == nt - 2);
            const char* a1 = cA + (size_t)(t + 1) * kstep;
            const char* a2 = last ? nA : cA + (size_t)(t + 2) * kstep; const char* b2 = last ? nB : cB + (size_t)(t + 2) * kstep;
            const char* a3 = a2 + kstep; const char* b3 = b2 + kstep;
            PG8_LDB(B0, 0, 0); PG8_SCHED; PG8_LDA(At, 0, 0); PG8_STAGE(PG8_SA(1, 1), a1 + hstep, voffA);
            PG8_WAIT_L(8); PG8_BAR; PG8_WAIT_L(0); PG8_MMA(0, 0, At, B0); PG8_BAR; PG8_SCHED;
            PG8_LDB(B1, 0, 1); PG8_STAGE(PG8_SB(0, 0), b2, voffB);
            PG8_BAR; PG8_WAIT_L(0); PG8_MMA(0, 1, At, B1); PG8_BAR;
            PG8_LDA(At, 0, 1); PG8_STAGE(PG8_SA(0, 0), a2, voffA);
            PG8_BAR; PG8_WAIT_L(0); PG8_MMA(1, 0, At, B0); PG8_BAR; PG8_SCHED;
            PG8_STAGE(PG8_SB(0, 1), b2 + hstep, voffB);
            PG8_WAIT_V(6); PG8_BAR; PG8_MMA(1, 1, At, B1); PG8_BAR;
            PG8_LDB(B0, 1, 0); PG8_SCHED; PG8_LDA(At, 1, 0); PG8_STAGE(PG8_SA(0, 1), a2 + hstep, voffA);
            PG8_WAIT_L(8); PG8_BAR; PG8_WAIT_L(0); PG8_MMA(0, 0, At, B0); PG8_BAR; PG8_SCHED;
            PG8_LDB(B1, 1, 1); PG8_STAGE(PG8_SB(1, 0), b3, voffB);
            PG8_BAR; PG8_WAIT_L(0); PG8_MMA(0, 1, At, B1); PG8_BAR;
            PG8_LDA(At, 1, 1); PG8_STAGE(PG8_SA(1, 0), a3, voffA);
            PG8_BAR; PG8_WAIT_L(0); PG8_MMA(1, 0, At, B0); PG8_BAR; PG8_SCHED;
            PG8_STAGE(PG8_SB(1, 1), b3 + hstep, voffB);
            PG8_WAIT_V(6); PG8_BAR; PG8_MMA(1, 1, At, B1); PG8_BAR;
        }
        {
            const int row0 = cur.r0 + wr * 64 + fr;
            if (PERM) {
                bf16_t* base = (bf16_t*)cur.out; const int col0 = cur.c0 + wc * 32 + 8 * fq;
#pragma unroll
                for (int ai = 0; ai < 2; ++ai)
#pragma unroll
                    for (int m = 0; m < 4; ++m) { bf16_t* rowp = base + (size_t)(row0 + ai * HALF + m * 16) * cur.ldo + col0;
#pragma unroll
                        for (int bj = 0; bj < 2; ++bj) { const f32x4 v0 = acc[ai][bj][m][0], v1 = acc[ai][bj][m][1];
                            u32x4 w; w.x = cvt_pk_bf16(v0[0], v0[1]); w.y = cvt_pk_bf16(v0[2], v0[3]); w.z = cvt_pk_bf16(v1[0], v1[1]); w.w = cvt_pk_bf16(v1[2], v1[3]);
                            *(u32x4*)(rowp + bj * cur.bjs) = w; } }
            } else {
                float* base = (float*)cur.out; const int col0 = cur.c0 + wc * 32 + 4 * fq;
#pragma unroll
                for (int ai = 0; ai < 2; ++ai)
#pragma unroll
                    for (int m = 0; m < 4; ++m) { float* rowp = base + (size_t)(row0 + ai * HALF + m * 16) * cur.ldo + col0;
#pragma unroll
                        for (int bj = 0; bj < 2; ++bj)
#pragma unroll
                            for (int n = 0; n < 2; ++n) *(f32x4*)(rowp + bj * cur.bjs + n * 16) = acc[ai][bj][m][n]; }
            }
        }
        if (!has_next) break;
#pragma unroll
        for (int a = 0; a < 2; ++a)
#pragma unroll
            for (int b = 0; b < 2; ++b)
#pragma unroll
                for (int m = 0; m < 4; ++m)
#pragma unroll
                    for (int n = 0; n < 2; ++n) acc[a][b][m][n] = (f32x4){0.f, 0.f, 0.f, 0.f};
        cur = nxt; cA = nA; cB = nB; ++ui;
    }
    PG8_WAIT_V(0);
    if (wr == 0) PG8_BAR;
    PG8_BAR;
#undef PG8_SA
#undef PG8_SB
#undef PG8_STAGE
#undef PG8_LDA
#undef PG8_LDB
#undef PG8_MMA
#undef PG8_WAIT_V
#undef PG8_WAIT_L
#undef PG8_BAR
#undef PG8_SCHED
}
}

struct DecIn {
    const char* HB; const char* W; char* U1; char* UT;
    __device__ void operator()(int pm, int pn, pg8::Unit& u) const {
        const char* tp = HB + (size_t)pm * 256 * DM * 2; const char* wp = W + (size_t)pn * 256 * DM * 2;
        u.bjs = 128;
        if (pn < 4) { u.A = tp; u.B = wp; u.out = U1; u.ldo = LDU1; u.r0 = pm * 256; u.c0 = pn * 256; }
        else if (pn < 6) {
            const int bb = pm < 128 ? pm >> 4 : pm - 128, srow0 = pm < 128 ? LCTX + (pm & 15) * 256 : 0;
            u.A = tp; u.B = wp; u.out = U1 + (WS_V2 - WS_U1) + ((size_t)(bb * 4 + 2 * (pn - 4)) * (LCTX + LSEQ) + srow0) * 128 * 2; u.ldo = 128; u.r0 = 0; u.c0 = 0; u.bjs = (LCTX + LSEQ) * 128; }
        else if (pn < 10) { u.A = tp; u.B = wp; u.out = U1; u.ldo = LDU1; u.r0 = pm * 256; u.c0 = (pn - 2) * 256; }
        else { u.A = wp; u.B = tp; u.out = UT; u.ldo = MT; u.r0 = (pn - 10) * 256; u.c0 = pm * 256; }
    }
};
struct DecOut {
    const char* YM; const char* W; char* Y;
    __device__ void operator()(int pm, int pn, pg8::Unit& u) const {
        u.A = YM + (size_t)pm * 256 * DM * 2; u.B = W + (size_t)pn * 256 * DM * 2; u.out = Y; u.ldo = DM; u.r0 = pm * 256; u.c0 = pn * 256; u.bjs = 128;
    }
};

__device__ __forceinline__ void mlstm_naive(const Args& a, int l, unsigned char* lds) {
    const int tid = opaque_tid(), G = gridDim.x;
    const bf16_t* U1 = (const bf16_t*)(a.ws + WS_U1);
    const float* GATES = (const float*)(a.ws + WS_GATES);
    bf16_t* HDo = (bf16_t*)(a.ws + WS_HB);
    float* qs = (float*)lds; float* ks = qs + 128; float* vs = ks + 128; float* sc = vs + 32;
    float* pnum = sc + 8;
    float* pden = pnum + 512;
    const float* cw = a.in[10] + (size_t)l * 3 * 1024; const float* cb = a.in[11] + (size_t)l * 1024;
    for (int it = blockIdx.x; it < 256; it += G) {
        const int dvs = it & 3, dir = (it >> 2) & 1, hh = (it >> 3) & 3, b = it >> 5;
        float C[8], nn[8];
#pragma unroll
        for (int i = 0; i < 8; ++i) { C[i] = 0.f; nn[i] = 0.f; }
        float m = 0.f;
        const int j = tid & 31, dg = tid >> 5;
        for (int step = 0; step < LCTX + LSEQ; ++step) {
            int seqlen, tt, rowbase; bool is_ctx = step < LCTX;
            if (is_ctx) { seqlen = LCTX; tt = dir ? (LCTX - 1 - step) : step; rowbase = MLAT + b * LCTX; }
            else { seqlen = LSEQ; const int s2 = step - LCTX; tt = dir ? (LSEQ - 1 - s2) : s2; rowbase = b * LSEQ; }
            const int row = rowbase + tt;
            if (tid < 256) {
                const int ch = (tid < 128) ? (hh * 128 + tid) : (512 + hh * 128 + (tid - 128));
                bool has_l, has_r;
                if (is_ctx) { has_l = tt > 0; has_r = tt < seqlen - 1; } else { has_l = (tt & 63) != 0; has_r = (tt & 63) != 63; }
                float v = bf2f(U1[(size_t)row * NU1 + ch]) * cw[1024 + ch] + cb[ch];
                if (has_l) v += bf2f(U1[(size_t)(row - 1) * NU1 + ch]) * cw[ch];
                if (has_r) v += bf2f(U1[(size_t)(row + 1) * NU1 + ch]) * cw[2048 + ch];
                v = silu_f(v);
                if (tid < 128) qs[tid] = v; else ks[tid - 128] = v * 0.08838834764831845f;
            } else if (tid < 288) {
                vs[tid - 256] = bf2f(U1[(size_t)row * NU1 + 1024 + hh * 128 + dvs * 32 + (tid - 256)]);
            } else if (tid == 288) {
                const float ip = GATES[(size_t)row * 16 + (2 * dir) * 4 + hh], fp = GATES[(size_t)row * 16 + (2 * dir + 1) * 4 + hh];
                const float logf = fminf(fp, 0.f) - log1pf(__expf(-fabsf(fp)));
                const float mn = fmaxf(logf + m, ip);
                sc[0] = __expf(logf + m - mn); sc[1] = __expf(ip - mn); sc[2] = __expf(-mn);
                m = mn;
            }
            __syncthreads();
            const float fw = sc[0], iw = sc[1];
            float pn = 0.f, pd = 0.f;
#pragma unroll
            for (int dd = 0; dd < 8; ++dd) { const int d = dg * 8 + dd; const float kk = ks[d], qq = qs[d];
                C[dd] = fw * C[dd] + iw * kk * vs[j]; nn[dd] = fw * nn[dd] + iw * kk; pn += qq * C[dd]; pd += qq * nn[dd]; }
            pnum[dg * 32 + j] = pn; if (j == 0) pden[dg] = pd;
            __syncthreads();
            if (tid < 32) { float num = 0.f, den = 0.f;
#pragma unroll
                for (int g = 0; g < 16; ++g) { num += pnum[g * 32 + tid]; den += pden[g]; }
                const float h = num / fmaxf(fabsf(den), sc[2]);
                HDo[((size_t)dir * MT + row) * DML + hh * 128 + dvs * 32 + tid] = (bf16_t)f2bf(h); }
        }
        __syncthreads();
    }
}


#define LAS __attribute__((address_space(3)))
typedef short bf16x8 __attribute__((ext_vector_type(8)));
__device__ __forceinline__ u32x4 ldg16_or_zero(const bf16_t* p, bool ok) { u32x4 z = {0u, 0u, 0u, 0u}; return ok ? *(const u32x4*)p : z; }


__device__ __forceinline__ void filt_item(const Args& a, int l, unsigned char* lds_, int fi);
__device__ __forceinline__ void phase_mprep(const Args& a, int l, unsigned char* lds_, int rep) {
    const int tid = opaque_tid(), lane = tid & 63, wave = __builtin_amdgcn_readfirstlane(tid >> 6), fr = lane & 15, fq = lane >> 4;
    LAS float* P = (LAS float*)lds_;
    LAS float* Gs = P + 2048;
    LAS bf16_t* WgS = (LAS bf16_t*)((LAS unsigned char*)lds_ + 32768);
    LAS unsigned* qslot = (LAS unsigned*)((LAS unsigned char*)lds_ + (LDS_BYTES - 32));
    const bf16_t* U1 = (const bf16_t*)(a.ws + WS_U1);
    const bf16_t* HB = (const bf16_t*)(a.ws + WS_HB);
    const bf16_t* WgT = (const bf16_t*)(a.ws + WS_WGT) + (size_t)l * 16 * 1024;
    bf16_t* QK = (bf16_t*)(a.ws + WS_YMIX);
    float* GP = (float*)(a.ws + WS_GP);
    const float* cw = a.in[10] + (size_t)l * 3072; const float* cb = a.in[11] + (size_t)l * 1024;
    unsigned* ctr = (unsigned*)(a.ws + WS_CTL) + CW_QUEUE + 64 * (16 + l * 8 + rep);
    const int co = tid & 127, rg4 = tid >> 7;
    __syncthreads();
    for (int i = tid; i < 16 * 128; i += NTHR) { const int g = i >> 7, c8 = (i & 127) * 8; *(LAS u32x4*)(WgS + g * 1032 + c8) = *(const u32x4*)(WgT + g * 1024 + c8); }
    for (;;) {
        __syncthreads();
        if (tid == 0) *qslot = __hip_atomic_fetch_add(ctr, 1u, __ATOMIC_RELAXED, __HIP_MEMORY_SCOPE_AGENT);
        __syncthreads();
        const int item = (int)*qslot;
        if (item >= 128 + MT / 64) break;
        if (item < 128) { filt_item(a, l, lds_, item); continue; }
        const int ch = item - 128;
        const int rowbase = ch * 64;
        const bool is_ctx = rowbase >= MLAT; const int cc = is_ctx ? ((rowbase - MLAT) >> 6) & 3 : 0;
        const bool has_lo = is_ctx && cc > 0, has_hi = is_ctx && cc < 3;
        {
            const int rt = wave & 3, kh = wave >> 2;
            f32x4 acc = {0.f, 0.f, 0.f, 0.f};
            const bf16_t* ap = HB + (size_t)(rowbase + rt * 16 + fr) * DM + kh * 512 + fq * 8;
            LAS const bf16_t* bp = WgS + fr * 1032 + kh * 512 + fq * 8;
            bf16x8 af[16];
#pragma unroll
            for (int ks = 0; ks < 16; ++ks) af[ks] = *(const bf16x8*)(ap + ks * 32);
#pragma unroll
            for (int ks = 0; ks < 16; ++ks) { const bf16x8 bf = *(const LAS bf16x8*)(bp + ks * 32); acc = __builtin_amdgcn_mfma_f32_16x16x32_bf16(af[ks], bf, acc, 0, 0, 0); }
#pragma unroll
            for (int jj = 0; jj < 4; ++jj) P[(kh * 64 + rt * 16 + 4 * fq + jj) * 16 + fr] = acc[jj];
        }
        {
            float w0[8], w1[8], w2[8], bb[8];
#pragma unroll
            for (int e = 0; e < 8; ++e) { w0[e] = cw[co * 8 + e]; w1[e] = cw[1024 + co * 8 + e]; w2[e] = cw[2048 + co * 8 + e]; bb[e] = cb[co * 8 + e]; }
            u32x4 r0, r1, r2;
            { const int tt = rg4 * 16 - 1; r0 = ldg16_or_zero(U1 + (size_t)(rowbase + tt) * LDU1 + co * 8, tt >= 0 || has_lo); }
            r1 = *(const u32x4*)(U1 + (size_t)(rowbase + rg4 * 16) * LDU1 + co * 8);
            const int qb = is_ctx ? (rowbase - MLAT) >> 8 : rowbase >> 12, srow0 = is_ctx ? (rowbase - MLAT) & 255 : LCTX + (rowbase & 4095);
            unsigned char* qdst = (unsigned char*)QK + (size_t)(qb * 4 + ((co & 63) >> 4)) * QK8_STRIDE + (size_t)srow0 * 256 + (co >> 6) * 128 + (co & 15) * 8;
#pragma unroll 4
            for (int i = 0; i < 16; ++i) { const int tt = rg4 * 16 + i;
                r2 = ldg16_or_zero(U1 + (size_t)(rowbase + tt + 1) * LDU1 + co * 8, tt + 1 <= 63 || has_hi);
                float fv[8];
#pragma unroll
                for (int e2 = 0; e2 < 4; ++e2) {
                    fv[2 * e2] = silu_f(bflo(r0[e2]) * w0[2 * e2] + bflo(r1[e2]) * w1[2 * e2] + bflo(r2[e2]) * w2[2 * e2] + bb[2 * e2]);
                    fv[2 * e2 + 1] = silu_f(bfhi(r0[e2]) * w0[2 * e2 + 1] + bfhi(r1[e2]) * w1[2 * e2 + 1] + bfhi(r2[e2]) * w2[2 * e2 + 1] + bb[2 * e2 + 1]); }
                int p0 = 0, p1 = 0;
                p0 = __builtin_amdgcn_cvt_pk_fp8_f32(fv[0], fv[1], p0, false); p0 = __builtin_amdgcn_cvt_pk_fp8_f32(fv[2], fv[3], p0, true);
                p1 = __builtin_amdgcn_cvt_pk_fp8_f32(fv[4], fv[5], p1, false); p1 = __builtin_amdgcn_cvt_pk_fp8_f32(fv[6], fv[7], p1, true);
                *(u32x2*)(qdst + (size_t)tt * 256) = (u32x2){(unsigned)p0, (unsigned)p1};
                r0 = r1; r1 = r2; }
        }
        __syncthreads();
        for (int i = tid; i < 1024; i += NTHR) Gs[i] = P[i] + P[1024 + i] + a.in[9][l * 16 + (i & 15)];
        __syncthreads();
        {
            const int dir = wave >> 2, hh = wave & 3, tt = dir ? 63 - lane : lane;
            const float gi = Gs[tt * 16 + (2 * dir) * 4 + hh], gf = Gs[tt * 16 + (2 * dir + 1) * 4 + hh];
            const float logf = fminf(gf, 0.f) - log1pf(__expf(-fabsf(gf)));
            float bc = logf;
#pragma unroll
            for (int ofs = 1; ofs < 64; ofs <<= 1) { const float t = __shfl_up(bc, ofs); if (lane >= ofs) bc += t; }
            const float av = gi - bc;
            float cm = av;
#pragma unroll
            for (int ofs = 1; ofs < 64; ofs <<= 1) { const float t = __shfl_up(cm, ofs); if (lane >= ofs) cm = fmaxf(cm, t); }
            float* gp = GP + ((size_t)ch * 8 + wave) * 192;
            gp[lane] = bc; gp[64 + lane] = av; gp[128 + lane] = cm;
        }
    }
    __syncthreads();
}

__device__ __forceinline__ void dec16_fp8(const u32x4 raw, float (&f)[16]) {
#pragma unroll
    for (int e = 0; e < 4; ++e) { const f32x2 lo = __builtin_amdgcn_cvt_pk_f32_fp8((int)raw[e], false), hi = __builtin_amdgcn_cvt_pk_f32_fp8((int)raw[e], true);
        f[4 * e] = lo.x; f[4 * e + 1] = lo.y; f[4 * e + 2] = hi.x; f[4 * e + 3] = hi.y; }
}
__device__ __forceinline__ void mlstm_item(const Args& a, int l, unsigned char* lds_, int it, bool do_store) {
    const int tid = opaque_tid(), lane = tid & 63, wave = __builtin_amdgcn_readfirstlane(tid >> 6), fr = lane & 15, fq = lane >> 4;
    LAS unsigned char* lds = (LAS unsigned char*)lds_;
    LAS bf16_t* Qs = (LAS bf16_t*)(lds);
    LAS bf16_t* Ks = (LAS bf16_t*)(lds + 17408);
    LAS bf16_t* KTs = (LAS bf16_t*)(lds + 34816);
    LAS bf16_t* VTs = (LAS bf16_t*)(lds + 53248);
    LAS bf16_t* Ss = (LAS bf16_t*)(lds + 73984);
    LAS bf16_t* CTs = (LAS bf16_t*)(lds + 83200);
    LAS float* F = (LAS float*)(lds + 122368);
    LAS float* Aa = F; LAS float* Gg = F + 64; LAS float* WI = F + 128; LAS float* EM = F + 192;
    const unsigned char* QK8 = (const unsigned char*)(a.ws + WS_YMIX);
    const bf16_t* V2 = (const bf16_t*)(a.ws + WS_V2);
    const float* GP = (const float*)(a.ws + WS_GP);
    bf16_t* HDo = (bf16_t*)(a.ws + WS_HB);
    const int dir = it & 1, hh = (it >> 1) & 3, b = it >> 3;
    const int c16 = wave * 16;
    const int rpos = dir ? 63 - lane : lane;
    __syncthreads();
    for (int i = tid; i < 144 * 136 / 2; i += NTHR) ((LAS unsigned*)CTs)[i] = 0u;
    for (int i = tid; i < 16 * 72 / 2; i += NTHR) ((LAS unsigned*)(VTs + 128 * 72))[i] = (i < 36) ? 0x3f803f80u : 0u;
    f32x4 accC[9];
#pragma unroll
    for (int j = 0; j < 9; ++j) accC[j] = (f32x4){0.f, 0.f, 0.f, 0.f};
    float m_prev = 0.f;
    struct OpSet { u32x4 rq8, rk8, v0, v1; float ga, gbc, gav, gcm, g_bl, g_cm63; };
    auto chunk_rowbase = [&](int cs) -> int {
        const bool is_ctx = cs < 4; const int cc = is_ctx ? (dir ? 3 - cs : cs) : (dir ? 63 - (cs - 4) : cs - 4);
        return is_ctx ? MLAT + b * LCTX + cc * 64 : b * LSEQ + cc * 64; };
    auto prefetch = [&](int cs_, OpSet& o) {
        const int cs = cs_ < 68 ? cs_ : 67;
        const int rowbase = chunk_rowbase(cs);
        const int srow0 = (rowbase >= MLAT) ? (rowbase - MLAT) & 255 : LCTX + (rowbase & 4095);
        const unsigned char* qp = QK8 + (size_t)(b * 4 + hh) * QK8_STRIDE + (size_t)(srow0 + lane) * 256 + c16;
        o.rq8 = *(const u32x4*)qp; o.rk8 = *(const u32x4*)(qp + 128);
        const bf16_t* vp = V2 + ((size_t)(b * 4 + hh) * (LCTX + LSEQ) + srow0 + lane) * 128 + c16;
        o.v0 = *(const u32x4*)vp; o.v1 = *(const u32x4*)(vp + 8);
        const float* gp = GP + ((size_t)(rowbase >> 6) * 8 + dir * 4 + hh) * 192;
        o.g_bl = gp[63]; o.g_cm63 = gp[128 + 63]; o.ga = gp[64 + rpos];
        o.gbc = gp[lane]; o.gav = gp[64 + lane]; o.gcm = gp[128 + lane];
    };
    OpSet os0, os1, os2;
    prefetch(0, os0); prefetch(1, os1); prefetch(2, os2);
    __syncthreads();
    u32x2 hold[4]; int hold_row = -1;
#pragma unroll
    for (int j = 0; j < 4; ++j) hold[j] = (u32x2){0u, 0u};
    auto flush = [&]() {
        if (hold_row >= 0 && do_store) { bf16_t* op = HDo + (((size_t)dir * 32 + b * 4 + hh) * (LCTX + LSEQ) + hold_row) * 128 + (wave >> 2) * 64 + 4 * fq;
#pragma unroll
            for (int j = 0; j < 4; ++j) *(u32x2*)(op + j * 16) = hold[j]; } };
    auto step = [&](const int cs, OpSet& o) {
        const int rowbase = chunk_rowbase(cs);
        const u32x4 rq8 = o.rq8, rk8 = o.rk8; u32x4 vraw[2]; vraw[0] = o.v0; vraw[1] = o.v1;
        const float ga = o.ga, gbc = o.gbc, gav = o.gav, gcm = o.gcm, g_bl = o.g_bl, g_cm63 = o.g_cm63;
        const float g63 = fmaxf(m_prev, g_cm63), wc = __expf(m_prev - g63);
        {
            float f[16];
            dec16_fp8(rq8, f);
            { u32x4 w0, w1;
#pragma unroll
              for (int e = 0; e < 4; ++e) { w0[e] = pg8::cvt_pk_bf16(f[2 * e], f[2 * e + 1]); w1[e] = pg8::cvt_pk_bf16(f[8 + 2 * e], f[8 + 2 * e + 1]); }
              *(LAS u32x4*)(Qs + rpos * 136 + c16) = w0; *(LAS u32x4*)(Qs + rpos * 136 + c16 + 8) = w1; }
            dec16_fp8(rk8, f);
            { u32x4 w0, w1;
#pragma unroll
              for (int e = 0; e < 16; ++e) f[e] *= 0.08838834764831845f;
#pragma unroll
              for (int e = 0; e < 4; ++e) { w0[e] = pg8::cvt_pk_bf16(f[2 * e], f[2 * e + 1]); w1[e] = pg8::cvt_pk_bf16(f[8 + 2 * e], f[8 + 2 * e + 1]); }
              *(LAS u32x4*)(Ks + rpos * 136 + c16) = w0; *(LAS u32x4*)(Ks + rpos * 136 + c16 + 8) = w1;
              const float ws = __expf(ga - g63);
#pragma unroll
              for (int e = 0; e < 8; ++e) { const unsigned pw = pg8::cvt_pk_bf16(f[2 * e] * ws, f[2 * e + 1] * ws);
                  KTs[(c16 + 2 * e) * 72 + rpos] = (bf16_t)(pw & 0xffffu); KTs[(c16 + 2 * e + 1) * 72 + rpos] = (bf16_t)(pw >> 16); } }
#pragma unroll
            for (int h2 = 0; h2 < 2; ++h2)
#pragma unroll
                for (int e2 = 0; e2 < 4; ++e2) { VTs[(c16 + h2 * 8 + 2 * e2) * 72 + rpos] = (bf16_t)(vraw[h2][e2] & 0xffffu); VTs[(c16 + h2 * 8 + 2 * e2 + 1) * 72 + rpos] = (bf16_t)(vraw[h2][e2] >> 16); }
            if (wave == 7) { const float g = fmaxf(m_prev, gcm); Aa[lane] = gav; Gg[lane] = g; WI[lane] = __expf(m_prev - g); EM[lane] = __expf(-(gbc + g)); }
        }
        m_prev = g_bl + g63;
        flush();
        prefetch(cs + 3, o);
        __syncthreads();
        {
            const int tb = wave >> 1;
#pragma unroll
            for (int q2 = 0; q2 < 2; ++q2) {
                const int sb = (wave & 1) * 2 + q2;
                f32x4 acc = {0.f, 0.f, 0.f, 0.f};
                if (sb <= tb) {
                    bf16x8 kf[4], qf[4];
#pragma unroll
                    for (int ks = 0; ks < 4; ++ks) { kf[ks] = *(const LAS bf16x8*)(Ks + (sb * 16 + fr) * 136 + ks * 32 + fq * 8); qf[ks] = *(const LAS bf16x8*)(Qs + (tb * 16 + fr) * 136 + ks * 32 + fq * 8); }
#pragma unroll
                    for (int ks = 0; ks < 4; ++ks) acc = __builtin_amdgcn_mfma_f32_16x16x32_bf16(kf[ks], qf[ks], acc, 0, 0, 0);
                    const int t = tb * 16 + fr, s0 = sb * 16 + 4 * fq; const float g = Gg[t];
                    const f32x4 av = *(const LAS f32x4*)(Aa + s0);
#pragma unroll
                    for (int jj = 0; jj < 4; ++jj) acc[jj] = (s0 + jj <= t) ? acc[jj] * __expf(av[jj] - g) : 0.f;
                }
                u32x2 w; w.x = pg8::cvt_pk_bf16(acc[0], acc[1]); w.y = pg8::cvt_pk_bf16(acc[2], acc[3]);
                *(LAS u32x2*)(Ss + (tb * 16 + fr) * 72 + sb * 16 + 4 * fq) = w;
            }
        }
        __syncthreads();
        {
            const int tb = wave & 3, half = wave >> 2, t = tb * 16 + fr;
            f32x4 acc[5];
#pragma unroll
            for (int j = 0; j < 5; ++j) acc[j] = (f32x4){0.f, 0.f, 0.f, 0.f};
#pragma unroll
            for (int ks = 0; ks < 4; ++ks) {
                const bf16x8 qf = *(const LAS bf16x8*)(Qs + t * 136 + ks * 32 + fq * 8);
#pragma unroll
                for (int j = 0; j < 5; ++j) { const int jrow = (j < 4) ? (half * 4 + j) * 16 : 128;
                    const bf16x8 cf = *(const LAS bf16x8*)(CTs + (jrow + fr) * 136 + ks * 32 + fq * 8);
                    acc[j] = __builtin_amdgcn_mfma_f32_16x16x32_bf16(cf, qf, acc[j], 0, 0, 0); }
            }
            const float wi = WI[t];
#pragma unroll
            for (int j = 0; j < 5; ++j) acc[j] = acc[j] * wi;
#pragma unroll
            for (int ks = 0; ks < 2; ++ks) {
                const bf16x8 sf = *(const LAS bf16x8*)(Ss + t * 72 + ks * 32 + fq * 8);
#pragma unroll
                for (int j = 0; j < 5; ++j) { const int jrow = (j < 4) ? (half * 4 + j) * 16 : 128;
                    const bf16x8 vf = *(const LAS bf16x8*)(VTs + (jrow + fr) * 72 + ks * 32 + fq * 8);
                    acc[j] = __builtin_amdgcn_mfma_f32_16x16x32_bf16(vf, sf, acc[j], 0, 0, 0); }
            }
            const float den = __shfl(acc[4][0], fr);
            const float inv = 1.f / fmaxf(fabsf(den), EM[t]);
#pragma unroll
            for (int j = 0; j < 4; ++j) { hold[j].x = pg8::cvt_pk_bf16(acc[j][0] * inv, acc[j][1] * inv); hold[j].y = pg8::cvt_pk_bf16(acc[j][2] * inv, acc[j][3] * inv); }
            hold_row = ((rowbase >= MLAT) ? (rowbase - MLAT) & 255 : LCTX + (rowbase & 4095)) + (dir ? 63 - t : t);
            const int d0 = wave * 16;
#pragma unroll
            for (int j = 0; j < 9; ++j) accC[j] = accC[j] * wc;
#pragma unroll
            for (int ks = 0; ks < 2; ++ks) {
                const bf16x8 kf = *(const LAS bf16x8*)(KTs + (d0 + fr) * 72 + ks * 32 + fq * 8);
#pragma unroll
                for (int j = 0; j < 9; ++j) { const bf16x8 vf = *(const LAS bf16x8*)(VTs + (j * 16 + fr) * 72 + ks * 32 + fq * 8);
                    accC[j] = __builtin_amdgcn_mfma_f32_16x16x32_bf16(kf, vf, accC[j], 0, 0, 0); }
            }
        }
        __syncthreads();
        {
            const int d0 = wave * 16;
#pragma unroll
            for (int j = 0; j < 9; ++j) { u32x2 w; w.x = pg8::cvt_pk_bf16(accC[j][0], accC[j][1]); w.y = pg8::cvt_pk_bf16(accC[j][2], accC[j][3]);
                *(LAS u32x2*)(CTs + (j * 16 + fr) * 136 + d0 + 4 * fq) = w; }
        }
    };
#pragma unroll 1
    for (int cs = 0; cs < 66; cs += 3) { step(cs, os0); step(cs + 1, os1); step(cs + 2, os2); }
    step(66, os0); step(67, os1);
    flush();
    __syncthreads();
}

__device__ __forceinline__ float conv3_at(const bf16_t* rowp, int t, int seglen, float w0, float w1, float w2, float bias) {
    const int tl = t % seglen;
    float v = bf2f(rowp[t]) * w1 + bias;
    if (tl > 0) v += bf2f(rowp[t - 1]) * w0;
    if (tl < seglen - 1) v += bf2f(rowp[t + 1]) * w2;
    return v;
}
__device__ __forceinline__ void hyena_naive(const Args& a, int l, unsigned char* lds, int pass_lo, bool do_store) {
    const int tid = opaque_tid(), G = gridDim.x;
    bf16_t* UT = (bf16_t*)(a.ws + WS_UT);
    float* H = (float*)lds;
    float* Ub = H + 8192;
    float* Zb = Ub + 4096;
    float* red = Zb + 4096;
    float* w3s = red + 64;
    const float* hw = a.in[13] + (size_t)l * 3 * 1536; const float* hb = a.in[14] + (size_t)l * 1536;
    const float MIN_DECAY = -3.0701134573253946f, MAX_DECAY = -15.350567286626973f;
    for (int c = blockIdx.x; c < DHY; c += G) {
        const float rate = fabsf(MIN_DECAY + (MAX_DECAY - MIN_DECAY) * (float)c / 511.f);
        const float fb0 = a.in[21][(l * 2 + 0) * 512 + c], fb1 = a.in[21][(l * 2 + 1) * 512 + c];
        float cwv[3][3], cbv[3];
#pragma unroll
        for (int g = 0; g < 3; ++g) { cbv[g] = hb[g * 512 + c];
#pragma unroll
            for (int t3 = 0; t3 < 3; ++t3) cwv[g][t3] = hw[t3 * 1536 + g * 512 + c]; }
        for (int pass = pass_lo; pass < (l == 0 ? 2 : 1); ++pass) {
            const int L = pass ? LCTX : LSEQ;
            const float* hdn = pass ? (const float*)(a.ws + WS_HDNC) : (const float*)(a.ws + WS_HDN) + (size_t)l * 4096 * 64;
            __syncthreads();
            if (tid < 128) w3s[tid] = a.in[20][(size_t)l * 64 * 1024 + (tid & 63) * 1024 + (tid >> 6) * 512 + c];
            __syncthreads();
            float ssq0 = 0.f, ssq1 = 0.f;
            for (int t = tid; t < L; t += 512) { float s0 = 0.f, s1 = 0.f;
                for (int jj = 0; jj < 64; ++jj) { const float hv = hdn[(size_t)t * 64 + jj]; s0 += hv * w3s[jj]; s1 += hv * w3s[64 + jj]; }
                const float off = fabsf((float)t - (float)(L / 2)) / (float)(L / 2); const float dec = __expf(-off * rate);
                s0 *= dec; s1 *= dec; H[t] = s0; H[4096 + t] = s1; ssq0 += s0 * s0; ssq1 += s1 * s1; }
            ssq0 = wave_sum(ssq0); ssq1 = wave_sum(ssq1);
            if ((tid & 63) == 0) { red[tid >> 6] = ssq0; red[8 + (tid >> 6)] = ssq1; }
            __syncthreads();
            float t0 = 0.f, t1 = 0.f;
            for (int w = 0; w < 8; ++w) { t0 += red[w]; t1 += red[8 + w]; }
            const float n0 = rsqrtf(t0 + RMS_EPS), n1 = rsqrtf(t1 + RMS_EPS);
            __syncthreads();
            for (int t = tid; t < L; t += 512) { H[t] *= n0; H[4096 + t] *= n1; }
            __syncthreads();
            for (int b = 0; b < NB; ++b) {
                const size_t col0 = pass ? (size_t)MLAT + (size_t)b * LCTX : (size_t)b * LSEQ;
                const int seglen = pass ? LCTX : 64;
                const bf16_t* rv = UT + (size_t)c * MT + col0; const bf16_t* r1 = UT + (size_t)(512 + c) * MT + col0;
                const bf16_t* r2 = UT + (size_t)(1024 + c) * MT + col0; const bf16_t* rz = UT + (size_t)(1536 + c) * MT + col0;
                for (int t = tid; t < L; t += 512) Ub[t] = conv3_at(rv, t, seglen, cwv[0][0], cwv[0][1], cwv[0][2], cbv[0]);
                __syncthreads();
                for (int t = tid; t < L; t += 512) { float y = 0.f;
                    int slo = t + L / 2 - (L - 1); if (slo < 0) slo = 0; int shi = t + L / 2; if (shi > L - 1) shi = L - 1;
                    for (int s = slo; s <= shi; ++s) y += Ub[s] * H[t + L / 2 - s];
                    const float x1 = conv3_at(r1, t, seglen, cwv[1][0], cwv[1][1], cwv[1][2], cbv[1]);
                    Zb[t] = x1 * (y + Ub[t] * fb0); }
                __syncthreads();
                for (int t = tid; t < L; t += 512) { float y = 0.f;
                    int slo = t + L / 2 - (L - 1); if (slo < 0) slo = 0; int shi = t + L / 2; if (shi > L - 1) shi = L - 1;
                    for (int s = slo; s <= shi; ++s) y += Zb[s] * H[4096 + t + L / 2 - s];
                    const float x2 = conv3_at(r2, t, seglen, cwv[2][0], cwv[2][1], cwv[2][2], cbv[2]);
                    const float o = x2 * (y + Zb[t] * fb1) * silu_f(bf2f(rz[t]));
                    Ub[t] = o; }
                __syncthreads();
                if (do_store) for (int t = tid; t < L; t += 512) UT[(size_t)c * MT + col0 + t] = (bf16_t)f2bf(Ub[t]);
                __syncthreads();
            }
        }
    }
    __syncthreads();
}


typedef float cf __attribute__((ext_vector_type(2)));
__device__ __forceinline__ cf cmul(cf a, cf b) { const cf sw = __builtin_shufflevector(a, a, 1, 0); return a * b.x + sw * cf{-b.y, b.y}; }
__host__ __device__ constexpr float tw32c(int e) { return e == 0 ? 1.f : e == 1 ? 0.98078528040323043f : e == 2 ? 0.92387953251128674f : e == 3 ? 0.83146961230254524f : e == 4 ? 0.70710678118654752f : e == 5 ? 0.55557023301960218f :
    e == 6 ? 0.38268343236508977f : e == 7 ? 0.19509032201612825f : e == 8 ? 0.f : e == 9 ? -0.19509032201612825f : e == 10 ? -0.38268343236508977f : e == 11 ? -0.55557023301960218f : e == 12 ? -0.70710678118654752f :
    e == 13 ? -0.83146961230254524f : e == 14 ? -0.92387953251128674f : -0.98078528040323043f; }
template <int E32> __device__ __forceinline__ cf twmul(cf d) {
    if (E32 == 0) return d;
    if (E32 == 8) return cf{d.y, -d.x};
    constexpr float c = tw32c(E32), sn = tw32c(E32 < 8 ? 8 - E32 : E32 - 8);
    const cf sw = __builtin_shufflevector(d, d, 1, 0);
    return d * c + sw * cf{sn, -sn};
}
template <int R, int HALF, int I> struct DftStage {
    static __device__ __forceinline__ void run(cf (&v)[R]) {
        if constexpr ((I & HALF) == 0) {
            constexpr int E32 = (I % HALF) * (R / (2 * HALF)) * (32 / R);
            const cf a = v[I], b = v[I + HALF];
            v[I] = a + b;
            v[I + HALF] = twmul<E32>(a - b);
        }
        if constexpr (I + 1 < R) DftStage<R, HALF, I + 1>::run(v);
    }
};
template <int R, int HALF> struct DftAll {
    static __device__ __forceinline__ void run(cf (&v)[R]) { DftStage<R, HALF, 0>::run(v); if constexpr (HALF > 1) DftAll<R, HALF / 2>::run(v); }
};
__host__ __device__ constexpr int bitrev_c(int x, int bits) { int r = 0; for (int i = 0; i < bits; ++i) r = (r << 1) | ((x >> i) & 1); return r; }
__device__ __forceinline__ int PADI(int i) { return i + (i >> 4); }
constexpr int FFT_W_ELEMS = 8192 + 512;
template <int R, int I> struct StoreRev {
    static __device__ __forceinline__ void run(LAS cf* Wp, int pstride, const cf (&v)[R]) {
        constexpr int bits = (R == 32) ? 5 : 4;
        Wp[I * pstride] = v[bitrev_c(I, bits)];
        if constexpr (I + 1 < R) StoreRev<R, I + 1>::run(Wp, pstride, v);
    }
};
template <int R, int NS> __device__ __forceinline__ void fft_pass(LAS cf* W, int tid_) {
    int tid = tid_; asm volatile("" : "+v"(tid));
    constexpr int NT = 8192 / R;
    cf v[R];
    const bool act = tid < NT;
    if (act) {
#pragma unroll
        for (int r = 0; r < R; ++r) v[r] = W[PADI(tid) + r * (NT + NT / 16)];
    }
    __syncthreads();
    if (act) {
        const int k = tid % NS;
        if (NS > 1) {
            const float fr_ = -(float)k * (1.f / (float)(NS * R)); const float sn = __builtin_amdgcn_sinf(fr_), cs = __builtin_amdgcn_cosf(fr_);
            const cf w = cf{cs, sn}; cf cur = w;
#pragma unroll
            for (int r = 1; r < R; ++r) { v[r] = cmul(v[r], cur); cur = cmul(cur, w); }
        }
        DftAll<R, R / 2>::run(v);
        const int idx = (tid / NS) * NS * R + k;
        StoreRev<R, 0>::run(W + PADI(idx), NS >= 16 ? NS + NS / 16 : 1, v);
    }
    __syncthreads();
}
__device__ __forceinline__ void fft_pass2(LAS cf* W, int tid_) {
    int tid = tid_; asm volatile("" : "+v"(tid));
#pragma unroll 2
    for (int m = 0; m < 8; ++m) { const int j = tid + 512 * m; const int pj = PADI(j); const cf a = W[pj]; cf b = W[pj + 4352];
        const float fr_ = -(float)j * (1.f / 8192.f); b = cmul(b, cf{__builtin_amdgcn_cosf(fr_), __builtin_amdgcn_sinf(fr_)});
        W[pj] = cf{a.x + b.x, a.y + b.y}; W[pj + 4352] = cf{a.x - b.x, a.y - b.y}; }
    __syncthreads();
}
__device__ __forceinline__ void fft8192(LAS cf* W, int tid) { fft_pass<16, 1>(W, tid); fft_pass<16, 16>(W, tid); fft_pass<16, 256>(W, tid); fft_pass2(W, tid); }

template <int NS> __device__ __forceinline__ void fft4k_pass(LAS cf* Wb, int j_) {
    int j = j_; asm volatile("" : "+v"(j));
    cf v[16];
#pragma unroll
    for (int r = 0; r < 16; ++r) v[r] = Wb[PADI(j) + r * 272];
    __syncthreads();
    const int k = j % NS;
    if (NS > 1) {
        const float fr_ = -(float)k * (1.f / (float)(NS * 16)); const float sn = __builtin_amdgcn_sinf(fr_), cs = __builtin_amdgcn_cosf(fr_);
        const cf w = cf{cs, sn}; cf cur = w;
#pragma unroll
        for (int r = 1; r < 16; ++r) { v[r] = cmul(v[r], cur); cur = cmul(cur, w); }
    }
    DftAll<16, 8>::run(v);
    const int idx = (j / NS) * NS * 16 + k;
    StoreRev<16, 0>::run(Wb + PADI(idx), NS >= 16 ? NS + NS / 16 : 1, v);
    __syncthreads();
}
__device__ __forceinline__ void fft4k_x2(LAS cf* Wb, int j) { fft4k_pass<1>(Wb, j); fft4k_pass<16>(Wb, j); fft4k_pass<256>(Wb, j); }

__device__ __forceinline__ void conv8(const u32x4 rv, int tid, float w0, float w1, float w2, float bias, float (&o)[8]) {
    float x[8];
#pragma unroll
    for (int e = 0; e < 4; ++e) { x[2 * e] = bflo(rv[e]); x[2 * e + 1] = bfhi(rv[e]); }
    float left = __shfl_up(x[7], 1), right = __shfl_down(x[0], 1);
    if ((tid & 7) == 0) left = 0.f;
    if ((tid & 7) == 7) right = 0.f;
#pragma unroll
    for (int e = 0; e < 8; ++e) { const float xm = (e == 0) ? left : x[e - 1], xp = (e == 7) ? right : x[e + 1]; o[e] = w0 * xm + w1 * x[e] + w2 * xp + bias; }
}

__device__ __forceinline__ void hyena_item(const Args& a, int l, unsigned char* lds_, int item, bool do_store) {
    const int tid = opaque_tid();
    const int c = item >> 1, half = item & 1;
    LAS unsigned char* lds = (LAS unsigned char*)lds_;
    LAS cf* W = (LAS cf*)lds;
    LAS cf* He0 = (LAS cf*)(lds + 69632);
    LAS cf* Ho0 = He0 + 2049;
    LAS cf* He1 = Ho0 + 2048;
    LAS cf* Ho1 = He1 + 2049;
    const int sel = tid >> 8, j = tid & 255;
    LAS cf* Wb = W + sel * 4352;
    bf16_t* UT = (bf16_t*)(a.ws + WS_UT);
    const float* FT = (const float*)(a.ws + WS_FT);
    const float* hw = a.in[13] + (size_t)l * 3 * 1536; const float* hb = a.in[14] + (size_t)l * 1536;
    const float fb0 = a.in[21][(l * 2 + 0) * 512 + c], fb1 = a.in[21][(l * 2 + 1) * 512 + c];
    const int pi0 = PADI(tid * 8);
    __syncthreads();
    {
        const f32x4 ha = *(const f32x4*)(FT + (size_t)c * 4096 + tid * 8), hb2 = *(const f32x4*)(FT + (size_t)c * 4096 + tid * 8 + 4);
        const f32x4 ga = *(const f32x4*)(FT + (size_t)(512 + c) * 4096 + tid * 8), gb2 = *(const f32x4*)(FT + (size_t)(512 + c) * 4096 + tid * 8 + 4);
        const float fn0 = FT[(size_t)1024 * 4096 + c], fn1 = FT[(size_t)1024 * 4096 + 512 + c];
#pragma unroll
        for (int e = 0; e < 8; ++e) { const cf f = cf{(e < 4 ? ha[e & 3] : hb2[e & 3]) * fn0, (e < 4 ? ga[e & 3] : gb2[e & 3]) * fn1};
            const float fr_ = -(float)(tid * 8 + e) * (1.f / 8192.f);
            W[pi0 + e] = f; W[4352 + pi0 + e] = cmul(f, cf{__builtin_amdgcn_cosf(fr_), __builtin_amdgcn_sinf(fr_)}); }
        __syncthreads();
        fft4k_x2(Wb, j);
        for (int m = tid; m <= 2048; m += NTHR) { const cf A = W[PADI(m & 4095)], Bm = W[PADI((4096 - m) & 4095)];
            He0[m] = cf{0.5f * (A.x + Bm.x), 0.5f * (A.y - Bm.y)}; He1[m] = cf{0.5f * (A.y + Bm.y), -0.5f * (A.x - Bm.x)}; }
        for (int m = tid; m < 2048; m += NTHR) { const cf A = W[4352 + PADI(m)], Bm = W[4352 + PADI(4095 - m)];
            Ho0[m] = cf{0.5f * (A.x + Bm.x), 0.5f * (A.y - Bm.y)}; Ho1[m] = cf{0.5f * (A.y + Bm.y), -0.5f * (A.x - Bm.x)}; }
        __syncthreads();
    }
    float cwv[3][3], cbv[3];
#pragma unroll
    for (int g = 0; g < 3; ++g) { cbv[g] = hb[g * 512 + c];
#pragma unroll
        for (int t3 = 0; t3 < 3; ++t3) cwv[g][t3] = hw[t3 * 1536 + g * 512 + c]; }
#pragma unroll 1
    for (int bp = half * 2; bp < half * 2 + 2; ++bp) {
        const size_t o0 = (size_t)(2 * bp) * LSEQ + tid * 8, o1 = o0 + LSEQ;
        bf16_t* rv = UT + (size_t)c * MT; const bf16_t* r1 = UT + (size_t)(512 + c) * MT; const bf16_t* r2 = UT + (size_t)(1024 + c) * MT; const bf16_t* rz = UT + (size_t)(1536 + c) * MT;
        const u32x4 qv0 = *(const u32x4*)(rv + o0), qv1 = *(const u32x4*)(rv + o1), qa0 = *(const u32x4*)(r1 + o0), qa1 = *(const u32x4*)(r1 + o1);
        const u32x4 qb0 = *(const u32x4*)(r2 + o0), qb1 = *(const u32x4*)(r2 + o1), qz0 = *(const u32x4*)(rz + o0), qz1 = *(const u32x4*)(rz + o1);
        float z0[8], z1[8];
        conv8(qv0, tid, cwv[0][0], cwv[0][1], cwv[0][2], cbv[0], z0);
        conv8(qv1, tid, cwv[0][0], cwv[0][1], cwv[0][2], cbv[0], z1);
#pragma unroll 1
        for (int ord = 0; ord < 2; ++ord) {
#pragma unroll
            for (int e = 0; e < 8; ++e) { const cf f = cf{z0[e], z1[e]}; const float fr_ = -(float)(tid * 8 + e) * (1.f / 8192.f);
                W[pi0 + e] = f; W[4352 + pi0 + e] = cmul(f, cf{__builtin_amdgcn_cosf(fr_), __builtin_amdgcn_sinf(fr_)}); }
            __syncthreads();
            fft4k_x2(Wb, j);
            {
                LAS const cf* Hs = sel ? (ord ? Ho1 : Ho0) : (ord ? He1 : He0);
                const int top = sel ? 4095 : 4096, lim = sel ? 2047 : 2048;
#pragma unroll 4
                for (int i = 0; i < 16; ++i) { const int m = j + 256 * i; const int pm = PADI(m); const cf zv = Wb[pm];
                    cf hk; if (m <= lim) hk = Hs[m]; else { hk = Hs[top - m]; hk.y = -hk.y; }
                    const cf y = cmul(zv, hk); Wb[pm] = cf{y.x, -y.y}; }
            }
            __syncthreads();
            fft4k_x2(Wb, j);
            float x0[8], x1[8];
            conv8(ord ? qb0 : qa0, tid, cwv[1 + ord][0], cwv[1 + ord][1], cwv[1 + ord][2], cbv[1 + ord], x0);
            conv8(ord ? qb1 : qa1, tid, cwv[1 + ord][0], cwv[1 + ord][1], cwv[1 + ord][2], cbv[1 + ord], x1);
            const float fb = ord ? fb1 : fb0;
            const int pr = PADI((2048 + tid * 8) & 4095);
#pragma unroll
            for (int e = 0; e < 8; ++e) { const float fr_ = -(float)(2048 + tid * 8 + e) * (1.f / 8192.f);
                const cf ev = W[pr + e], ov = cmul(W[4352 + pr + e], cf{__builtin_amdgcn_cosf(fr_), __builtin_amdgcn_sinf(fr_)});
                const float y0 = (ev.x + ov.x) * (1.f / 8192.f), y1 = -(ev.y + ov.y) * (1.f / 8192.f);
                z0[e] = x0[e] * (y0 + z0[e] * fb); z1[e] = x1[e] * (y1 + z1[e] * fb); }
            __syncthreads();
        }
        {
            u32x4 w0, w1;
#pragma unroll
            for (int e = 0; e < 4; ++e) { w0[e] = pg8::cvt_pk_bf16(z0[2 * e] * silu_f(bflo(qz0[e])), z0[2 * e + 1] * silu_f(bfhi(qz0[e])));
                w1[e] = pg8::cvt_pk_bf16(z1[2 * e] * silu_f(bflo(qz1[e])), z1[2 * e + 1] * silu_f(bfhi(qz1[e]))); }
            if (do_store) { *(u32x4*)(rv + o0) = w0; *(u32x4*)(rv + o1) = w1; } }
    }
    __syncthreads();
}

__device__ __forceinline__ void filt_item(const Args& a, int l, unsigned char* lds_, int fi) {
    const int tid = opaque_tid();
    LAS float* w3s = (LAS float*)lds_ + 4096;
    LAS float* red = w3s + 512;
    float* FT = (float*)(a.ws + WS_FT);
    const float* hdn = (const float*)(a.ws + WS_HDN) + (size_t)l * 4096 * 64;
    const float MIN_DECAY = -3.0701134573253946f, MAX_DECAY = -15.350567286626973f;
    __syncthreads();
    w3s[tid] = a.in[20][(size_t)l * 64 * 1024 + (size_t)(tid >> 3) * 1024 + fi * 8 + (tid & 7)];
    __syncthreads();
    float rate[8], ssq[8];
#pragma unroll
    for (int cc = 0; cc < 8; ++cc) { const int ch = (fi * 8 + cc) & 511; rate[cc] = fabsf(MIN_DECAY + (MAX_DECAY - MIN_DECAY) * (float)ch / 511.f); ssq[cc] = 0.f; }
#pragma unroll 1
    for (int it2 = 0; it2 < 2; ++it2) {
        float acc[4][8];
#pragma unroll
        for (int q = 0; q < 4; ++q)
#pragma unroll
            for (int cc = 0; cc < 8; ++cc) acc[q][cc] = 0.f;
        const f32x4* hp = (const f32x4*)(hdn + (size_t)(it2 * 2048 + tid) * 64);
        f32x4 hn[4];
#pragma unroll
        for (int q = 0; q < 4; ++q) hn[q] = hp[(size_t)q * 512 * 16];
#pragma unroll 1
        for (int j4 = 0; j4 < 16; ++j4) {
            f32x4 hv[4];
#pragma unroll
            for (int q = 0; q < 4; ++q) hv[q] = hn[q];
            if (j4 < 15) {
#pragma unroll
                for (int q = 0; q < 4; ++q) hn[q] = hp[(size_t)q * 512 * 16 + j4 + 1]; }
#pragma unroll
            for (int jj = 0; jj < 4; ++jj) { const f32x4 wa = *(const LAS f32x4*)(w3s + (4 * j4 + jj) * 8), wb = *(const LAS f32x4*)(w3s + (4 * j4 + jj) * 8 + 4);
#pragma unroll
                for (int q = 0; q < 4; ++q) { const float h = hv[q][jj];
                    acc[q][0] += h * wa.x; acc[q][1] += h * wa.y; acc[q][2] += h * wa.z; acc[q][3] += h * wa.w; acc[q][4] += h * wb.x; acc[q][5] += h * wb.y; acc[q][6] += h * wb.z; acc[q][7] += h * wb.w; } }
        }
#pragma unroll
        for (int q = 0; q < 4; ++q) { const int t = it2 * 2048 + tid + 512 * q; const float off = fabsf((float)t - 2048.f) * (1.f / 2048.f);
#pragma unroll
            for (int cc = 0; cc < 8; ++cc) { const float v = acc[q][cc] * __expf(-off * rate[cc]); ssq[cc] += v * v; FT[(size_t)(fi * 8 + cc) * 4096 + t] = v; } }
    }
#pragma unroll
    for (int cc = 0; cc < 8; ++cc) { const float sv = wave_sum(ssq[cc]); if ((tid & 63) == 0) red[(tid >> 6) * 8 + cc] = sv; }
    __syncthreads();
    if (tid < 8) { float tsum = 0.f;
#pragma unroll
        for (int w = 0; w < 8; ++w) tsum += red[w * 8 + tid];
        FT[(size_t)1024 * 4096 + fi * 8 + tid] = rsqrtf(tsum + RMS_EPS); }
}

__device__ __forceinline__ float ctx_conv3(LAS const bf16_t* rowp, int t, float w0, float w1, float w2, float bias) {
    return bf2f(rowp[t - 1]) * w0 + bf2f(rowp[t]) * w1 + bf2f(rowp[t + 1]) * w2 + bias;
}
__device__ __forceinline__ void hyena_ctx_item(const Args& a, unsigned char* lds_, int c, bool do_store) {
    const int tid = opaque_tid();
    LAS float* Hc = (LAS float*)lds_;
    LAS float* U = Hc + 512;
    LAS float* Z = U + 2048;
    LAS float* red = Z + 2048;
    LAS float* w3s = red + 16;
    LAS bf16_t* RAW = (LAS bf16_t*)(w3s + 128);
    LAS bf16_t* OUT = RAW + 4 * 8 * 272;
    bf16_t* UT = (bf16_t*)(a.ws + WS_UT);
    const float* hdn = (const float*)(a.ws + WS_HDNC);
    const float* hw = a.in[13]; const float* hb = a.in[14];
    const float MIN_DECAY = -3.0701134573253946f, MAX_DECAY = -15.350567286626973f;
    const int t = tid & 255, bh = tid >> 8;
    {
        const float rate = fabsf(MIN_DECAY + (MAX_DECAY - MIN_DECAY) * (float)c / 511.f);
        const float fb0 = a.in[21][c], fb1 = a.in[21][512 + c];
        __syncthreads();
        if (tid < 128) w3s[tid] = a.in[20][(size_t)(tid & 63) * 1024 + (tid >> 6) * 512 + c];
#pragma unroll
        for (int i = 0; i < 2; ++i) { const int pp = tid + 512 * i, arr = pp >> 8, bb = (pp >> 5) & 7, seg = pp & 31;
            *(LAS u32x4*)(RAW + (arr * 8 + bb) * 272 + 8 + seg * 8) = *(const u32x4*)(UT + (size_t)(arr * 512 + c) * MT + MLAT + (size_t)bb * LCTX + seg * 8); }
        if (tid < 64) RAW[(tid >> 1) * 272 + ((tid & 1) ? 264 : 7)] = (bf16_t)0;
        __syncthreads();
        {
            float sv = 0.f;
            const f32x4* hp = (const f32x4*)(hdn + (size_t)t * 64);
#pragma unroll 4
            for (int j4 = 0; j4 < 16; ++j4) { const f32x4 hv = hp[j4]; sv += hv.x * w3s[bh * 64 + 4 * j4] + hv.y * w3s[bh * 64 + 4 * j4 + 1] + hv.z * w3s[bh * 64 + 4 * j4 + 2] + hv.w * w3s[bh * 64 + 4 * j4 + 3]; }
            sv *= __expf(-fabsf((float)t - 128.f) * (1.f / 128.f) * rate);
            const float ss = wave_sum(sv * sv);
            if ((tid & 63) == 0) red[tid >> 6] = ss;
            __syncthreads();
            const float tot = red[bh * 4] + red[bh * 4 + 1] + red[bh * 4 + 2] + red[bh * 4 + 3];
            Hc[bh * 256 + t] = sv * rsqrtf(tot + RMS_EPS);
        }
        float vv[4];
#pragma unroll
        for (int i = 0; i < 4; ++i) vv[i] = ctx_conv3(RAW + (0 * 8 + bh * 4 + i) * 272 + 8, t, hw[c], hw[1536 + c], hw[3072 + c], hb[c]);
        *(LAS f32x4*)(U + t * 8 + bh * 4) = (f32x4){vv[0], vv[1], vv[2], vv[3]};
        __syncthreads();
        const int slo = (t - 127 > 0) ? t - 127 : 0, shi = (t + 128 < 255) ? t + 128 : 255;
        f32x4 acc = {0.f, 0.f, 0.f, 0.f};
        for (int s2 = slo; s2 <= shi; ++s2) { const float h = Hc[t + 128 - s2]; const f32x4 u = *(const LAS f32x4*)(U + s2 * 8 + bh * 4); acc = acc + u * h; }
        float zz[4];
#pragma unroll
        for (int i = 0; i < 4; ++i) { const float x1 = ctx_conv3(RAW + (1 * 8 + bh * 4 + i) * 272 + 8, t, hw[512 + c], hw[1536 + 512 + c], hw[3072 + 512 + c], hb[512 + c]);
            zz[i] = x1 * (acc[i] + vv[i] * fb0); }
        *(LAS f32x4*)(Z + t * 8 + bh * 4) = (f32x4){zz[0], zz[1], zz[2], zz[3]};
        __syncthreads();
        acc = (f32x4){0.f, 0.f, 0.f, 0.f};
        for (int s2 = slo; s2 <= shi; ++s2) { const float h = Hc[256 + t + 128 - s2]; const f32x4 u = *(const LAS f32x4*)(Z + s2 * 8 + bh * 4); acc = acc + u * h; }
#pragma unroll
        for (int i = 0; i < 4; ++i) { const float x2 = ctx_conv3(RAW + (2 * 8 + bh * 4 + i) * 272 + 8, t, hw[1024 + c], hw[1536 + 1024 + c], hw[3072 + 1024 + c], hb[1024 + c]);
            OUT[(bh * 4 + i) * 256 + t] = (bf16_t)f2bf(x2 * (acc[i] + zz[i] * fb1) * silu_f(bf2f(RAW[(3 * 8 + bh * 4 + i) * 272 + 8 + t]))); }
        __syncthreads();
        if (do_store && tid < 256) *(u32x4*)(UT + (size_t)c * MT + MLAT + (size_t)(tid >> 5) * LCTX + (tid & 31) * 8) = *(LAS const u32x4*)(OUT + (tid >> 5) * 256 + (tid & 31) * 8);
    }
    __syncthreads();
}


__device__ __forceinline__ void phase_mixers(const Args& a, int l, unsigned char* lds, int rep, bool do_mlstm, bool do_hy, bool do_hyctx) {
    LAS unsigned* qslot = (LAS unsigned*)((LAS unsigned char*)lds + (LDS_BYTES - 32));
    if (do_mlstm && (blockIdx.x & 3) == 0 && (blockIdx.x >> 2) < 64) mlstm_item(a, l, lds, blockIdx.x >> 2, rep == 0);
    unsigned* ctr = (unsigned*)(a.ws + WS_CTL) + CW_QUEUE + 64 * (l * 8 + rep);
    const int n_lat = do_hy ? 2 * DHY : 0, n_ctx = (l == 0 && do_hyctx) ? DHY : 0;
    for (;;) {
        __syncthreads();
        if (threadIdx.x == 0) *qslot = __hip_atomic_fetch_add(ctr, 1u, __ATOMIC_RELAXED, __HIP_MEMORY_SCOPE_AGENT);
        __syncthreads();
        const int item = (int)*qslot;
        if (item >= n_lat + n_ctx) break;
        if (item < n_lat) hyena_item(a, l, lds, item, rep == 0);
        else hyena_ctx_item(a, lds, item - n_lat, rep == 0);
    }
    __syncthreads();
}

__device__ __forceinline__ void phase_combine(const Args& a, int l, unsigned char* lds) {
    const int tid = opaque_tid(), G = gridDim.x, lane = tid & 63, wave = tid >> 6;
    const bf16_t* U1 = (const bf16_t*)(a.ws + WS_U1);
    const bf16_t* HDi = (const bf16_t*)(a.ws + WS_HB);
    const bf16_t* UT = (const bf16_t*)(a.ws + WS_UT);
    bf16_t* YM = (bf16_t*)(a.ws + WS_YMIX);
    bf16_t* T = (bf16_t*)lds;
    const int nblk = (l == 0 ? MT : MLAT) / 64;
    float mgv[8];
#pragma unroll
    for (int i = 0; i < 8; ++i) mgv[i] = a.in[12][l * 512 + lane * 8 + i];
    const size_t dstride = (size_t)32 * (LCTX + LSEQ) * 128;
    for (int blk = blockIdx.x; blk < nblk; blk += G) {
        const int r0 = blk * 64;
        __syncthreads();
#pragma unroll
        for (int i = 0; i < 8; ++i) { const int e = tid + i * 512, ch = e >> 3, pc = e & 7;
            *(u32x4*)(T + ch * 72 + ((pc ^ ((ch >> 3) & 7)) * 8)) = *(const u32x4*)(UT + (size_t)ch * MT + r0 + pc * 8); }
        const int cb = r0 >= MLAT ? (r0 - MLAT) >> 8 : r0 >> 12, csr0 = r0 >= MLAT ? (r0 - MLAT) & 255 : LCTX + (r0 & 4095);
        const bf16_t* hbase = HDi + ((size_t)(cb * 4 + (lane >> 4)) * (LCTX + LSEQ) + csr0) * 128 + (lane & 15) * 8;
#pragma unroll 1
        for (int rr = wave; rr < 64; rr += 16) {
            u32x4 hf[2], hb[2], ov[2], zv[2];
#pragma unroll
            for (int q = 0; q < 2; ++q) { const int r1 = rr + 8 * q; const size_t row = r0 + r1;
                hf[q] = *(const u32x4*)(hbase + (size_t)r1 * 128); hb[q] = *(const u32x4*)(hbase + (size_t)r1 * 128 + dstride);
                ov[q] = *(const u32x4*)(U1 + row * LDU1 + 1024 + lane * 8); zv[q] = *(const u32x4*)(U1 + row * LDU1 + 1536 + lane * 8); }
#pragma unroll
            for (int q = 0; q < 2; ++q) { const size_t row = r0 + rr + 8 * q;
                float hg[8]; float ss = 0.f;
#pragma unroll
                for (int i = 0; i < 4; ++i) {
                    hg[2 * i] = (bflo(hf[q][i]) + bflo(hb[q][i])) * sigmoid_f(bflo(ov[q][i]));
                    hg[2 * i + 1] = (bfhi(hf[q][i]) + bfhi(hb[q][i])) * sigmoid_f(bfhi(ov[q][i]));
                    ss += hg[2 * i] * hg[2 * i] + hg[2 * i + 1] * hg[2 * i + 1]; }
                ss += __shfl_xor(ss, 1); ss += __shfl_xor(ss, 2); ss += __shfl_xor(ss, 4); ss += __shfl_xor(ss, 8);
                const float r = rsqrtf(ss * (1.f / 128.f) + RMS_EPS);
                u32x4 o4;
#pragma unroll
                for (int i = 0; i < 4; ++i) o4[i] = pk2(hg[2 * i] * r * mgv[2 * i] * silu_f(bflo(zv[q][i])), hg[2 * i + 1] * r * mgv[2 * i + 1] * silu_f(bfhi(zv[q][i])));
                *(u32x4*)(YM + row * DM + lane * 8) = o4; }
        }
        __syncthreads();
        for (int rr = wave; rr < 64; rr += 8) {
            const int col = (((rr >> 3) ^ (lane & 7)) << 3) | (rr & 7);
            u32x4 o4;
#pragma unroll
            for (int i = 0; i < 4; ++i) o4[i] = (unsigned)T[(lane * 8 + 2 * i) * 72 + col] | ((unsigned)T[(lane * 8 + 2 * i + 1) * 72 + col] << 16);
            *(u32x4*)(YM + (size_t)(r0 + rr) * DM + 512 + lane * 8) = o4;
        }
    }
    __syncthreads();
}


#define XB_TMO      128
#define XB_XCNT(j)  (256  + 64 * (j))
#define XB_XSUB(j)  (1280 + 64 * (j))
#define XB_XGEN(j)  (2304 + 64 * (j))
#define XB_TOP      3328
#define XB_TOPGEN   3392
#define XCD_BAR_WORDS 3456
#define XB_SPIN_CAP (1u << 18)
__device__ __forceinline__ unsigned xb_ld(unsigned* p)              { return __hip_atomic_load(p, __ATOMIC_RELAXED, __HIP_MEMORY_SCOPE_AGENT); }
__device__ __forceinline__ unsigned xb_add(unsigned* p, unsigned v) { return __hip_atomic_fetch_add(p, v, __ATOMIC_RELAXED, __HIP_MEMORY_SCOPE_AGENT); }
__device__ __forceinline__ unsigned xb_xcc_id() { return (unsigned)__builtin_amdgcn_s_getreg((3 << 11) | 20) & 0xFu; }
#define XB_SPIN(cond, bar) do { unsigned _sp = 0; while (cond) { __builtin_amdgcn_s_sleep(1); \
    if ((++_sp & 255u) == 0u) { if (xb_ld(&(bar)[XB_TMO])) break; if (_sp > XB_SPIN_CAP) { atomicAdd(&(bar)[XB_TMO], 1u); break; } } } } while (0)
struct XcdBarrier { unsigned* bar; unsigned x; volatile __attribute__((address_space(3))) unsigned* st; };
__device__ __forceinline__ XcdBarrier xcd_barrier_post(unsigned* bar, volatile __attribute__((address_space(3))) unsigned* st) {
    XcdBarrier b; b.bar = bar; b.x = xb_xcc_id(); b.st = st;
    if (threadIdx.x == 0) (void)xb_add(&bar[XB_XCNT(b.x)], 1u);
    return b;
}
__device__ __forceinline__ void xcd_barrier_complete(unsigned* bar, unsigned x, unsigned& nloc, unsigned& nx) {
    const unsigned G = gridDim.x * gridDim.y * gridDim.z;
    unsigned sum, cnt, mine, sp = 0u;
    for (;;) {
        sum = 0u; cnt = 0u; mine = 0u;
#pragma unroll
        for (unsigned j = 0; j < 16; ++j) { const unsigned c = xb_ld(&bar[XB_XCNT(j)]); sum += c; cnt += (c > 0u) ? 1u : 0u; mine = (j == x) ? c : mine; }
        if (sum == G) break;
        __builtin_amdgcn_s_sleep(1);
        if ((++sp & 255u) == 0u) { if (xb_ld(&bar[XB_TMO])) break; if (sp > XB_SPIN_CAP) { atomicAdd(&bar[XB_TMO], 1u); break; } }
    }
    nloc = mine > 0u ? mine : 1u; nx = cnt > 0u ? cnt : 1u;
}
__device__ __forceinline__ void xcd_barrier(const XcdBarrier& b) {
    asm volatile("s_waitcnt vmcnt(0)" ::: "memory");
    __syncthreads();
    if (threadIdx.x == 0) {
        unsigned* bar = b.bar;
        __builtin_amdgcn_s_waitcnt(0);
        unsigned nloc = b.st[0], nx = b.st[1];
        if (nloc == 0u) { xcd_barrier_complete(bar, b.x, nloc, nx); b.st[0] = nloc; b.st[1] = nx; }
        const unsigned old = xb_add(&bar[XB_XSUB(b.x)], 1u);
        const unsigned gen = old / nloc;
        if (old + 1u == (gen + 1u) * nloc) {
            __builtin_amdgcn_fence(__ATOMIC_RELEASE, "agent");
            asm volatile("s_waitcnt vmcnt(0)" ::: "memory");
            const unsigned og = xb_add(&bar[XB_TOP], 1u);
            const unsigned tg = og / nx;
            if (og + 1u == (tg + 1u) * nx) xb_add(&bar[XB_TOPGEN], 1u);
            else XB_SPIN(xb_ld(&bar[XB_TOPGEN]) == tg, bar);
            __builtin_amdgcn_fence(__ATOMIC_ACQUIRE, "agent");
            xb_add(&bar[XB_XGEN(b.x)], 1u);
            asm volatile("s_waitcnt vmcnt(0)" ::: "memory");
        } else {
            XB_SPIN(xb_ld(&bar[XB_XGEN(b.x)]) == gen, bar);
            __builtin_amdgcn_fence(__ATOMIC_ACQUIRE, "agent");
            asm volatile("s_waitcnt vmcnt(0)" ::: "memory");
        }
    }
    __syncthreads();
}

__global__ void __launch_bounds__(NTHR, 2) fwd(Args a_) {
    extern __shared__ __attribute__((aligned(16))) unsigned char lds[];
    cg::grid_group grid = cg::this_grid();
    const int lo = a_.ph_lo, hi = a_.ph_hi; const int rp_phase = a_.rep_phase, rp_count = a_.rep_count & 255;
#define IN(k) (lo <= (k) && (k) < hi)
    volatile __attribute__((address_space(3))) unsigned* bst = (volatile __attribute__((address_space(3))) unsigned*)((__attribute__((address_space(3))) unsigned char*)lds + (LDS_BYTES - 64));
    if (threadIdx.x < 2) bst[threadIdx.x] = 0u;
    __syncthreads();
    const XcdBarrier xbar = xcd_barrier_post((unsigned*)(a_.ws + WS_CTL), bst);
    if (lo < 0) grid.sync();
#define SEAM(k) do { if (IN(k) && IN((k) + 1)) xcd_barrier(xbar); } while (0)
    if (IN(0)) _Pragma("unroll 1") for (int rep = 0, nrep = (rp_phase == 0) ? rp_count : 1; rep < nrep; ++rep) phase_prep(kargs(), lds);
    SEAM(0);
    if (IN(1)) _Pragma("unroll 1") for (int rep = 0, nrep = (rp_phase == 1) ? rp_count : 1; rep < nrep; ++rep) phase_norm(kargs(), 0, false, true, lds);
    SEAM(1);
    for (int l = 0; l < DEPTH; ++l) {
        const int p = 2 + 6 * l;
        if (IN(p)) {
            unsigned char* ws = kargs().ws;
            const bf16_t* HB = (const bf16_t*)(ws + WS_HB);
            const bf16_t* WinT = (const bf16_t*)(ws + WS_WINT) + (size_t)l * NPK * DM;
#if NAIVE_GEMM
            gemm_naive(HB, WinT, MT, NU1, DM, ws + WS_U1, NU1, 0, lds);
            gemm_naive(HB, WinT + (size_t)NU1 * DM, MT, NU2, DM, ws + WS_UT, MT, 1, lds);
#else
            DecIn d{(const char*)HB, (const char*)WinT, (char*)(ws + WS_U1), (char*)(ws + WS_UT)};
            pg8::GridOrder<DecIn> S; S.init(MT / 256, NPK / 256, gridDim.x, blockIdx.x, d);
            _Pragma("unroll 1") for (int rep = 0, nrep = (rp_phase == 2) ? rp_count : 1; rep < nrep; ++rep) pg8::gemm_phase<true>((PG8_LAS unsigned char*)lds, DM, S);
#endif
        }
        SEAM(p);
        if (IN(p + 1)) _Pragma("unroll 1") for (int rep = 0, nrep = (rp_phase == 9) ? rp_count : 1; rep < nrep; ++rep) phase_mprep(kargs(), l, lds, rep);
        SEAM(p + 1);
        if (IN(p + 2)) {
            const int nrep = (rp_phase == 3 || rp_phase == 4 || rp_phase == 5 || rp_phase == 11) ? rp_count : 1;
            _Pragma("unroll 1") for (int rep = 0; rep < nrep; ++rep)
                phase_mixers(kargs(), l, lds, rep, rep == 0 || rp_phase == 3 || rp_phase == 11, rep == 0 || rp_phase == 4 || rp_phase == 11, rep == 0 || rp_phase == 5 || rp_phase == 11);
        }
        SEAM(p + 2);
        if (IN(p + 3)) _Pragma("unroll 1") for (int rep = 0, nrep = (rp_phase == 6) ? rp_count : 1; rep < nrep; ++rep) phase_combine(kargs(), l, lds);
        SEAM(p + 3);
        if (IN(p + 4)) {
            unsigned char* ws = kargs().ws;
            const bf16_t* WoutT = (const bf16_t*)(ws + WS_WOUTT) + (size_t)l * DM * DM;
#if NAIVE_GEMM
            gemm_naive((const bf16_t*)(ws + WS_YMIX), WoutT, (l == 0) ? MT : MLAT, DM, DM, ws + WS_U1, DM, 2, lds);
#else
            DecOut d{(const char*)(ws + WS_YMIX), (const char*)WoutT, (char*)(ws + WS_U1)};
            pg8::GridOrder<DecOut> S; S.init(((l == 0) ? MT : MLAT) / 256, DM / 256, gridDim.x, blockIdx.x, d);
            _Pragma("unroll 1") for (int rep = 0, nrep = (rp_phase == 7) ? rp_count : 1; rep < nrep; ++rep) pg8::gemm_phase<true>((PG8_LAS unsigned char*)lds, DM, S);
#endif
        }
        SEAM(p + 4);
        if (IN(p + 5)) _Pragma("unroll 1") for (int rep = 0, nrep = (rp_phase == 8 && l == 0) ? rp_count : 1; rep < nrep; ++rep) phase_norm(kargs(), l + 1, true, l + 1 < DEPTH, lds);
        SEAM(p + 5);
    }
    if (rp_phase == 10) for (int rep = 0; rep < rp_count; ++rep) xcd_barrier(xbar);
#undef IN
#undef SEAM
}

constexpr int NPHASES = 2 + 6 * DEPTH;

extern "C" void kernel_launch(void* const* d_in, const int* in_sizes, int n_in, void* d_out, int out_size, void* d_ws, size_t ws_size, hipStream_t stream) {
    static int grid = 0;
    if (grid == 0) {
        if (n_in != 23 || out_size != MLAT * DM || ws_size < WS_END) { fprintf(stderr, "kernel_launch: unexpected shapes n_in %d out %d ws %zu\n", n_in, out_size, ws_size); grid = -1; return; }
        int dev = 0, cus = 0, per_cu = 0;
        (void)hipGetDevice(&dev);
        (void)hipDeviceGetAttribute(&cus, hipDeviceAttributeMultiprocessorCount, dev);
        (void)hipFuncSetAttribute((const void*)fwd, hipFuncAttributeMaxDynamicSharedMemorySize, LDS_BYTES);
        (void)hipOccupancyMaxActiveBlocksPerMultiprocessor(&per_cu, (const void*)fwd, NTHR, LDS_BYTES);
        if (per_cu < 1) per_cu = 1;
        grid = cus * per_cu;
        fprintf(stderr, "kernel_launch: cus %d per_cu %d grid %d ws %zu\n", cus, per_cu, grid, ws_size);
    }
    if (grid < 0) return;
    Args a{};
    for (int i = 0; i < 23; ++i) a.in[i] = (const float*)d_in[i];
    a.out = (float*)d_out; a.ws = (unsigned char*)d_ws;
    (void)hipMemsetAsync((char*)d_ws + WS_CTL, 0, 32768, stream);
    a.ph_lo = 0; a.ph_hi = NPHASES; a.rep_phase = PROBE_PHASE; a.rep_count = PROBE_COUNT;
    void* kargs[] = {&a};
    hipError_t e = hipLaunchCooperativeKernel((const void*)fwd, dim3(grid), dim3(NTHR), kargs, LDS_BYTES, stream);
    if (e != hipSuccess) fprintf(stderr, "kernel_launch: cooperative launch failed: %s (grid %d)\n", hipGetErrorString(e), grid);
}
```

```cpp
#include <hip/hip_runtime.h>
#include <hip/hip_cooperative_groups.h>
#include <cstdio>
#include <cstdint>
namespace cg = cooperative_groups;

constexpr int NB = 8, LSEQ = 4096, DM = 1024, LCTX = 256, DEPTH = 2;
constexpr int MLAT = NB * LSEQ, MCTX = NB * LCTX, MT = MLAT + MCTX;
constexpr int DIN = 4624, NU1 = 2560, NU2 = 2048, NPK = NU1 + NU2;
constexpr int QK8_STRIDE = (LCTX + LSEQ) * 256 + 8192;
constexpr int LDU1 = 2048;
constexpr int NH = 4, HD = 128, DML = 512, DHY = 512;
constexpr float RMS_EPS = 1e-6f;
constexpr int NTHR = 512;
constexpr int LDS_BYTES = 147456;
#ifndef PROBE_PHASE
#define PROBE_PHASE -1
#endif
#ifndef PROBE_COUNT
#define PROBE_COUNT 1
#endif
#ifndef REP_PREP
#define REP_PREP 1
#endif
#ifndef REP_NORM
#define REP_NORM 1
#endif
#ifndef REP_GEMM1
#define REP_GEMM1 1
#endif
#ifndef REP_MLSTM
#define REP_MLSTM 1
#endif
#ifndef REP_HYENA
#define REP_HYENA 1
#endif
#ifndef REP_HYCTX
#define REP_HYCTX 1
#endif
#ifndef REP_COMB
#define REP_COMB 1
#endif
#ifndef REP_GEMM2
#define REP_GEMM2 1
#endif
#ifndef NAIVE_MLSTM
#define NAIVE_MLSTM 0
#endif
#ifndef NAIVE_HYENA
#define NAIVE_HYENA 0
#endif
#ifndef NAIVE_GEMM
#define NAIVE_GEMM 0
#endif

constexpr size_t MiB = 1u << 20;
constexpr size_t WS_CTL = 0;
constexpr size_t WS_MOD = 1 * MiB;
constexpr size_t WS_HDN = 2 * MiB;
constexpr size_t WS_HDNC = 4 * MiB;
constexpr size_t WS_GATES = 5 * MiB;
constexpr size_t WS_WGT = 512 * 1024;
constexpr size_t WS_GP = 4 * MiB + 256 * 1024;
constexpr size_t WS_XC1 = 8 * MiB;
constexpr size_t WS_WINT = 16 * MiB;
constexpr size_t WS_WOUTT = 34 * MiB;
constexpr size_t WS_HB = 40 * MiB;
constexpr size_t WS_U1 = 108 * MiB;
constexpr size_t WS_V2 = 244 * MiB;
constexpr size_t WS_UT = 280 * MiB;
constexpr size_t WS_YMIX = 416 * MiB;
constexpr size_t WS_FT = 485 * MiB;
constexpr size_t WS_END = 502 * MiB;

constexpr int CW_QUEUE = 4096;

typedef unsigned short bf16_t;
typedef float f32x4 __attribute__((ext_vector_type(4)));
typedef float f32x2 __attribute__((ext_vector_type(2)));
typedef unsigned u32x4 __attribute__((ext_vector_type(4)));
typedef unsigned u32x2 __attribute__((ext_vector_type(2)));

struct Args {
    const float* in[23];
    float* out;
    unsigned char* ws;
    int ph_lo, ph_hi;
    int rep_phase, rep_count;
};

__device__ __forceinline__ float bf2f(unsigned b) { return __uint_as_float(b << 16); }
__device__ __forceinline__ unsigned f2bf(float f) { unsigned u = __float_as_uint(f); return (u + 0x7fffu + ((u >> 16) & 1u)) >> 16; }
__device__ __forceinline__ unsigned pk2(float lo, float hi) { return f2bf(lo) | (f2bf(hi) << 16); }
__device__ __forceinline__ float bflo(unsigned x) { return __uint_as_float(x << 16); }
__device__ __forceinline__ float bfhi(unsigned x) { return __uint_as_float(x & 0xffff0000u); }
__device__ __forceinline__ float silu_f(float x) { return x * __builtin_amdgcn_rcpf(1.f + __expf(-x)); }
__device__ __forceinline__ float sigmoid_f(float x) { return __builtin_amdgcn_rcpf(1.f + __expf(-x)); }
typedef const Args __attribute__((address_space(4)))* KArgsP;
__device__ __forceinline__ Args kargs() {
    int z = 0; asm volatile("" : "+s"(z));
    KArgsP p = (KArgsP)((const char __attribute__((address_space(4)))*)__builtin_amdgcn_kernarg_segment_ptr() + z);
    Args a;
#pragma unroll
    for (int i = 0; i < 23; ++i) a.in[i] = p->in[i];
    a.out = p->out; a.ws = p->ws; a.ph_lo = p->ph_lo; a.ph_hi = p->ph_hi; a.rep_phase = p->rep_phase; a.rep_count = p->rep_count;
    return a;
}
__device__ __forceinline__ int opaque_tid() { int t = threadIdx.x; asm volatile("" : "+v"(t)); return t; }
__device__ __forceinline__ float wave_sum(float v) {
#pragma unroll
    for (int o = 1; o < 64; o <<= 1) v += __shfl_xor(v, o);
    return v;
}

__device__ __forceinline__ void phase_prep(const Args& a, unsigned char* lds) {
    const int tid = opaque_tid(), G = gridDim.x;
    float* scr = (float*)lds;
    constexpr int IT_WIN = 2 * 16 * 72, IT_WOUT = 2 * 16 * 16, IT_MOD = 2 * 48, IT_HDN = 132, IT_WG = 2;
    constexpr int NIT = IT_WIN + IT_WOUT + IT_MOD + IT_HDN + IT_WG;
    bool s_loaded = false;
    for (int it = blockIdx.x; it < NIT; it += G) {
        int r = it;
        if (r < IT_WIN + IT_WOUT) {
            const float* W; bf16_t* WT; int N, kb, nb, srccol;
            if (r < IT_WIN) { const int l = r / (16 * 72); r %= 16 * 72; kb = r / 72; nb = r % 72; N = DIN;
                W = a.in[8] + (size_t)l * DM * DIN; WT = (bf16_t*)(a.ws + WS_WINT) + (size_t)l * NPK * DM; srccol = nb * 64 + (nb >= 40 ? 16 : 0); }
            else { r -= IT_WIN; const int l = r / 256; r %= 256; kb = r / 16; nb = r % 16; N = DM;
                W = a.in[22] + (size_t)l * DM * DM; WT = (bf16_t*)(a.ws + WS_WOUTT) + (size_t)l * DM * DM; srccol = nb * 64; }
            __syncthreads();
#pragma unroll
            for (int i = 0; i < 8; ++i) { const int e = tid + i * 512, kk = e >> 6, nn = e & 63; scr[kk * 65 + nn] = W[(size_t)(kb * 64 + kk) * N + srccol + nn]; }
            __syncthreads();
            { const int nn = tid >> 3, k8 = (tid & 7) * 8; u32x4 o;
              o.x = pk2(scr[(k8 + 0) * 65 + nn], scr[(k8 + 1) * 65 + nn]); o.y = pk2(scr[(k8 + 2) * 65 + nn], scr[(k8 + 3) * 65 + nn]);
              o.z = pk2(scr[(k8 + 4) * 65 + nn], scr[(k8 + 5) * 65 + nn]); o.w = pk2(scr[(k8 + 6) * 65 + nn], scr[(k8 + 7) * 65 + nn]);
              *(u32x4*)(WT + (size_t)(nb * 64 + nn) * DM + kb * 64 + k8) = o; }
            continue;
        }
        r -= IT_WIN + IT_WOUT;
        if (r < IT_MOD) {
            const int l = r / 48, cb = r % 48;
            float* S = scr + 8192;
            float* P = scr;
            __syncthreads();
            if (!s_loaded) {
                for (int i = tid; i < 9 * 1024; i += 512) { const int v = i >> 10, k = i & 1023; const float cv = (v < 8) ? a.in[1][v * 1024 + k] : a.in[3][k]; S[i] = silu_f(cv); }
                s_loaded = true;
            }
            __syncthreads();
            const int kg = tid >> 6, col = cb * 64 + (tid & 63);
            const float* W = a.in[4] + (size_t)l * DM * 3072;
            float acc[9];
#pragma unroll
            for (int v = 0; v < 9; ++v) acc[v] = 0.f;
            for (int k = kg * 128; k < kg * 128 + 128; ++k) { const float w = W[(size_t)k * 3072 + col];
#pragma unroll
                for (int v = 0; v < 9; ++v) acc[v] += S[v * 1024 + k] * w; }
#pragma unroll
            for (int v = 0; v < 9; ++v) P[(kg * 9 + v) * 64 + (tid & 63)] = acc[v];
            __syncthreads();
            for (int i = tid; i < 9 * 64; i += 512) { const int v = i >> 6, cc = i & 63; float s = a.in[5][l * 3072 + cb * 64 + cc];
#pragma unroll
                for (int g = 0; g < 8; ++g) s += P[(g * 9 + v) * 64 + cc];
                ((float*)(a.ws + WS_MOD))[(size_t)(l * 9 + v) * 3072 + cb * 64 + cc] = s; }
            continue;
        }
        r -= IT_MOD;
        if (r >= IT_HDN) {
            const int l = r - IT_HDN; const float* w = a.in[8] + (size_t)l * DM * DIN; bf16_t* wg = (bf16_t*)(a.ws + WS_WGT) + (size_t)l * 16 * 1024;
            for (int i = tid; i < 16384; i += 512) wg[(i & 15) * 1024 + (i >> 4)] = (bf16_t)f2bf(w[(size_t)(i >> 4) * DIN + 2560 + (i & 15)]);
            continue;
        }
        {
            __syncthreads();
            float* W1 = scr;
            float* W2 = scr + 17 * 64;
            float* B1 = W2 + 64 * 64; float* B2 = B1 + 64; float* F0 = B2 + 64; float* F1 = F0 + 64;
            float* FT = F1 + 64;
            float* H1 = FT + 8 * 17;
            const int lb = ((r * 64) < 8192) ? ((r * 64) >> 12) : 0;
            for (int i = tid; i < 17 * 64; i += 512) W1[i] = a.in[15][lb * 17 * 64 + i];
            for (int i = tid; i < 64 * 64; i += 512) W2[i] = a.in[18][lb * 64 * 64 + i];
            if (tid < 64) { B1[tid] = a.in[16][lb * 64 + tid]; B2[tid] = a.in[19][lb * 64 + tid]; F0[tid] = a.in[17][lb * 128 + tid]; F1[tid] = a.in[17][lb * 128 + 64 + tid]; }
            const int j = tid & 63, pg = tid >> 6;
            for (int sub = 0; sub < 8; ++sub) {
                const int p = r * 64 + sub * 8 + pg;
                const int L = (p < 8192) ? 4096 : 256; const int pos = (p < 8192) ? (p & 4095) : (p - 8192);
                __syncthreads();
                if (j < 17) { float f;
                    if (j == 0) f = (float)pos / (float)L;
                    else { const int bnd = (j <= 8) ? j : j - 8; const float ang = (6.283185307179586f / (float)L) * (float)pos * (float)bnd; f = (j <= 8) ? sinf(ang) : cosf(ang); }
                    FT[pg * 17 + j] = f; }
                __syncthreads();
                { float s = B1[j];
#pragma unroll
                  for (int f = 0; f < 17; ++f) s += FT[pg * 17 + f] * W1[f * 64 + j];
                  H1[pg * 64 + j] = sinf(F0[j] * s); }
                __syncthreads();
                { float s = B2[j];
#pragma unroll 8
                  for (int i = 0; i < 64; ++i) s += H1[pg * 64 + i] * W2[i * 64 + j];
                  float* dst = (p < 8192) ? (float*)(a.ws + WS_HDN) + (size_t)p * 64 : (float*)(a.ws + WS_HDNC) + (size_t)pos * 64;
                  dst[j] = sinf(F1[j] * s); }
            }
        }
    }
    __syncthreads();
}

__device__ __forceinline__ void phase_norm(const Args& a, int l, bool has_prev, bool do_next, unsigned char* lds) {
    const int tid = opaque_tid(), G = gridDim.x, lane = tid & 63, wave = tid >> 6;
    const float* MOD = (const float*)(a.ws + WS_MOD);
    const bf16_t* Y = (const bf16_t*)(a.ws + WS_U1);
    bf16_t* HB = (bf16_t*)(a.ws + WS_HB);
    float* XC1 = (float*)(a.ws + WS_XC1);
    const int nrows = do_next ? MT : MLAT;
    const bool from_out = !(l == 0 || (has_prev && l == 1));
    const float* xlat = from_out ? (const float*)a.out : a.in[0]; const float* xctx = a.in[2];
#define XSRC(row) (((row) >= MLAT) ? xctx + (size_t)((row) - MLAT) * DM : xlat + (size_t)(row) * DM)
    f32x4 nx[4]; u32x2 ny[4];
    int row = blockIdx.x * 8 + wave;
    if (row < nrows) {
#pragma unroll
        for (int j = 0; j < 4; ++j) { nx[j] = ((const f32x4*)XSRC(row))[lane + 64 * j]; ny[j] = has_prev ? ((const u32x2*)(Y + (size_t)row * DM))[lane + 64 * j] : (u32x2){0u, 0u}; }
    }
    for (; row < nrows; row += G * 8) {
        const bool is_ctx = row >= MLAT; const int mv = is_ctx ? 8 : (row >> 12);
        float* xout = is_ctx ? XC1 + (size_t)(row - MLAT) * DM : a.out + (size_t)row * DM;
        f32x4 xv[4]; u32x2 yr[4];
#pragma unroll
        for (int j = 0; j < 4; ++j) { xv[j] = nx[j]; yr[j] = ny[j]; }
        const int nrow = row + G * 8;
        if (nrow < nrows) {
#pragma unroll
            for (int j = 0; j < 4; ++j) { nx[j] = ((const f32x4*)XSRC(nrow))[lane + 64 * j]; ny[j] = has_prev ? ((const u32x2*)(Y + (size_t)nrow * DM))[lane + 64 * j] : (u32x2){0u, 0u}; }
        }
        if (has_prev) {
            const int lp = l - 1;
            f32x4 yv[4]; float ss = 0.f;
#pragma unroll
            for (int j = 0; j < 4; ++j) { yv[j] = (f32x4){bflo(yr[j].x), bfhi(yr[j].x), bflo(yr[j].y), bfhi(yr[j].y)}; ss += yv[j].x * yv[j].x + yv[j].y * yv[j].y + yv[j].z * yv[j].z + yv[j].w * yv[j].w; }
            const float r = rsqrtf(wave_sum(ss) * (1.f / DM) + RMS_EPS);
#pragma unroll
            for (int j = 0; j < 4; ++j) { const f32x4 gt = ((const f32x4*)(MOD + (size_t)(lp * 9 + mv) * 3072 + 2048))[lane + 64 * j]; const f32x4 pg = ((const f32x4*)(a.in[7] + lp * DM))[lane + 64 * j];
                xv[j] = xv[j] + gt * (yv[j] * r * pg); ((f32x4*)xout)[lane + 64 * j] = xv[j]; }
        }
        if (do_next) {
            float ss = 0.f;
#pragma unroll
            for (int j = 0; j < 4; ++j) ss += xv[j].x * xv[j].x + xv[j].y * xv[j].y + xv[j].z * xv[j].z + xv[j].w * xv[j].w;
            const float r = rsqrtf(wave_sum(ss) * (1.f / DM) + RMS_EPS);
#pragma unroll
            for (int j = 0; j < 4; ++j) {
                const f32x4 pg = ((const f32x4*)(a.in[6] + l * DM))[lane + 64 * j];
                const f32x4 sh = ((const f32x4*)(MOD + (size_t)(l * 9 + mv) * 3072))[lane + 64 * j];
                const f32x4 sc = ((const f32x4*)(MOD + (size_t)(l * 9 + mv) * 3072 + 1024))[lane + 64 * j];
                const f32x4 h = xv[j] * r * pg * (sc + 1.f) + sh;
                u32x2 o; o.x = pk2(h.x, h.y); o.y = pk2(h.z, h.w);
                ((u32x2*)(HB + (size_t)row * DM))[lane + 64 * j] = o;
            }
        }
    }
#undef XSRC
    __syncthreads();
}

__device__ __forceinline__ void gemm_naive(const bf16_t* A, const bf16_t* Bt, int M, int N, int K, void* out, int ldo, int mode, unsigned char* lds) {
    const int tid = opaque_tid(), G = gridDim.x;
    float* As = (float*)lds;
    float* Bs = As + 64 * 33;
    const int ntm = M / 64, ntn = N / 64;
    const int ty = tid >> 4, tx = tid & 15;
    for (int t = blockIdx.x; t < ntm * ntn; t += G) {
        const int tm = t / ntn, tn = t % ntn;
        float acc[2][4] = {};
        for (int k0 = 0; k0 < K; k0 += 32) {
            __syncthreads();
            { const int r = tid >> 3, c4 = (tid & 7) * 4;
              const u32x2 va = *(const u32x2*)(A + (size_t)(tm * 64 + r) * K + k0 + c4);
              As[r * 33 + c4] = bf2f(va.x & 0xffff); As[r * 33 + c4 + 1] = bf2f(va.x >> 16); As[r * 33 + c4 + 2] = bf2f(va.y & 0xffff); As[r * 33 + c4 + 3] = bf2f(va.y >> 16);
              const u32x2 vb = *(const u32x2*)(Bt + (size_t)(tn * 64 + r) * K + k0 + c4);
              Bs[r * 33 + c4] = bf2f(vb.x & 0xffff); Bs[r * 33 + c4 + 1] = bf2f(vb.x >> 16); Bs[r * 33 + c4 + 2] = bf2f(vb.y & 0xffff); Bs[r * 33 + c4 + 3] = bf2f(vb.y >> 16); }
            __syncthreads();
#pragma unroll 8
            for (int kk = 0; kk < 32; ++kk) {
                const float a0 = As[(ty * 2) * 33 + kk], a1 = As[(ty * 2 + 1) * 33 + kk];
#pragma unroll
                for (int j = 0; j < 4; ++j) { const float b = Bs[(tx * 4 + j) * 33 + kk]; acc[0][j] += a0 * b; acc[1][j] += a1 * b; }
            }
        }
#pragma unroll
        for (int i = 0; i < 2; ++i)
#pragma unroll
            for (int j = 0; j < 4; ++j) { const size_t r = tm * 64 + ty * 2 + i, c = tn * 64 + tx * 4 + j;
                if (mode == 0) ((bf16_t*)out)[r * ldo + c] = (bf16_t)f2bf(acc[i][j]);
                else if (mode == 1) ((bf16_t*)out)[c * ldo + r] = (bf16_t)f2bf(acc[i][j]);
                else ((float*)out)[r * ldo + c] = acc[i][j]; }
    }
    __syncthreads();
}


namespace pg8 {
#define PG8_LAS __attribute__((address_space(3)))
typedef short bf16x8 __attribute__((ext_vector_type(8)));
constexpr int BM = 256, BK = 64, HALF = 128, HTB = HALF * BK * 2, STAGE_BYTES = 8 * HTB, NXCD = 8, WGM = 8;
__device__ __forceinline__ int lds_byte(int r, int c) { const int st = (r >> 4) * 2 + (c >> 5), rr = r & 15, cc = c & 31, ob = rr * 64 + cc * 2; return st * 1024 + (ob ^ (((ob >> 9) & 1) << 5)); }
__device__ __forceinline__ void stage_rc(int b, int& R, int& C) { const int st = b / 1024, sb = b % 1024, swz = sb ^ (((sb >> 9) & 1) << 5); R = (st >> 1) * 16 + swz / 64; C = (st & 1) * 32 + (swz % 64) / 2; }
__device__ __forceinline__ int perm32(int rho) { const int n = rho >> 4, i = rho & 15; return 8 * (i >> 2) + 4 * n + (i & 3); }
__device__ __forceinline__ unsigned cvt_pk_bf16(float lo, float hi) { unsigned r; asm volatile("v_cvt_pk_bf16_f32 %0, %1, %2" : "=v"(r) : "v"(lo), "v"(hi)); return r; }

struct Unit { const char* A; const char* B; char* out; int ldo, r0, c0, bjs; };

template <class Dec> struct GridOrder {
    int nM, nN, nwg, G, c; Dec dec;
    __device__ void init(int nM_, int nN_, int G_, int c_, const Dec& d) { nM = nM_; nN = nN_; nwg = nM * nN; G = G_; c = c_; dec = d; }
    __device__ bool next(int i, Unit& u) const {
        const long L = (long)i * G + c; if (L >= nwg) return false;
        int wgid = (int)L; { const int q = nwg / NXCD, r = nwg % NXCD, xcd = wgid % NXCD, off = wgid / NXCD; wgid = (xcd < r ? xcd * (q + 1) : r * (q + 1) + (xcd - r) * q) + off; }
        const int nig = WGM * nN, gid = wgid / nig, fm = gid * WGM, gsz = (nM - fm) < WGM ? (nM - fm) : WGM;
        const int pm = fm + ((wgid % nig) % gsz), pn = (wgid % nig) / gsz; dec(pm, pn, u); return true;
    }
};

template <bool PERM, class Sched>
__device__ __forceinline__ void gemm_phase(PG8_LAS unsigned char* lds, const int K, const Sched& S) {
    const int tid = opaque_tid(), wid = __builtin_amdgcn_readfirstlane(tid >> 6), lane = tid & 63, wr = wid >> 2, wc = wid & 3, fr = lane & 15, fq = lane >> 4;
    const int nt = K / BK;
    unsigned voffA[2], voffB[2];
#pragma unroll
    for (int i = 0; i < 2; ++i) { int R, C; stage_rc(tid * 16 + i * 8192, R, C); const int Rb = PERM ? ((R & ~31) + perm32(R & 31)) : R;
        voffA[i] = (unsigned)(R * K + C) * 2u; voffB[i] = (unsigned)(Rb * K + C) * 2u; }
    const size_t kstep = (size_t)(BK * 2);
    const size_t hstep = (size_t)HALF * K * 2;
    const unsigned ldsw = (unsigned)wid * 1024u;
    const int aoff = lds_byte(wr * 64 + fr, fq * 8), boff = lds_byte(wc * 32 + fr, fq * 8);
#define PG8_SA(b, h) (((b) * 2 + (h)) * HTB)
#define PG8_SB(b, h) ((4 + (b) * 2 + (h)) * HTB)
#define PG8_STAGE(bufoff, gbase, voff) do { _Pragma("unroll") for (int _i = 0; _i < 2; ++_i) \
        __builtin_amdgcn_global_load_lds((const unsigned*)((const char*)(gbase) + (voff)[_i]), (PG8_LAS unsigned*)(lds + (bufoff) + ldsw + _i * 8192), 16, 0, 0); } while (0)
#define PG8_LDA(dst, b, h) do { _Pragma("unroll") for (int m = 0; m < 4; ++m) _Pragma("unroll") for (int k = 0; k < 2; ++k) dst[m][k] = *(const PG8_LAS bf16x8*)(lds + PG8_SA(b, h) + aoff + m * 2048 + k * 1024); } while (0)
#define PG8_LDB(dst, b, h) do { _Pragma("unroll") for (int n = 0; n < 2; ++n) _Pragma("unroll") for (int k = 0; k < 2; ++k) dst[n][k] = *(const PG8_LAS bf16x8*)(lds + PG8_SB(b, h) + boff + n * 2048 + k * 1024); } while (0)
#define PG8_MMA(ai, bj, At, Bt) do { __builtin_amdgcn_s_setprio(1); _Pragma("unroll") for (int m = 0; m < 4; ++m) _Pragma("unroll") for (int n = 0; n < 2; ++n) _Pragma("unroll") for (int k = 0; k < 2; ++k) \
        acc[ai][bj][m][n] = __builtin_amdgcn_mfma_f32_16x16x32_bf16(Bt[n][k], At[m][k], acc[ai][bj][m][n], 0, 0, 0); __builtin_amdgcn_s_setprio(0); } while (0)
#define PG8_WAIT_V(n) asm volatile("s_waitcnt vmcnt(" #n ")" ::: "memory")
#define PG8_WAIT_L(n) asm volatile("s_waitcnt lgkmcnt(" #n ")" ::: "memory")
#define PG8_BAR __builtin_amdgcn_s_barrier()
#define PG8_SCHED __builtin_amdgcn_sched_barrier(0)
    Unit cur, nxt; int ui = 0;
    if (!S.next(0, cur)) return;
    f32x4 acc[2][2][4][2];
#pragma unroll
    for (int a = 0; a < 2; ++a)
#pragma unroll
        for (int b = 0; b < 2; ++b)
#pragma unroll
            for (int m = 0; m < 4; ++m)
#pragma unroll
                for (int n = 0; n < 2; ++n) acc[a][b][m][n] = (f32x4){0.f, 0.f, 0.f, 0.f};
    bf16x8 At[4][2], B0[2][2], B1[2][2];
    const char* cA = cur.A; const char* cB = cur.B;
    PG8_STAGE(PG8_SB(0, 0), cB, voffB); PG8_STAGE(PG8_SA(0, 0), cA, voffA); PG8_STAGE(PG8_SB(0, 1), cB + hstep, voffB); PG8_STAGE(PG8_SA(0, 1), cA + hstep, voffA);
    if (wr == 1) PG8_BAR;
    PG8_WAIT_V(4); PG8_BAR;
    PG8_STAGE(PG8_SB(1, 0), cB + kstep, voffB); PG8_STAGE(PG8_SA(1, 0), cA + kstep, voffA); PG8_STAGE(PG8_SB(1, 1), cB + hstep + kstep, voffB);
    PG8_WAIT_V(6); PG8_BAR;
    for (;;) {
        const bool has_next = S.next(ui + 1, nxt);
        const char* nA = has_next ? nxt.A : cA; const char* nB = has_next ? nxt.B : cB;
        for (int t = 0; t < nt; t += 2) {
            const bool last = (t == nt - 2);
            const char* a1 = cA + (size_t)(t + 1) * kstep;
            const char* a2 = last ? nA : cA + (size_t)(t + 2) * kstep; const char* b2 = last ? nB : cB + (size_t)(t + 2) * kstep;
            const char* a3 = a2 + kstep; const char* b3 = b2 + kstep;
            PG8_LDB(B0, 0, 0); PG8_SCHED; PG8_LDA(At, 0, 0); PG8_STAGE(PG8_SA(1, 1), a1 + hstep, voffA);
            PG8_WAIT_L(8); PG8_BAR; PG8_WAIT_L(0); PG8_MMA(0, 0, At, B0); PG8_BAR; PG8_SCHED;
            PG8_LDB(B1, 0, 1); PG8_STAGE(PG8_SB(0, 0), b2, voffB);
            PG8_BAR; PG8_WAIT_L(0); PG8_MMA(0, 1, At, B1); PG8_BAR;
            PG8_LDA(At, 0, 1); PG8_STAGE(PG8_SA(0, 0), a2, voffA);
            PG8_BAR; PG8_WAIT_L(0); PG8_MMA(1, 0, At, B0); PG8_BAR; PG8_SCHED;
            PG8_STAGE(PG8_SB(0, 1), b2 + hstep, voffB);
            PG8_WAIT_V(6); PG8_BAR; PG8_MMA(1, 1, At, B1); PG8_BAR;
            PG8_LDB(B0, 1, 0); PG8_SCHED; PG8_LDA(At, 1, 0); PG8_STAGE(PG8_SA(0, 1), a2 + hstep, voffA);
            PG8_WAIT_L(8); PG8_BAR; PG8_WAIT_L(0); PG8_MMA(0, 0, At, B0); PG8_BAR; PG8_SCHED;
            PG8_LDB(B1, 1, 1); PG8_STAGE(PG8_SB(1, 0), b3, voffB);
            PG8_BAR; PG8_WAIT_L(0); PG8_MMA(0, 1, At, B1); PG8_BAR;
            PG8_LDA(At, 1, 1); PG8_STAGE(PG8_SA(1, 0), a3, voffA);
            PG8_BAR; PG8_WAIT_L(0); PG8_MMA(1, 0, At, B0); PG8_BAR; PG8_SCHED;
            PG8_STAGE(PG8_SB(1, 1), b3 + hstep, voffB);
            PG8_WAIT_V(6); PG8_BAR; PG8_MMA(1, 1, At, B1); PG8_BAR;
        }
        {
            const int row0 = cur.r0 + wr * 64 + fr;
            if (PERM) {
                bf16_t* base = (bf16_t*)cur.out; const int col0 = cur.c0 + wc * 32 + 8 * fq;
#pragma unroll
                for (int ai = 0; ai < 2; ++ai)
#pragma unroll
                    for (int m = 0; m < 4; ++m) { bf16_t* rowp = base + (size_t)(row0 + ai * HALF + m * 16) * cur.ldo + col0;
#pragma unroll
                        for (int bj = 0; bj < 2; ++bj) { const f32x4 v0 = acc[ai][bj][m][0], v1 = acc[ai][bj][m][1];
                            u32x4 w; w.x = cvt_pk_bf16(v0[0], v0[1]); w.y = cvt_pk_bf16(v0[2], v0[3]); w.z = cvt_pk_bf16(v1[0], v1[1]); w.w = cvt_pk_bf16(v1[2], v1[3]);
                            *(u32x4*)(rowp + bj * cur.bjs) = w; } }
            } else {
                float* base = (float*)cur.out; const int col0 = cur.c0 + wc * 32 + 4 * fq;
#pragma unroll
                for (int ai = 0; ai < 2; ++ai)
#pragma unroll
                    for (int m = 0; m < 4; ++m) { float* rowp = base + (size_t)(row0 + ai * HALF + m * 16) * cur.ldo + col0;
#pragma unroll
                        for (int bj = 0; bj < 2; ++bj)
#pragma unroll
                            for (int n = 0; n < 2; ++n) *(f32x4*)(rowp + bj * cur.bjs + n * 16) = acc[ai][bj][m][n]; }
            }
        }
        if (!has_next) break;
#pragma unroll
        for (int a = 0; a < 2; ++a)
#pragma unroll
            for (int b = 0; b < 2; ++b)
#pragma unroll
                for (int m = 0; m < 4; ++m)
#pragma unroll
                    for (int n = 0; n < 2; ++n) acc[a][b][m][n] = (f32x4){0.f, 0.f, 0.f, 0.f};
        cur = nxt; cA = nA; cB = nB; ++ui;
    }
    PG8_WAIT_V(0);
    if (wr == 0) PG8_BAR;
    PG8_BAR;
#undef PG8_SA
#undef PG8_SB
#undef PG8_STAGE
#undef PG8_LDA
#undef PG8_LDB
#undef PG8_MMA
#undef PG8_WAIT_V
#undef PG8_WAIT_L
#undef PG8_BAR
#undef PG8_SCHED
}
}

struct DecIn {
    const char* HB; const char* W; char* U1; char* UT;
    __device__ void operator()(int pm, int pn, pg8::Unit& u) const {
        const char* tp = HB + (size_t)pm * 256 * DM * 2; const char* wp = W + (size_t)pn * 256 * DM * 2;
        u.bjs = 128;
        if (pn < 4) { u.A = tp; u.B = wp; u.out = U1; u.ldo = LDU1; u.r0 = pm * 256; u.c0 = pn * 256; }
        else if (pn < 6) {
            const int bb = pm < 128 ? pm >> 4 : pm - 128, srow0 = pm < 128 ? LCTX + (pm & 15) * 256 : 0;
            u.A = tp; u.B = wp; u.out = U1 + (WS_V2 - WS_U1) + ((size_t)(bb * 4 + 2 * (pn - 4)) * (LCTX + LSEQ) + srow0) * 128 * 2; u.ldo = 128; u.r0 = 0; u.c0 = 0; u.bjs = (LCTX + LSEQ) * 128; }
        else if (pn < 10) { u.A = tp; u.B = wp; u.out = U1; u.ldo = LDU1; u.r0 = pm * 256; u.c0 = (pn - 2) * 256; }
        else { u.A = wp; u.B = tp; u.out = UT; u.ldo = MT; u.r0 = (pn - 10) * 256; u.c0 = pm * 256; }
    }
};
struct DecOut {
    const char* YM; const char* W; char* Y;
    __device__ void operator()(int pm, int pn, pg8::Unit& u) const {
        u.A = YM + (size_t)pm * 256 * DM * 2; u.B = W + (size_t)pn * 256 * DM * 2; u.out = Y; u.ldo = DM; u.r0 = pm * 256; u.c0 = pn * 256; u.bjs = 128;
    }
};

__device__ __forceinline__ void mlstm_naive(const Args& a, int l, unsigned char* lds) {
    const int tid = opaque_tid(), G = gridDim.x;
    const bf16_t* U1 = (const bf16_t*)(a.ws + WS_U1);
    const float* GATES = (const float*)(a.ws + WS_GATES);
    bf16_t* HDo = (bf16_t*)(a.ws + WS_HB);
    float* qs = (float*)lds; float* ks = qs + 128; float* vs = ks + 128; float* sc = vs + 32;
    float* pnum = sc + 8;
    float* pden = pnum + 512;
    const float* cw = a.in[10] + (size_t)l * 3 * 1024; const float* cb = a.in[11] + (size_t)l * 1024;
    for (int it = blockIdx.x; it < 256; it += G) {
        const int dvs = it & 3, dir = (it >> 2) & 1, hh = (it >> 3) & 3, b = it >> 5;
        float C[8], nn[8];
#pragma unroll
        for (int i = 0; i < 8; ++i) { C[i] = 0.f; nn[i] = 0.f; }
        float m = 0.f;
        const int j = tid & 31, dg = tid >> 5;
        for (int step = 0; step < LCTX + LSEQ; ++step) {
            int seqlen, tt, rowbase; bool is_ctx = step < LCTX;
            if (is_ctx) { seqlen = LCTX; tt = dir ? (LCTX - 1 - step) : step; rowbase = MLAT + b * LCTX; }
            else { seqlen = LSEQ; const int s2 = step - LCTX; tt = dir ? (LSEQ - 1 - s2) : s2; rowbase = b * LSEQ; }
            const int row = rowbase + tt;
            if (tid < 256) {
                const int ch = (tid < 128) ? (hh * 128 + tid) : (512 + hh * 128 + (tid - 128));
                bool has_l, has_r;
                if (is_ctx) { has_l = tt > 0; has_r = tt < seqlen - 1; } else { has_l = (tt & 63) != 0; has_r = (tt & 63) != 63; }
                float v = bf2f(U1[(size_t)row * NU1 + ch]) * cw[1024 + ch] + cb[ch];
                if (has_l) v += bf2f(U1[(size_t)(row - 1) * NU1 + ch]) * cw[ch];
                if (has_r) v += bf2f(U1[(size_t)(row + 1) * NU1 + ch]) * cw[2048 + ch];
                v = silu_f(v);
                if (tid < 128) qs[tid] = v; else ks[tid - 128] = v * 0.08838834764831845f;
            } else if (tid < 288) {
                vs[tid - 256] = bf2f(U1[(size_t)row * NU1 + 1024 + hh * 128 + dvs * 32 + (tid - 256)]);
            } else if (tid == 288) {
                const float ip = GATES[(size_t)row * 16 + (2 * dir) * 4 + hh], fp = GATES[(size_t)row * 16 + (2 * dir + 1) * 4 + hh];
                const float logf = fminf(fp, 0.f) - log1pf(__expf(-fabsf(fp)));
                const float mn = fmaxf(logf + m, ip);
                sc[0] = __expf(logf + m - mn); sc[1] = __expf(ip - mn); sc[2] = __expf(-mn);
                m = mn;
            }
            __syncthreads();
            const float fw = sc[0], iw = sc[1];
            float pn = 0.f, pd = 0.f;
#pragma unroll
            for (int dd = 0; dd < 8; ++dd) { const int d = dg * 8 + dd; const float kk = ks[d], qq = qs[d];
                C[dd] = fw * C[dd] + iw * kk * vs[j]; nn[dd] = fw * nn[dd] + iw * kk; pn += qq * C[dd]; pd += qq * nn[dd]; }
            pnum[dg * 32 + j] = pn; if (j == 0) pden[dg] = pd;
            __syncthreads();
            if (tid < 32) { float num = 0.f, den = 0.f;
#pragma unroll
                for (int g = 0; g < 16; ++g) { num += pnum[g * 32 + tid]; den += pden[g]; }
                const float h = num / fmaxf(fabsf(den), sc[2]);
                HDo[((size_t)dir * MT + row) * DML + hh * 128 + dvs * 32 + tid] = (bf16_t)f2bf(h); }
        }
        __syncthreads();
    }
}


#define LAS __attribute__((address_space(3)))
typedef short bf16x8 __attribute__((ext_vector_type(8)));
__device__ __forceinline__ u32x4 ldg16_or_zero(const bf16_t* p, bool ok) { u32x4 z = {0u, 0u, 0u, 0u}; return ok ? *(const u32x4*)p : z; }


__device__ __forceinline__ void filt_item(const Args& a, int l, unsigned char* lds_, int fi);
__device__ __forceinline__ void phase_mprep(const Args& a, int l, unsigned char* lds_, int rep) {
    const int tid = opaque_tid(), lane = tid & 63, wave = __builtin_amdgcn_readfirstlane(tid >> 6), fr = lane & 15, fq = lane >> 4;
    LAS float* P = (LAS float*)lds_;
    LAS float* Gs = P + 2048;
    LAS bf16_t* WgS = (LAS bf16_t*)((LAS unsigned char*)lds_ + 32768);
    LAS unsigned* qslot = (LAS unsigned*)((LAS unsigned char*)lds_ + (LDS_BYTES - 32));
    const bf16_t* U1 = (const bf16_t*)(a.ws + WS_U1);
    const bf16_t* HB = (const bf16_t*)(a.ws + WS_HB);
    const bf16_t* WgT = (const bf16_t*)(a.ws + WS_WGT) + (size_t)l * 16 * 1024;
    bf16_t* QK = (bf16_t*)(a.ws + WS_YMIX);
    float* GP = (float*)(a.ws + WS_GP);
    const float* cw = a.in[10] + (size_t)l * 3072; const float* cb = a.in[11] + (size_t)l * 1024;
    unsigned* ctr = (unsigned*)(a.ws + WS_CTL) + CW_QUEUE + 64 * (16 + l * 8 + rep);
    const int co = tid & 127, rg4 = tid >> 7;
    __syncthreads();
    for (int i = tid; i < 16 * 128; i += NTHR) { const int g = i >> 7, c8 = (i & 127) * 8; *(LAS u32x4*)(WgS + g * 1032 + c8) = *(const u32x4*)(WgT + g * 1024 + c8); }
    for (;;) {
        __syncthreads();
        if (tid == 0) *qslot = __hip_atomic_fetch_add(ctr, 1u, __ATOMIC_RELAXED, __HIP_MEMORY_SCOPE_AGENT);
        __syncthreads();
        const int item = (int)*qslot;
        if (item >= 128 + MT / 64) break;
        if (item < 128) { filt_item(a, l, lds_, item); continue; }
        const int ch = item - 128;
        const int rowbase = ch * 64;
        const bool is_ctx = rowbase >= MLAT; const int cc = is_ctx ? ((rowbase - MLAT) >> 6) & 3 : 0;
        const bool has_lo = is_ctx && cc > 0, has_hi = is_ctx && cc < 3;
        {
            const int rt = wave & 3, kh = wave >> 2;
            f32x4 acc = {0.f, 0.f, 0.f, 0.f};
            const bf16_t* ap = HB + (size_t)(rowbase + rt * 16 + fr) * DM + kh * 512 + fq * 8;
            LAS const bf16_t* bp = WgS + fr * 1032 + kh * 512 + fq * 8;
            bf16x8 af[16];
#pragma unroll
            for (int ks = 0; ks < 16; ++ks) af[ks] = *(const bf16x8*)(ap + ks * 32);
#pragma unroll
            for (int ks = 0; ks < 16; ++ks) { const bf16x8 bf = *(const LAS bf16x8*)(bp + ks * 32); acc = __builtin_amdgcn_mfma_f32_16x16x32_bf16(af[ks], bf, acc, 0, 0, 0); }
#pragma unroll
            for (int jj = 0; jj < 4; ++jj) P[(kh * 64 + rt * 16 + 4 * fq + jj) * 16 + fr] = acc[jj];
        }
        {
            float w0[8], w1[8], w2[8], bb[8];
#pragma unroll
            for (int e = 0; e < 8; ++e) { w0[e] = cw[co * 8 + e]; w1[e] = cw[1024 + co * 8 + e]; w2[e] = cw[2048 + co * 8 + e]; bb[e] = cb[co * 8 + e]; }
            u32x4 r0, r1, r2;
            { const int tt = rg4 * 16 - 1; r0 = ldg16_or_zero(U1 + (size_t)(rowbase + tt) * LDU1 + co * 8, tt >= 0 || has_lo); }
            r1 = *(const u32x4*)(U1 + (size_t)(rowbase + rg4 * 16) * LDU1 + co * 8);
            const int qb = is_ctx ? (rowbase - MLAT) >> 8 : rowbase >> 12, srow0 = is_ctx ? (rowbase - MLAT) & 255 : LCTX + (rowbase & 4095);
            unsigned char* qdst = (unsigned char*)QK + (size_t)(qb * 4 + ((co & 63) >> 4)) * QK8_STRIDE + (size_t)srow0 * 256 + (co >> 6) * 128 + (co & 15) * 8;
#pragma unroll 4
            for (int i = 0; i < 16; ++i) { const int tt = rg4 * 16 + i;
                r2 = ldg16_or_zero(U1 + (size_t)(rowbase + tt + 1) * LDU1 + co * 8, tt + 1 <= 63 || has_hi);
                float fv[8];
#pragma unroll
                for (int e2 = 0; e2 < 4; ++e2) {
                    fv[2 * e2] = silu_f(bflo(r0[e2]) * w0[2 * e2] + bflo(r1[e2]) * w1[2 * e2] + bflo(r2[e2]) * w2[2 * e2] + bb[2 * e2]);
                    fv[2 * e2 + 1] = silu_f(bfhi(r0[e2]) * w0[2 * e2 + 1] + bfhi(r1[e2]) * w1[2 * e2 + 1] + bfhi(r2[e2]) * w2[2 * e2 + 1] + bb[2 * e2 + 1]); }
                int p0 = 0, p1 = 0;
                p0 = __builtin_amdgcn_cvt_pk_fp8_f32(fv[0], fv[1], p0, false); p0 = __builtin_amdgcn_cvt_pk_fp8_f32(fv[2], fv[3], p0, true);
                p1 = __builtin_amdgcn_cvt_pk_fp8_f32(fv[4], fv[5], p1, false); p1 = __builtin_amdgcn_cvt_pk_fp8_f32(fv[6], fv[7], p1, true);
                *(u32x2*)(qdst + (size_t)tt * 256) = (u32x2){(unsigned)p0, (unsigned)p1};
                r0 = r1; r1 = r2; }
        }
        __syncthreads();
        for (int i = tid; i < 1024; i += NTHR) Gs[i] = P[i] + P[1024 + i] + a.in[9][l * 16 + (i & 15)];
        __syncthreads();
        {
            const int dir = wave >> 2, hh = wave & 3, tt = dir ? 63 - lane : lane;
            const float gi = Gs[tt * 16 + (2 * dir) * 4 + hh], gf = Gs[tt * 16 + (2 * dir + 1) * 4 + hh];
            const float logf = fminf(gf, 0.f) - log1pf(__expf(-fabsf(gf)));
            float bc = logf;
#pragma unroll
            for (int ofs = 1; ofs < 64; ofs <<= 1) { const float t = __shfl_up(bc, ofs); if (lane >= ofs) bc += t; }
            const float av = gi - bc;
            float cm = av;
#pragma unroll
            for (int ofs = 1; ofs < 64; ofs <<= 1) { const float t = __shfl_up(cm, ofs); if (lane >= ofs) cm = fmaxf(cm, t); }
            float* gp = GP + ((size_t)ch * 8 + wave) * 192;
            gp[lane] = bc; gp[64 + lane] = av; gp[128 + lane] = cm;
        }
    }
    __syncthreads();
}

__device__ __forceinline__ void dec16_fp8(const u32x4 raw, float (&f)[16]) {
#pragma unroll
    for (int e = 0; e < 4; ++e) { const f32x2 lo = __builtin_amdgcn_cvt_pk_f32_fp8((int)raw[e], false), hi = __builtin_amdgcn_cvt_pk_f32_fp8((int)raw[e], true);
        f[4 * e] = lo.x; f[4 * e + 1] = lo.y; f[4 * e + 2] = hi.x; f[4 * e + 3] = hi.y; }
}
__device__ __forceinline__ void mlstm_item(const Args& a, int l, unsigned char* lds_, int it, bool do_store) {
    const int tid = opaque_tid(), lane = tid & 63, wave = __builtin_amdgcn_readfirstlane(tid >> 6), fr = lane & 15, fq = lane >> 4;
    LAS unsigned char* lds = (LAS unsigned char*)lds_;
    LAS bf16_t* Qs = (LAS bf16_t*)(lds);
    LAS bf16_t* Ks = (LAS bf16_t*)(lds + 17408);
    LAS bf16_t* KTs = (LAS bf16_t*)(lds + 34816);
    LAS bf16_t* VTs = (LAS bf16_t*)(lds + 53248);
    LAS bf16_t* Ss = (LAS bf16_t*)(lds + 73984);
    LAS bf16_t* CTs = (LAS bf16_t*)(lds + 83200);
    LAS float* F = (LAS float*)(lds + 122368);
    LAS float* Aa = F; LAS float* Gg = F + 64; LAS float* WI = F + 128; LAS float* EM = F + 192;
    const unsigned char* QK8 = (const unsigned char*)(a.ws + WS_YMIX);
    const bf16_t* V2 = (const bf16_t*)(a.ws + WS_V2);
    const float* GP = (const float*)(a.ws + WS_GP);
    bf16_t* HDo = (bf16_t*)(a.ws + WS_HB);
    const int dir = it & 1, hh = (it >> 1) & 3, b = it >> 3;
    const int c16 = wave * 16;
    const int rpos = dir ? 63 - lane : lane;
    __syncthreads();
    for (int i = tid; i < 144 * 136 / 2; i += NTHR) ((LAS unsigned*)CTs)[i] = 0u;
    for (int i = tid; i < 16 * 72 / 2; i += NTHR) ((LAS unsigned*)(VTs + 128 * 72))[i] = (i < 36) ? 0x3f803f80u : 0u;
    f32x4 accC[9];
#pragma unroll
    for (int j = 0; j < 9; ++j) accC[j] = (f32x4){0.f, 0.f, 0.f, 0.f};
    float m_prev = 0.f;
    struct OpSet { u32x4 rq8, rk8, v0, v1; float ga, gbc, gav, gcm, g_bl, g_cm63; };
    auto chunk_rowbase = [&](int cs) -> int {
        const bool is_ctx = cs < 4; const int cc = is_ctx ? (dir ? 3 - cs : cs) : (dir ? 63 - (cs - 4) : cs - 4);
        return is_ctx ? MLAT + b * LCTX + cc * 64 : b * LSEQ + cc * 64; };
    auto prefetch = [&](int cs_, OpSet& o) {
        const int cs = cs_ < 68 ? cs_ : 67;
        const int rowbase = chunk_rowbase(cs);
        const int srow0 = (rowbase >= MLAT) ? (rowbase - MLAT) & 255 : LCTX + (rowbase & 4095);
        const unsigned char* qp = QK8 + (size_t)(b * 4 + hh) * QK8_STRIDE + (size_t)(srow0 + lane) * 256 + c16;
        o.rq8 = *(const u32x4*)qp; o.rk8 = *(const u32x4*)(qp + 128);
        const bf16_t* vp = V2 + ((size_t)(b * 4 + hh) * (LCTX + LSEQ) + srow0 + lane) * 128 + c16;
        o.v0 = *(const u32x4*)vp; o.v1 = *(const u32x4*)(vp + 8);
        const float* gp = GP + ((size_t)(rowbase >> 6) * 8 + dir * 4 + hh) * 192;
        o.g_bl = gp[63]; o.g_cm63 = gp[128 + 63]; o.ga = gp[64 + rpos];
        o.gbc = gp[lane]; o.gav = gp[64 + lane]; o.gcm = gp[128 + lane];
    };
    OpSet os0, os1, os2;
    prefetch(0, os0); prefetch(1, os1); prefetch(2, os2);
    __syncthreads();
    u32x2 hold[4]; int hold_row = -1;
#pragma unroll
    for (int j = 0; j < 4; ++j) hold[j] = (u32x2){0u, 0u};
    auto flush = [&]() {
        if (hold_row >= 0 && do_store) { bf16_t* op = HDo + (((size_t)dir * 32 + b * 4 + hh) * (LCTX + LSEQ) + hold_row) * 128 + (wave >> 2) * 64 + 4 * fq;
#pragma unroll
            for (int j = 0; j < 4; ++j) *(u32x2*)(op + j * 16) = hold[j]; } };
    auto step = [&](const int cs, OpSet& o) {
        const int rowbase = chunk_rowbase(cs);
        const u32x4 rq8 = o.rq8, rk8 = o.rk8; u32x4 vraw[2]; vraw[0] = o.v0; vraw[1] = o.v1;
        const float ga = o.ga, gbc = o.gbc, gav = o.gav, gcm = o.gcm, g_bl = o.g_bl, g_cm63 = o.g_cm63;
        const float g63 = fmaxf(m_prev, g_cm63), wc = __expf(m_prev - g63);
        {
            float f[16];
            dec16_fp8(rq8, f);
            { u32x4 w0, w1;
#pragma unroll
              for (int e = 0; e < 4; ++e) { w0[e] = pg8::cvt_pk_bf16(f[2 * e], f[2 * e + 1]); w1[e] = pg8::cvt_pk_bf16(f[8 + 2 * e], f[8 + 2 * e + 1]); }
              *(LAS u32x4*)(Qs + rpos * 136 + c16) = w0; *(LAS u32x4*)(Qs + rpos * 136 + c16 + 8) = w1; }
            dec16_fp8(rk8, f);
            { u32x4 w0, w1;
#pragma unroll
              for (int e = 0; e < 16; ++e) f[e] *= 0.08838834764831845f;
#pragma unroll
              for (int e = 0; e < 4; ++e) { w0[e] = pg8::cvt_pk_bf16(f[2 * e], f[2 * e + 1]); w1[e] = pg8::cvt_pk_bf16(f[8 + 2 * e], f[8 + 2 * e + 1]); }
              *(LAS u32x4*)(Ks + rpos * 136 + c16) = w0; *(LAS u32x4*)(Ks + rpos * 136 + c16 + 8) = w1;
              const float ws = __expf(ga - g63);
#pragma unroll
              for (int e = 0; e < 8; ++e) { const unsigned pw = pg8::cvt_pk_bf16(f[2 * e] * ws, f[2 * e + 1] * ws);
                  KTs[(c16 + 2 * e) * 72 + rpos] = (bf16_t)(pw & 0xffffu); KTs[(c16 + 2 * e + 1) * 72 + rpos] = (bf16_t)(pw >> 16); } }
#pragma unroll
            for (int h2 = 0; h2 < 2; ++h2)
#pragma unroll
                for (int e2 = 0; e2 < 4; ++e2) { VTs[(c16 + h2 * 8 + 2 * e2) * 72 + rpos] = (bf16_t)(vraw[h2][e2] & 0xffffu); VTs[(c16 + h2 * 8 + 2 * e2 + 1) * 72 + rpos] = (bf16_t)(vraw[h2][e2] >> 16); }
            if (wave == 7) { const float g = fmaxf(m_prev, gcm); Aa[lane] = gav; Gg[lane] = g; WI[lane] = __expf(m_prev - g); EM[lane] = __expf(-(gbc + g)); }
        }
        m_prev = g_bl + g63;
        flush();
        prefetch(cs + 3, o);
        __syncthreads();
        {
            const int tb = wave >> 1;
#pragma unroll
            for (int q2 = 0; q2 < 2; ++q2) {
                const int sb = (wave & 1) * 2 + q2;
                f32x4 acc = {0.f, 0.f, 0.f, 0.f};
                if (sb <= tb) {
                    bf16x8 kf[4], qf[4];
#pragma unroll
                    for (int ks = 0; ks < 4; ++ks) { kf[ks] = *(const LAS bf16x8*)(Ks + (sb * 16 + fr) * 136 + ks * 32 + fq * 8); qf[ks] = *(const LAS bf16x8*)(Qs + (tb * 16 + fr) * 136 + ks * 32 + fq * 8); }
#pragma unroll
                    for (int ks = 0; ks < 4; ++ks) acc = __builtin_amdgcn_mfma_f32_16x16x32_bf16(kf[ks], qf[ks], acc, 0, 0, 0);
                    const int t = tb * 16 + fr, s0 = sb * 16 + 4 * fq; const float g = Gg[t];
                    const f32x4 av = *(const LAS f32x4*)(Aa + s0);
#pragma unroll
                    for (int jj = 0; jj < 4; ++jj) acc[jj] = (s0 + jj <= t) ? acc[jj] * __expf(av[jj] - g) : 0.f;
                }
                u32x2 w; w.x = pg8::cvt_pk_bf16(acc[0], acc[1]); w.y = pg8::cvt_pk_bf16(acc[2], acc[3]);
                *(LAS u32x2*)(Ss + (tb * 16 + fr) * 72 + sb * 16 + 4 * fq) = w;
            }
        }
        __syncthreads();
        {
            const int tb = wave & 3, half = wave >> 2, t = tb * 16 + fr;
            f32x4 acc[5];
#pragma unroll
            for (int j = 0; j < 5; ++j) acc[j] = (f32x4){0.f, 0.f, 0.f, 0.f};
#pragma unroll
            for (int ks = 0; ks < 4; ++ks) {
                const bf16x8 qf = *(const LAS bf16x8*)(Qs + t * 136 + ks * 32 + fq * 8);
#pragma unroll
                for (int j = 0; j < 5; ++j) { const int jrow = (j < 4) ? (half * 4 + j) * 16 : 128;
                    const bf16x8 cf = *(const LAS bf16x8*)(CTs + (jrow + fr) * 136 + ks * 32 + fq * 8);
                    acc[j] = __builtin_amdgcn_mfma_f32_16x16x32_bf16(cf, qf, acc[j], 0, 0, 0); }
            }
            const float wi = WI[t];
#pragma unroll
            for (int j = 0; j < 5; ++j) acc[j] = acc[j] * wi;
#pragma unroll
            for (int ks = 0; ks < 2; ++ks) {
                const bf16x8 sf = *(const LAS bf16x8*)(Ss + t * 72 + ks * 32 + fq * 8);
#pragma unroll
                for (int j = 0; j < 5; ++j) { const int jrow = (j < 4) ? (half * 4 + j) * 16 : 128;
                    const bf16x8 vf = *(const LAS bf16x8*)(VTs + (jrow + fr) * 72 + ks * 32 + fq * 8);
                    acc[j] = __builtin_amdgcn_mfma_f32_16x16x32_bf16(vf, sf, acc[j], 0, 0, 0); }
            }
            const float den = __shfl(acc[4][0], fr);
            const float inv = __builtin_amdgcn_rcpf(fmaxf(fabsf(den), EM[t]));
#pragma unroll
            for (int j = 0; j < 4; ++j) { hold[j].x = pg8::cvt_pk_bf16(acc[j][0] * inv, acc[j][1] * inv); hold[j].y = pg8::cvt_pk_bf16(acc[j][2] * inv, acc[j][3] * inv); }
            hold_row = ((rowbase >= MLAT) ? (rowbase - MLAT) & 255 : LCTX + (rowbase & 4095)) + (dir ? 63 - t : t);
            const int d0 = wave * 16;
#pragma unroll
            for (int j = 0; j < 9; ++j) accC[j] = accC[j] * wc;
#pragma unroll
            for (int ks = 0; ks < 2; ++ks) {
                const bf16x8 kf = *(const LAS bf16x8*)(KTs + (d0 + fr) * 72 + ks * 32 + fq * 8);
#pragma unroll
                for (int j = 0; j < 9; ++j) { const bf16x8 vf = *(const LAS bf16x8*)(VTs + (j * 16 + fr) * 72 + ks * 32 + fq * 8);
                    accC[j] = __builtin_amdgcn_mfma_f32_16x16x32_bf16(kf, vf, accC[j], 0, 0, 0); }
            }
        }
        __syncthreads();
        {
            const int d0 = wave * 16;
#pragma unroll
            for (int j = 0; j < 9; ++j) { u32x2 w; w.x = pg8::cvt_pk_bf16(accC[j][0], accC[j][1]); w.y = pg8::cvt_pk_bf16(accC[j][2], accC[j][3]);
                *(LAS u32x2*)(CTs + (j * 16 + fr) * 136 + d0 + 4 * fq) = w; }
        }
    };
#pragma unroll 1
    for (int cs = 0; cs < 66; cs += 3) { step(cs, os0); step(cs + 1, os1); step(cs + 2, os2); }
    step(66, os0); step(67, os1);
    flush();
    __syncthreads();
}

__device__ __forceinline__ float conv3_at(const bf16_t* rowp, int t, int seglen, float w0, float w1, float w2, float bias) {
    const int tl = t % seglen;
    float v = bf2f(rowp[t]) * w1 + bias;
    if (tl > 0) v += bf2f(rowp[t - 1]) * w0;
    if (tl < seglen - 1) v += bf2f(rowp[t + 1]) * w2;
    return v;
}
__device__ __forceinline__ void hyena_naive(const Args& a, int l, unsigned char* lds, int pass_lo, bool do_store) {
    const int tid = opaque_tid(), G = gridDim.x;
    bf16_t* UT = (bf16_t*)(a.ws + WS_UT);
    float* H = (float*)lds;
    float* Ub = H + 8192;
    float* Zb = Ub + 4096;
    float* red = Zb + 4096;
    float* w3s = red + 64;
    const float* hw = a.in[13] + (size_t)l * 3 * 1536; const float* hb = a.in[14] + (size_t)l * 1536;
    const float MIN_DECAY = -3.0701134573253946f, MAX_DECAY = -15.350567286626973f;
    for (int c = blockIdx.x; c < DHY; c += G) {
        const float rate = fabsf(MIN_DECAY + (MAX_DECAY - MIN_DECAY) * (float)c / 511.f);
        const float fb0 = a.in[21][(l * 2 + 0) * 512 + c], fb1 = a.in[21][(l * 2 + 1) * 512 + c];
        float cwv[3][3], cbv[3];
#pragma unroll
        for (int g = 0; g < 3; ++g) { cbv[g] = hb[g * 512 + c];
#pragma unroll
            for (int t3 = 0; t3 < 3; ++t3) cwv[g][t3] = hw[t3 * 1536 + g * 512 + c]; }
        for (int pass = pass_lo; pass < (l == 0 ? 2 : 1); ++pass) {
            const int L = pass ? LCTX : LSEQ;
            const float* hdn = pass ? (const float*)(a.ws + WS_HDNC) : (const float*)(a.ws + WS_HDN) + (size_t)l * 4096 * 64;
            __syncthreads();
            if (tid < 128) w3s[tid] = a.in[20][(size_t)l * 64 * 1024 + (tid & 63) * 1024 + (tid >> 6) * 512 + c];
            __syncthreads();
            float ssq0 = 0.f, ssq1 = 0.f;
            for (int t = tid; t < L; t += 512) { float s0 = 0.f, s1 = 0.f;
                for (int jj = 0; jj < 64; ++jj) { const float hv = hdn[(size_t)t * 64 + jj]; s0 += hv * w3s[jj]; s1 += hv * w3s[64 + jj]; }
                const float off = fabsf((float)t - (float)(L / 2)) / (float)(L / 2); const float dec = __expf(-off * rate);
                s0 *= dec; s1 *= dec; H[t] = s0; H[4096 + t] = s1; ssq0 += s0 * s0; ssq1 += s1 * s1; }
            ssq0 = wave_sum(ssq0); ssq1 = wave_sum(ssq1);
            if ((tid & 63) == 0) { red[tid >> 6] = ssq0; red[8 + (tid >> 6)] = ssq1; }
            __syncthreads();
            float t0 = 0.f, t1 = 0.f;
            for (int w = 0; w < 8; ++w) { t0 += red[w]; t1 += red[8 + w]; }
            const float n0 = rsqrtf(t0 + RMS_EPS), n1 = rsqrtf(t1 + RMS_EPS);
            __syncthreads();
            for (int t = tid; t < L; t += 512) { H[t] *= n0; H[4096 + t] *= n1; }
            __syncthreads();
            for (int b = 0; b < NB; ++b) {
                const size_t col0 = pass ? (size_t)MLAT + (size_t)b * LCTX : (size_t)b * LSEQ;
                const int seglen = pass ? LCTX : 64;
                const bf16_t* rv = UT + (size_t)c * MT + col0; const bf16_t* r1 = UT + (size_t)(512 + c) * MT + col0;
                const bf16_t* r2 = UT + (size_t)(1024 + c) * MT + col0; const bf16_t* rz = UT + (size_t)(1536 + c) * MT + col0;
                for (int t = tid; t < L; t += 512) Ub[t] = conv3_at(rv, t, seglen, cwv[0][0], cwv[0][1], cwv[0][2], cbv[0]);
                __syncthreads();
                for (int t = tid; t < L; t += 512) { float y = 0.f;
                    int slo = t + L / 2 - (L - 1); if (slo < 0) slo = 0; int shi = t + L / 2; if (shi > L - 1) shi = L - 1;
                    for (int s = slo; s <= shi; ++s) y += Ub[s] * H[t + L / 2 - s];
                    const float x1 = conv3_at(r1, t, seglen, cwv[1][0], cwv[1][1], cwv[1][2], cbv[1]);
                    Zb[t] = x1 * (y + Ub[t] * fb0); }
                __syncthreads();
                for (int t = tid; t < L; t += 512) { float y = 0.f;
                    int slo = t + L / 2 - (L - 1); if (slo < 0) slo = 0; int shi = t + L / 2; if (shi > L - 1) shi = L - 1;
                    for (int s = slo; s <= shi; ++s) y += Zb[s] * H[4096 + t + L / 2 - s];
                    const float x2 = conv3_at(r2, t, seglen, cwv[2][0], cwv[2][1], cwv[2][2], cbv[2]);
                    const float o = x2 * (y + Zb[t] * fb1) * silu_f(bf2f(rz[t]));
                    Ub[t] = o; }
                __syncthreads();
                if (do_store) for (int t = tid; t < L; t += 512) UT[(size_t)c * MT + col0 + t] = (bf16_t)f2bf(Ub[t]);
                __syncthreads();
            }
        }
    }
    __syncthreads();
}


typedef float cf __attribute__((ext_vector_type(2)));
__device__ __forceinline__ cf cmul(cf a, cf b) { const cf sw = __builtin_shufflevector(a, a, 1, 0); return a * b.x + sw * cf{-b.y, b.y}; }
__host__ __device__ constexpr float tw32c(int e) { return e == 0 ? 1.f : e == 1 ? 0.98078528040323043f : e == 2 ? 0.92387953251128674f : e == 3 ? 0.83146961230254524f : e == 4 ? 0.70710678118654752f : e == 5 ? 0.55557023301960218f :
    e == 6 ? 0.38268343236508977f : e == 7 ? 0.19509032201612825f : e == 8 ? 0.f : e == 9 ? -0.19509032201612825f : e == 10 ? -0.38268343236508977f : e == 11 ? -0.55557023301960218f : e == 12 ? -0.70710678118654752f :
    e == 13 ? -0.83146961230254524f : e == 14 ? -0.92387953251128674f : -0.98078528040323043f; }
template <int E32> __device__ __forceinline__ cf twmul(cf d) {
    if (E32 == 0) return d;
    if (E32 == 8) return cf{d.y, -d.x};
    constexpr float c = tw32c(E32), sn = tw32c(E32 < 8 ? 8 - E32 : E32 - 8);
    const cf sw = __builtin_shufflevector(d, d, 1, 0);
    return d * c + sw * cf{sn, -sn};
}
template <int R, int HALF, int I> struct DftStage {
    static __device__ __forceinline__ void run(cf (&v)[R]) {
        if constexpr ((I & HALF) == 0) {
            constexpr int E32 = (I % HALF) * (R / (2 * HALF)) * (32 / R);
            const cf a = v[I], b = v[I + HALF];
            v[I] = a + b;
            v[I + HALF] = twmul<E32>(a - b);
        }
        if constexpr (I + 1 < R) DftStage<R, HALF, I + 1>::run(v);
    }
};
template <int R, int HALF> struct DftAll {
    static __device__ __forceinline__ void run(cf (&v)[R]) { DftStage<R, HALF, 0>::run(v); if constexpr (HALF > 1) DftAll<R, HALF / 2>::run(v); }
};
__host__ __device__ constexpr int bitrev_c(int x, int bits) { int r = 0; for (int i = 0; i < bits; ++i) r = (r << 1) | ((x >> i) & 1); return r; }
__device__ __forceinline__ int PADI(int i) { return i + (i >> 4); }
constexpr int FFT_W_ELEMS = 8192 + 512;
template <int R, int I> struct StoreRev {
    static __device__ __forceinline__ void run(LAS cf* Wp, int pstride, const cf (&v)[R]) {
        constexpr int bits = (R == 32) ? 5 : 4;
        Wp[I * pstride] = v[bitrev_c(I, bits)];
        if constexpr (I + 1 < R) StoreRev<R, I + 1>::run(Wp, pstride, v);
    }
};
template <int R, int NS> __device__ __forceinline__ void fft_pass(LAS cf* W, int tid_) {
    int tid = tid_; asm volatile("" : "+v"(tid));
    constexpr int NT = 8192 / R;
    cf v[R];
    const bool act = tid < NT;
    if (act) {
#pragma unroll
        for (int r = 0; r < R; ++r) v[r] = W[PADI(tid) + r * (NT + NT / 16)];
    }
    __syncthreads();
    if (act) {
        const int k = tid % NS;
        if (NS > 1) {
            const float fr_ = -(float)k * (1.f / (float)(NS * R)); const float sn = __builtin_amdgcn_sinf(fr_), cs = __builtin_amdgcn_cosf(fr_);
            const cf w = cf{cs, sn}; cf cur = w;
#pragma unroll
            for (int r = 1; r < R; ++r) { v[r] = cmul(v[r], cur); cur = cmul(cur, w); }
        }
        DftAll<R, R / 2>::run(v);
        const int idx = (tid / NS) * NS * R + k;
        StoreRev<R, 0>::run(W + PADI(idx), NS >= 16 ? NS + NS / 16 : 1, v);
    }
    __syncthreads();
}
__device__ __forceinline__ void fft_pass2(LAS cf* W, int tid_) {
    int tid = tid_; asm volatile("" : "+v"(tid));
#pragma unroll 2
    for (int m = 0; m < 8; ++m) { const int j = tid + 512 * m; const int pj = PADI(j); const cf a = W[pj]; cf b = W[pj + 4352];
        const float fr_ = -(float)j * (1.f / 8192.f); b = cmul(b, cf{__builtin_amdgcn_cosf(fr_), __builtin_amdgcn_sinf(fr_)});
        W[pj] = cf{a.x + b.x, a.y + b.y}; W[pj + 4352] = cf{a.x - b.x, a.y - b.y}; }
    __syncthreads();
}
__device__ __forceinline__ void fft8192(LAS cf* W, int tid) { fft_pass<16, 1>(W, tid); fft_pass<16, 16>(W, tid); fft_pass<16, 256>(W, tid); fft_pass2(W, tid); }

template <int NS> __device__ __forceinline__ void fft4k_pass(LAS cf* Wb, int j_) {
    int j = j_; asm volatile("" : "+v"(j));
    cf v[16];
#pragma unroll
    for (int r = 0; r < 16; ++r) v[r] = Wb[PADI(j) + r * 272];
    __syncthreads();
    const int k = j % NS;
    if (NS > 1) {
        const float fr_ = -(float)k * (1.f / (float)(NS * 16)); const float sn = __builtin_amdgcn_sinf(fr_), cs = __builtin_amdgcn_cosf(fr_);
        const cf w = cf{cs, sn}; cf cur = w;
#pragma unroll
        for (int r = 1; r < 16; ++r) { v[r] = cmul(v[r], cur); cur = cmul(cur, w); }
    }
    DftAll<16, 8>::run(v);
    const int idx = (j / NS) * NS * 16 + k;
    StoreRev<16, 0>::run(Wb + PADI(idx), NS >= 16 ? NS + NS / 16 : 1, v);
    __syncthreads();
}
__device__ __forceinline__ void fft4k_x2(LAS cf* Wb, int j) { fft4k_pass<1>(Wb, j); fft4k_pass<16>(Wb, j); fft4k_pass<256>(Wb, j); }

__device__ __forceinline__ void conv8(const u32x4 rv, int tid, float w0, float w1, float w2, float bias, float (&o)[8]) {
    float x[8];
#pragma unroll
    for (int e = 0; e < 4; ++e) { x[2 * e] = bflo(rv[e]); x[2 * e + 1] = bfhi(rv[e]); }
    float left = __shfl_up(x[7], 1), right = __shfl_down(x[0], 1);
    if ((tid & 7) == 0) left = 0.f;
    if ((tid & 7) == 7) right = 0.f;
#pragma unroll
    for (int e = 0; e < 8; ++e) { const float xm = (e == 0) ? left : x[e - 1], xp = (e == 7) ? right : x[e + 1]; o[e] = w0 * xm + w1 * x[e] + w2 * xp + bias; }
}

__device__ __forceinline__ void hyena_item(const Args& a, int l, unsigned char* lds_, int item, bool do_store) {
    const int tid = opaque_tid();
    const int c = item >> 1, half = item & 1;
    LAS unsigned char* lds = (LAS unsigned char*)lds_;
    LAS cf* W = (LAS cf*)lds;
    LAS cf* He0 = (LAS cf*)(lds + 69632);
    LAS cf* Ho0 = He0 + 2049;
    LAS cf* He1 = Ho0 + 2048;
    LAS cf* Ho1 = He1 + 2049;
    const int sel = tid >> 8, j = tid & 255;
    LAS cf* Wb = W + sel * 4352;
    bf16_t* UT = (bf16_t*)(a.ws + WS_UT);
    const float* FT = (const float*)(a.ws + WS_FT);
    const float* hw = a.in[13] + (size_t)l * 3 * 1536; const float* hb = a.in[14] + (size_t)l * 1536;
    const float fb0 = a.in[21][(l * 2 + 0) * 512 + c], fb1 = a.in[21][(l * 2 + 1) * 512 + c];
    const int pi0 = PADI(tid * 8);
    __syncthreads();
    {
        const f32x4 ha = *(const f32x4*)(FT + (size_t)c * 4096 + tid * 8), hb2 = *(const f32x4*)(FT + (size_t)c * 4096 + tid * 8 + 4);
        const f32x4 ga = *(const f32x4*)(FT + (size_t)(512 + c) * 4096 + tid * 8), gb2 = *(const f32x4*)(FT + (size_t)(512 + c) * 4096 + tid * 8 + 4);
        const float fn0 = FT[(size_t)1024 * 4096 + c], fn1 = FT[(size_t)1024 * 4096 + 512 + c];
#pragma unroll
        for (int e = 0; e < 8; ++e) { const cf f = cf{(e < 4 ? ha[e & 3] : hb2[e & 3]) * fn0, (e < 4 ? ga[e & 3] : gb2[e & 3]) * fn1};
            const float fr_ = -(float)(tid * 8 + e) * (1.f / 8192.f);
            W[pi0 + e] = f; W[4352 + pi0 + e] = cmul(f, cf{__builtin_amdgcn_cosf(fr_), __builtin_amdgcn_sinf(fr_)}); }
        __syncthreads();
        fft4k_x2(Wb, j);
        for (int m = tid; m <= 2048; m += NTHR) { const cf A = W[PADI(m & 4095)], Bm = W[PADI((4096 - m) & 4095)];
            He0[m] = cf{0.5f * (A.x + Bm.x), 0.5f * (A.y - Bm.y)}; He1[m] = cf{0.5f * (A.y + Bm.y), -0.5f * (A.x - Bm.x)}; }
        for (int m = tid; m < 2048; m += NTHR) { const cf A = W[4352 + PADI(m)], Bm = W[4352 + PADI(4095 - m)];
            Ho0[m] = cf{0.5f * (A.x + Bm.x), 0.5f * (A.y - Bm.y)}; Ho1[m] = cf{0.5f * (A.y + Bm.y), -0.5f * (A.x - Bm.x)}; }
        __syncthreads();
    }
    float cwv[3][3], cbv[3];
#pragma unroll
    for (int g = 0; g < 3; ++g) { cbv[g] = hb[g * 512 + c];
#pragma unroll
        for (int t3 = 0; t3 < 3; ++t3) cwv[g][t3] = hw[t3 * 1536 + g * 512 + c]; }
#pragma unroll 1
    for (int bp = half * 2; bp < half * 2 + 2; ++bp) {
        const size_t o0 = (size_t)(2 * bp) * LSEQ + tid * 8, o1 = o0 + LSEQ;
        bf16_t* rv = UT + (size_t)c * MT; const bf16_t* r1 = UT + (size_t)(512 + c) * MT; const bf16_t* r2 = UT + (size_t)(1024 + c) * MT; const bf16_t* rz = UT + (size_t)(1536 + c) * MT;
        const u32x4 qv0 = *(const u32x4*)(rv + o0), qv1 = *(const u32x4*)(rv + o1), qa0 = *(const u32x4*)(r1 + o0), qa1 = *(const u32x4*)(r1 + o1);
        const u32x4 qb0 = *(const u32x4*)(r2 + o0), qb1 = *(const u32x4*)(r2 + o1), qz0 = *(const u32x4*)(rz + o0), qz1 = *(const u32x4*)(rz + o1);
        float z0[8], z1[8];
        conv8(qv0, tid, cwv[0][0], cwv[0][1], cwv[0][2], cbv[0], z0);
        conv8(qv1, tid, cwv[0][0], cwv[0][1], cwv[0][2], cbv[0], z1);
#pragma unroll 1
        for (int ord = 0; ord < 2; ++ord) {
#pragma unroll
            for (int e = 0; e < 8; ++e) { const cf f = cf{z0[e], z1[e]}; const float fr_ = -(float)(tid * 8 + e) * (1.f / 8192.f);
                W[pi0 + e] = f; W[4352 + pi0 + e] = cmul(f, cf{__builtin_amdgcn_cosf(fr_), __builtin_amdgcn_sinf(fr_)}); }
            __syncthreads();
            fft4k_x2(Wb, j);
            {
                LAS const cf* Hs = sel ? (ord ? Ho1 : Ho0) : (ord ? He1 : He0);
                const int top = sel ? 4095 : 4096, lim = sel ? 2047 : 2048;
#pragma unroll 4
                for (int i = 0; i < 16; ++i) { const int m = j + 256 * i; const int pm = PADI(m); const cf zv = Wb[pm];
                    cf hk; if (m <= lim) hk = Hs[m]; else { hk = Hs[top - m]; hk.y = -hk.y; }
                    const cf y = cmul(zv, hk); Wb[pm] = cf{y.x, -y.y}; }
            }
            __syncthreads();
            fft4k_x2(Wb, j);
            float x0[8], x1[8];
            conv8(ord ? qb0 : qa0, tid, cwv[1 + ord][0], cwv[1 + ord][1], cwv[1 + ord][2], cbv[1 + ord], x0);
            conv8(ord ? qb1 : qa1, tid, cwv[1 + ord][0], cwv[1 + ord][1], cwv[1 + ord][2], cbv[1 + ord], x1);
            const float fb = ord ? fb1 : fb0;
            const int pr = PADI((2048 + tid * 8) & 4095);
#pragma unroll
            for (int e = 0; e < 8; ++e) { const float fr_ = -(float)(2048 + tid * 8 + e) * (1.f / 8192.f);
                const cf ev = W[pr + e], ov = cmul(W[4352 + pr + e], cf{__builtin_amdgcn_cosf(fr_), __builtin_amdgcn_sinf(fr_)});
                const float y0 = (ev.x + ov.x) * (1.f / 8192.f), y1 = -(ev.y + ov.y) * (1.f / 8192.f);
                z0[e] = x0[e] * (y0 + z0[e] * fb); z1[e] = x1[e] * (y1 + z1[e] * fb); }
            __syncthreads();
        }
        {
            u32x4 w0, w1;
#pragma unroll
            for (int e = 0; e < 4; ++e) { w0[e] = pg8::cvt_pk_bf16(z0[2 * e] * silu_f(bflo(qz0[e])), z0[2 * e + 1] * silu_f(bfhi(qz0[e])));
                w1[e] = pg8::cvt_pk_bf16(z1[2 * e] * silu_f(bflo(qz1[e])), z1[2 * e + 1] * silu_f(bfhi(qz1[e]))); }
            if (do_store) { *(u32x4*)(rv + o0) = w0; *(u32x4*)(rv + o1) = w1; } }
    }
    __syncthreads();
}

__device__ __forceinline__ void filt_item(const Args& a, int l, unsigned char* lds_, int fi) {
    const int tid = opaque_tid();
    LAS float* w3s = (LAS float*)lds_ + 4096;
    LAS float* red = w3s + 512;
    float* FT = (float*)(a.ws + WS_FT);
    const float* hdn = (const float*)(a.ws + WS_HDN) + (size_t)l * 4096 * 64;
    const float MIN_DECAY = -3.0701134573253946f, MAX_DECAY = -15.350567286626973f;
    __syncthreads();
    w3s[tid] = a.in[20][(size_t)l * 64 * 1024 + (size_t)(tid >> 3) * 1024 + fi * 8 + (tid & 7)];
    __syncthreads();
    float rate[8], ssq[8];
#pragma unroll
    for (int cc = 0; cc < 8; ++cc) { const int ch = (fi * 8 + cc) & 511; rate[cc] = fabsf(MIN_DECAY + (MAX_DECAY - MIN_DECAY) * (float)ch / 511.f); ssq[cc] = 0.f; }
#pragma unroll 1
    for (int it2 = 0; it2 < 2; ++it2) {
        float acc[4][8];
#pragma unroll
        for (int q = 0; q < 4; ++q)
#pragma unroll
            for (int cc = 0; cc < 8; ++cc) acc[q][cc] = 0.f;
        const f32x4* hp = (const f32x4*)(hdn + (size_t)(it2 * 2048 + tid) * 64);
        f32x4 hn[4];
#pragma unroll
        for (int q = 0; q < 4; ++q) hn[q] = hp[(size_t)q * 512 * 16];
#pragma unroll 1
        for (int j4 = 0; j4 < 16; ++j4) {
            f32x4 hv[4];
#pragma unroll
            for (int q = 0; q < 4; ++q) hv[q] = hn[q];
            if (j4 < 15) {
#pragma unroll
                for (int q = 0; q < 4; ++q) hn[q] = hp[(size_t)q * 512 * 16 + j4 + 1]; }
#pragma unroll
            for (int jj = 0; jj < 4; ++jj) { const f32x4 wa = *(const LAS f32x4*)(w3s + (4 * j4 + jj) * 8), wb = *(const LAS f32x4*)(w3s + (4 * j4 + jj) * 8 + 4);
#pragma unroll
                for (int q = 0; q < 4; ++q) { const float h = hv[q][jj];
                    acc[q][0] += h * wa.x; acc[q][1] += h * wa.y; acc[q][2] += h * wa.z; acc[q][3] += h * wa.w; acc[q][4] += h * wb.x; acc[q][5] += h * wb.y; acc[q][6] += h * wb.z; acc[q][7] += h * wb.w; } }
        }
#pragma unroll
        for (int q = 0; q < 4; ++q) { const int t = it2 * 2048 + tid + 512 * q; const float off = fabsf((float)t - 2048.f) * (1.f / 2048.f);
#pragma unroll
            for (int cc = 0; cc < 8; ++cc) { const float v = acc[q][cc] * __expf(-off * rate[cc]); ssq[cc] += v * v; FT[(size_t)(fi * 8 + cc) * 4096 + t] = v; } }
    }
#pragma unroll
    for (int cc = 0; cc < 8; ++cc) { const float sv = wave_sum(ssq[cc]); if ((tid & 63) == 0) red[(tid >> 6) * 8 + cc] = sv; }
    __syncthreads();
    if (tid < 8) { float tsum = 0.f;
#pragma unroll
        for (int w = 0; w < 8; ++w) tsum += red[w * 8 + tid];
        FT[(size_t)1024 * 4096 + fi * 8 + tid] = rsqrtf(tsum + RMS_EPS); }
}

__device__ __forceinline__ float ctx_conv3(LAS const bf16_t* rowp, int t, float w0, float w1, float w2, float bias) {
    return bf2f(rowp[t - 1]) * w0 + bf2f(rowp[t]) * w1 + bf2f(rowp[t + 1]) * w2 + bias;
}
__device__ __forceinline__ void hyena_ctx_item(const Args& a, unsigned char* lds_, int c, bool do_store) {
    const int tid = opaque_tid();
    LAS float* Hc = (LAS float*)lds_;
    LAS float* U = Hc + 512;
    LAS float* Z = U + 2048;
    LAS float* red = Z + 2048;
    LAS float* w3s = red + 16;
    LAS bf16_t* RAW = (LAS bf16_t*)(w3s + 128);
    LAS bf16_t* OUT = RAW + 4 * 8 * 272;
    bf16_t* UT = (bf16_t*)(a.ws + WS_UT);
    const float* hdn = (const float*)(a.ws + WS_HDNC);
    const float* hw = a.in[13]; const float* hb = a.in[14];
    const float MIN_DECAY = -3.0701134573253946f, MAX_DECAY = -15.350567286626973f;
    const int t = tid & 255, bh = tid >> 8;
    {
        const float rate = fabsf(MIN_DECAY + (MAX_DECAY - MIN_DECAY) * (float)c / 511.f);
        const float fb0 = a.in[21][c], fb1 = a.in[21][512 + c];
        __syncthreads();
        if (tid < 128) w3s[tid] = a.in[20][(size_t)(tid & 63) * 1024 + (tid >> 6) * 512 + c];
#pragma unroll
        for (int i = 0; i < 2; ++i) { const int pp = tid + 512 * i, arr = pp >> 8, bb = (pp >> 5) & 7, seg = pp & 31;
            *(LAS u32x4*)(RAW + (arr * 8 + bb) * 272 + 8 + seg * 8) = *(const u32x4*)(UT + (size_t)(arr * 512 + c) * MT + MLAT + (size_t)bb * LCTX + seg * 8); }
        if (tid < 64) RAW[(tid >> 1) * 272 + ((tid & 1) ? 264 : 7)] = (bf16_t)0;
        __syncthreads();
        {
            float sv = 0.f;
            const f32x4* hp = (const f32x4*)(hdn + (size_t)t * 64);
#pragma unroll 4
            for (int j4 = 0; j4 < 16; ++j4) { const f32x4 hv = hp[j4]; sv += hv.x * w3s[bh * 64 + 4 * j4] + hv.y * w3s[bh * 64 + 4 * j4 + 1] + hv.z * w3s[bh * 64 + 4 * j4 + 2] + hv.w * w3s[bh * 64 + 4 * j4 + 3]; }
            sv *= __expf(-fabsf((float)t - 128.f) * (1.f / 128.f) * rate);
            const float ss = wave_sum(sv * sv);
            if ((tid & 63) == 0) red[tid >> 6] = ss;
            __syncthreads();
            const float tot = red[bh * 4] + red[bh * 4 + 1] + red[bh * 4 + 2] + red[bh * 4 + 3];
            Hc[bh * 256 + t] = sv * rsqrtf(tot + RMS_EPS);
        }
        float vv[4];
#pragma unroll
        for (int i = 0; i < 4; ++i) vv[i] = ctx_conv3(RAW + (0 * 8 + bh * 4 + i) * 272 + 8, t, hw[c], hw[1536 + c], hw[3072 + c], hb[c]);
        *(LAS f32x4*)(U + t * 8 + bh * 4) = (f32x4){vv[0], vv[1], vv[2], vv[3]};
        __syncthreads();
        const int slo = (t - 127 > 0) ? t - 127 : 0, shi = (t + 128 < 255) ? t + 128 : 255;
        f32x4 acc = {0.f, 0.f, 0.f, 0.f};
        for (int s2 = slo; s2 <= shi; ++s2) { const float h = Hc[t + 128 - s2]; const f32x4 u = *(const LAS f32x4*)(U + s2 * 8 + bh * 4); acc = acc + u * h; }
        float zz[4];
#pragma unroll
        for (int i = 0; i < 4; ++i) { const float x1 = ctx_conv3(RAW + (1 * 8 + bh * 4 + i) * 272 + 8, t, hw[512 + c], hw[1536 + 512 + c], hw[3072 + 512 + c], hb[512 + c]);
            zz[i] = x1 * (acc[i] + vv[i] * fb0); }
        *(LAS f32x4*)(Z + t * 8 + bh * 4) = (f32x4){zz[0], zz[1], zz[2], zz[3]};
        __syncthreads();
        acc = (f32x4){0.f, 0.f, 0.f, 0.f};
        for (int s2 = slo; s2 <= shi; ++s2) { const float h = Hc[256 + t + 128 - s2]; const f32x4 u = *(const LAS f32x4*)(Z + s2 * 8 + bh * 4); acc = acc + u * h; }
#pragma unroll
        for (int i = 0; i < 4; ++i) { const float x2 = ctx_conv3(RAW + (2 * 8 + bh * 4 + i) * 272 + 8, t, hw[1024 + c], hw[1536 + 1024 + c], hw[3072 + 1024 + c], hb[1024 + c]);
            OUT[(bh * 4 + i) * 256 + t] = (bf16_t)f2bf(x2 * (acc[i] + zz[i] * fb1) * silu_f(bf2f(RAW[(3 * 8 + bh * 4 + i) * 272 + 8 + t]))); }
        __syncthreads();
        if (do_store && tid < 256) *(u32x4*)(UT + (size_t)c * MT + MLAT + (size_t)(tid >> 5) * LCTX + (tid & 31) * 8) = *(LAS const u32x4*)(OUT + (tid >> 5) * 256 + (tid & 31) * 8);
    }
    __syncthreads();
}


__device__ __forceinline__ void phase_mixers(const Args& a, int l, unsigned char* lds, int rep, bool do_mlstm, bool do_hy, bool do_hyctx) {
    LAS unsigned* qslot = (LAS unsigned*)((LAS unsigned char*)lds + (LDS_BYTES - 32));
    if (do_mlstm && (blockIdx.x & 3) == 0 && (blockIdx.x >> 2) < 64) mlstm_item(a, l, lds, blockIdx.x >> 2, rep == 0);
    unsigned* ctr = (unsigned*)(a.ws + WS_CTL) + CW_QUEUE + 64 * (l * 8 + rep);
    const int n_lat = do_hy ? 2 * DHY : 0, n_ctx = (l == 0 && do_hyctx) ? DHY : 0;
    for (;;) {
        __syncthreads();
        if (threadIdx.x == 0) *qslot = __hip_atomic_fetch_add(ctr, 1u, __ATOMIC_RELAXED, __HIP_MEMORY_SCOPE_AGENT);
        __syncthreads();
        const int item = (int)*qslot;
        if (item >= n_lat + n_ctx) break;
        if (item < n_lat) hyena_item(a, l, lds, item, rep == 0);
        else hyena_ctx_item(a, lds, item - n_lat, rep == 0);
    }
    __syncthreads();
}

__device__ __forceinline__ void phase_combine(const Args& a, int l, unsigned char* lds) {
    const int tid = opaque_tid(), G = gridDim.x, lane = tid & 63, wave = tid >> 6;
    const bf16_t* U1 = (const bf16_t*)(a.ws + WS_U1);
    const bf16_t* HDi = (const bf16_t*)(a.ws + WS_HB);
    const bf16_t* UT = (const bf16_t*)(a.ws + WS_UT);
    bf16_t* YM = (bf16_t*)(a.ws + WS_YMIX);
    bf16_t* T = (bf16_t*)lds;
    const int nblk = (l == 0 ? MT : MLAT) / 64;
    float mgv[8];
#pragma unroll
    for (int i = 0; i < 8; ++i) mgv[i] = a.in[12][l * 512 + lane * 8 + i];
    const size_t dstride = (size_t)32 * (LCTX + LSEQ) * 128;
    for (int blk = blockIdx.x; blk < nblk; blk += G) {
        const int r0 = blk * 64;
        __syncthreads();
#pragma unroll
        for (int i = 0; i < 8; ++i) { const int e = tid + i * 512, ch = e >> 3, pc = e & 7;
            *(u32x4*)(T + ch * 72 + ((pc ^ ((ch >> 3) & 7)) * 8)) = *(const u32x4*)(UT + (size_t)ch * MT + r0 + pc * 8); }
        const int cb = r0 >= MLAT ? (r0 - MLAT) >> 8 : r0 >> 12, csr0 = r0 >= MLAT ? (r0 - MLAT) & 255 : LCTX + (r0 & 4095);
        const bf16_t* hbase = HDi + ((size_t)(cb * 4 + (lane >> 4)) * (LCTX + LSEQ) + csr0) * 128 + (lane & 15) * 8;
#pragma unroll 1
        for (int rr = wave; rr < 64; rr += 16) {
            u32x4 hf[2], hb[2], ov[2], zv[2];
#pragma unroll
            for (int q = 0; q < 2; ++q) { const int r1 = rr + 8 * q; const size_t row = r0 + r1;
                hf[q] = *(const u32x4*)(hbase + (size_t)r1 * 128); hb[q] = *(const u32x4*)(hbase + (size_t)r1 * 128 + dstride);
                ov[q] = *(const u32x4*)(U1 + row * LDU1 + 1024 + lane * 8); zv[q] = *(const u32x4*)(U1 + row * LDU1 + 1536 + lane * 8); }
#pragma unroll
            for (int q = 0; q < 2; ++q) { const size_t row = r0 + rr + 8 * q;
                float hg[8]; float ss = 0.f;
#pragma unroll
                for (int i = 0; i < 4; ++i) {
                    hg[2 * i] = (bflo(hf[q][i]) + bflo(hb[q][i])) * sigmoid_f(bflo(ov[q][i]));
                    hg[2 * i + 1] = (bfhi(hf[q][i]) + bfhi(hb[q][i])) * sigmoid_f(bfhi(ov[q][i]));
                    ss += hg[2 * i] * hg[2 * i] + hg[2 * i + 1] * hg[2 * i + 1]; }
                ss += __shfl_xor(ss, 1); ss += __shfl_xor(ss, 2); ss += __shfl_xor(ss, 4); ss += __shfl_xor(ss, 8);
                const float r = rsqrtf(ss * (1.f / 128.f) + RMS_EPS);
                u32x4 o4;
#pragma unroll
                for (int i = 0; i < 4; ++i) o4[i] = pk2(hg[2 * i] * r * mgv[2 * i] * silu_f(bflo(zv[q][i])), hg[2 * i + 1] * r * mgv[2 * i + 1] * silu_f(bfhi(zv[q][i])));
                *(u32x4*)(YM + row * DM + lane * 8) = o4; }
        }
        __syncthreads();
        for (int rr = wave; rr < 64; rr += 8) {
            const int col = (((rr >> 3) ^ (lane & 7)) << 3) | (rr & 7);
            u32x4 o4;
#pragma unroll
            for (int i = 0; i < 4; ++i) o4[i] = (unsigned)T[(lane * 8 + 2 * i) * 72 + col] | ((unsigned)T[(lane * 8 + 2 * i + 1) * 72 + col] << 16);
            *(u32x4*)(YM + (size_t)(r0 + rr) * DM + 512 + lane * 8) = o4;
        }
    }
    __syncthreads();
}


#define XB_TMO      128
#define XB_XCNT(j)  (256  + 64 * (j))
#define XB_XSUB(j)  (1280 + 64 * (j))
#define XB_XGEN(j)  (2304 + 64 * (j))
#define XB_TOP      3328
#define XB_TOPGEN   3392
#define XCD_BAR_WORDS 3456
#define XB_SPIN_CAP (1u << 18)
__device__ __forceinline__ unsigned xb_ld(unsigned* p)              { return __hip_atomic_load(p, __ATOMIC_RELAXED, __HIP_MEMORY_SCOPE_AGENT); }
__device__ __forceinline__ unsigned xb_add(unsigned* p, unsigned v) { return __hip_atomic_fetch_add(p, v, __ATOMIC_RELAXED, __HIP_MEMORY_SCOPE_AGENT); }
__device__ __forceinline__ unsigned xb_xcc_id() { return (unsigned)__builtin_amdgcn_s_getreg((3 << 11) | 20) & 0xFu; }
#define XB_SPIN(cond, bar) do { unsigned _sp = 0; while (cond) { __builtin_amdgcn_s_sleep(1); \
    if ((++_sp & 255u) == 0u) { if (xb_ld(&(bar)[XB_TMO])) break; if (_sp > XB_SPIN_CAP) { atomicAdd(&(bar)[XB_TMO], 1u); break; } } } } while (0)
struct XcdBarrier { unsigned* bar; unsigned x; volatile __attribute__((address_space(3))) unsigned* st; };
__device__ __forceinline__ XcdBarrier xcd_barrier_post(unsigned* bar, volatile __attribute__((address_space(3))) unsigned* st) {
    XcdBarrier b; b.bar = bar; b.x = xb_xcc_id(); b.st = st;
    if (threadIdx.x == 0) (void)xb_add(&bar[XB_XCNT(b.x)], 1u);
    return b;
}
__device__ __forceinline__ void xcd_barrier_complete(unsigned* bar, unsigned x, unsigned& nloc, unsigned& nx) {
    const unsigned G = gridDim.x * gridDim.y * gridDim.z;
    unsigned sum, cnt, mine, sp = 0u;
    for (;;) {
        sum = 0u; cnt = 0u; mine = 0u;
#pragma unroll
        for (unsigned j = 0; j < 16; ++j) { const unsigned c = xb_ld(&bar[XB_XCNT(j)]); sum += c; cnt += (c > 0u) ? 1u : 0u; mine = (j == x) ? c : mine; }
        if (sum == G) break;
        __builtin_amdgcn_s_sleep(1);
        if ((++sp & 255u) == 0u) { if (xb_ld(&bar[XB_TMO])) break; if (sp > XB_SPIN_CAP) { atomicAdd(&bar[XB_TMO], 1u); break; } }
    }
    nloc = mine > 0u ? mine : 1u; nx = cnt > 0u ? cnt : 1u;
}
__device__ __forceinline__ void xcd_barrier(const XcdBarrier& b) {
    asm volatile("s_waitcnt vmcnt(0)" ::: "memory");
    __syncthreads();
    if (threadIdx.x == 0) {
        unsigned* bar = b.bar;
        __builtin_amdgcn_s_waitcnt(0);
        unsigned nloc = b.st[0], nx = b.st[1];
        if (nloc == 0u) { xcd_barrier_complete(bar, b.x, nloc, nx); b.st[0] = nloc; b.st[1] = nx; }
        const unsigned old = xb_add(&bar[XB_XSUB(b.x)], 1u);
        const unsigned gen = old / nloc;
        if (old + 1u == (gen + 1u) * nloc) {
            __builtin_amdgcn_fence(__ATOMIC_RELEASE, "agent");
            asm volatile("s_waitcnt vmcnt(0)" ::: "memory");
            const unsigned og = xb_add(&bar[XB_TOP], 1u);
            const unsigned tg = og / nx;
            if (og + 1u == (tg + 1u) * nx) xb_add(&bar[XB_TOPGEN], 1u);
            else XB_SPIN(xb_ld(&bar[XB_TOPGEN]) == tg, bar);
            __builtin_amdgcn_fence(__ATOMIC_ACQUIRE, "agent");
            xb_add(&bar[XB_XGEN(b.x)], 1u);
            asm volatile("s_waitcnt vmcnt(0)" ::: "memory");
        } else {
            XB_SPIN(xb_ld(&bar[XB_XGEN(b.x)]) == gen, bar);
            __builtin_amdgcn_fence(__ATOMIC_ACQUIRE, "agent");
            asm volatile("s_waitcnt vmcnt(0)" ::: "memory");
        }
    }
    __syncthreads();
}

__global__ void __launch_bounds__(NTHR, 2) fwd(Args a_) {
    extern __shared__ __attribute__((aligned(16))) unsigned char lds[];
    cg::grid_group grid = cg::this_grid();
    const int lo = a_.ph_lo, hi = a_.ph_hi; const int rp_phase = a_.rep_phase, rp_count = a_.rep_count & 255;
#define IN(k) (lo <= (k) && (k) < hi)
    volatile __attribute__((address_space(3))) unsigned* bst = (volatile __attribute__((address_space(3))) unsigned*)((__attribute__((address_space(3))) unsigned char*)lds + (LDS_BYTES - 64));
    if (threadIdx.x < 2) bst[threadIdx.x] = 0u;
    __syncthreads();
    const XcdBarrier xbar = xcd_barrier_post((unsigned*)(a_.ws + WS_CTL), bst);
    if (lo < 0) grid.sync();
#define SEAM(k) do { if (IN(k) && IN((k) + 1)) xcd_barrier(xbar); } while (0)
    if (IN(0)) _Pragma("unroll 1") for (int rep = 0, nrep = (rp_phase == 0) ? rp_count : 1; rep < nrep; ++rep) phase_prep(kargs(), lds);
    SEAM(0);
    if (IN(1)) _Pragma("unroll 1") for (int rep = 0, nrep = (rp_phase == 1) ? rp_count : 1; rep < nrep; ++rep) phase_norm(kargs(), 0, false, true, lds);
    SEAM(1);
    for (int l = 0; l < DEPTH; ++l) {
        const int p = 2 + 6 * l;
        if (IN(p)) {
            unsigned char* ws = kargs().ws;
            const bf16_t* HB = (const bf16_t*)(ws + WS_HB);
            const bf16_t* WinT = (const bf16_t*)(ws + WS_WINT) + (size_t)l * NPK * DM;
#if NAIVE_GEMM
            gemm_naive(HB, WinT, MT, NU1, DM, ws + WS_U1, NU1, 0, lds);
            gemm_naive(HB, WinT + (size_t)NU1 * DM, MT, NU2, DM, ws + WS_UT, MT, 1, lds);
#else
            DecIn d{(const char*)HB, (const char*)WinT, (char*)(ws + WS_U1), (char*)(ws + WS_UT)};
            pg8::GridOrder<DecIn> S; S.init(MT / 256, NPK / 256, gridDim.x, blockIdx.x, d);
            _Pragma("unroll 1") for (int rep = 0, nrep = (rp_phase == 2) ? rp_count : 1; rep < nrep; ++rep) pg8::gemm_phase<true>((PG8_LAS unsigned char*)lds, DM, S);
#endif
        }
        SEAM(p);
        if (IN(p + 1)) _Pragma("unroll 1") for (int rep = 0, nrep = (rp_phase == 9) ? rp_count : 1; rep < nrep; ++rep) phase_mprep(kargs(), l, lds, rep);
        SEAM(p + 1);
        if (IN(p + 2)) {
            const int nrep = (rp_phase == 3 || rp_phase == 4 || rp_phase == 5 || rp_phase == 11) ? rp_count : 1;
            _Pragma("unroll 1") for (int rep = 0; rep < nrep; ++rep)
                phase_mixers(kargs(), l, lds, rep, rep == 0 || rp_phase == 3 || rp_phase == 11, rep == 0 || rp_phase == 4 || rp_phase == 11, rep == 0 || rp_phase == 5 || rp_phase == 11);
        }
        SEAM(p + 2);
        if (IN(p + 3)) _Pragma("unroll 1") for (int rep = 0, nrep = (rp_phase == 6) ? rp_count : 1; rep < nrep; ++rep) phase_combine(kargs(), l, lds);
        SEAM(p + 3);
        if (IN(p + 4)) {
            unsigned char* ws = kargs().ws;
            const bf16_t* WoutT = (const bf16_t*)(ws + WS_WOUTT) + (size_t)l * DM * DM;
#if NAIVE_GEMM
            gemm_naive((const bf16_t*)(ws + WS_YMIX), WoutT, (l == 0) ? MT : MLAT, DM, DM, ws + WS_U1, DM, 2, lds);
#else
            DecOut d{(const char*)(ws + WS_YMIX), (const char*)WoutT, (char*)(ws + WS_U1)};
            pg8::GridOrder<DecOut> S; S.init(((l == 0) ? MT : MLAT) / 256, DM / 256, gridDim.x, blockIdx.x, d);
            _Pragma("unroll 1") for (int rep = 0, nrep = (rp_phase == 7) ? rp_count : 1; rep < nrep; ++rep) pg8::gemm_phase<true>((PG8_LAS unsigned char*)lds, DM, S);
#endif
        }
        SEAM(p + 4);
        if (IN(p + 5)) _Pragma("unroll 1") for (int rep = 0, nrep = (rp_phase == 8 && l == 0) ? rp_count : 1; rep < nrep; ++rep) phase_norm(kargs(), l + 1, true, l + 1 < DEPTH, lds);
        SEAM(p + 5);
    }
    if (rp_phase == 10) for (int rep = 0; rep < rp_count; ++rep) xcd_barrier(xbar);
#undef IN
#undef SEAM
}

constexpr int NPHASES = 2 + 6 * DEPTH;

extern "C" void kernel_launch(void* const* d_in, const int* in_sizes, int n_in, void* d_out, int out_size, void* d_ws, size_t ws_size, hipStream_t stream) {
    static int grid = 0;
    if (grid == 0) {
        if (n_in != 23 || out_size != MLAT * DM || ws_size < WS_END) { fprintf(stderr, "kernel_launch: unexpected shapes n_in %d out %d ws %zu\n", n_in, out_size, ws_size); grid = -1; return; }
        int dev = 0, cus = 0, per_cu = 0;
        (void)hipGetDevice(&dev);
        (void)hipDeviceGetAttribute(&cus, hipDeviceAttributeMultiprocessorCount, dev);
        (void)hipFuncSetAttribute((const void*)fwd, hipFuncAttributeMaxDynamicSharedMemorySize, LDS_BYTES);
        (void)hipOccupancyMaxActiveBlocksPerMultiprocessor(&per_cu, (const void*)fwd, NTHR, LDS_BYTES);
        if (per_cu < 1) per_cu = 1;
        grid = cus * per_cu;
        fprintf(stderr, "kernel_launch: cus %d per_cu %d grid %d ws %zu\n", cus, per_cu, grid, ws_size);
    }
    if (grid < 0) return;
    Args a{};
    for (int i = 0; i < 23; ++i) a.in[i] = (const float*)d_in[i];
    a.out = (float*)d_out; a.ws = (unsigned char*)d_ws;
    (void)hipMemsetAsync((char*)d_ws + WS_CTL, 0, 32768, stream);
    a.ph_lo = 0; a.ph_hi = NPHASES; a.rep_phase = PROBE_PHASE; a.rep_count = PROBE_COUNT;
    void* kargs[] = {&a};
    hipError_t e = hipLaunchCooperativeKernel((const void*)fwd, dim3(grid), dim3(NTHR), kargs, LDS_BYTES, stream);
    if (e != hipSuccess) fprintf(stderr, "kernel_launch: cooperative launch failed: %s (grid %d)\n", hipGetErrorString(e), grid);
}
```

```cpp
#include <hip/hip_runtime.h>
#include <hip/hip_cooperative_groups.h>
#include <cstdio>
#include <cstdint>
namespace cg = cooperative_groups;

constexpr int NB = 8, LSEQ = 4096, DM = 1024, LCTX = 256, DEPTH = 2;
constexpr int MLAT = NB * LSEQ, MCTX = NB * LCTX, MT = MLAT + MCTX;
constexpr int DIN = 4624, NU1 = 2560, NU2 = 2048, NPK = NU1 + NU2;
constexpr int QK8_STRIDE = (LCTX + LSEQ) * 256 + 8192;
constexpr int LDU1 = 2048;
constexpr int NH = 4, HD = 128, DML = 512, DHY = 512;
constexpr float RMS_EPS = 1e-6f;
constexpr int NTHR = 512;
constexpr int LDS_BYTES = 147456;
#ifndef PROBE_PHASE
#define PROBE_PHASE -1
#endif
#ifndef PROBE_COUNT
#define PROBE_COUNT 1
#endif
#ifndef REP_PREP
#define REP_PREP 1
#endif
#ifndef REP_NORM
#define REP_NORM 1
#endif
#ifndef REP_GEMM1
#define REP_GEMM1 1
#endif
#ifndef REP_MLSTM
#define REP_MLSTM 1
#endif
#ifndef REP_HYENA
#define REP_HYENA 1
#endif
#ifndef REP_HYCTX
#define REP_HYCTX 1
#endif
#ifndef REP_COMB
#define REP_COMB 1
#endif
#ifndef REP_GEMM2
#define REP_GEMM2 1
#endif
#ifndef NAIVE_MLSTM
#define NAIVE_MLSTM 0
#endif
#ifndef NAIVE_HYENA
#define NAIVE_HYENA 0
#endif
#ifndef NAIVE_GEMM
#define NAIVE_GEMM 0
#endif

constexpr size_t MiB = 1u << 20;
constexpr size_t WS_CTL = 0;
constexpr size_t WS_MOD = 1 * MiB;
constexpr size_t WS_HDN = 2 * MiB;
constexpr size_t WS_HDNC = 4 * MiB;
constexpr size_t WS_GATES = 5 * MiB;
constexpr size_t WS_WGT = 512 * 1024;
constexpr size_t WS_GP = 4 * MiB + 256 * 1024;
constexpr size_t WS_XC1 = 8 * MiB;
constexpr size_t WS_WINT = 16 * MiB;
constexpr size_t WS_WOUTT = 34 * MiB;
constexpr size_t WS_HB = 40 * MiB;
constexpr size_t WS_U1 = 108 * MiB;
constexpr size_t WS_V2 = 244 * MiB;
constexpr size_t WS_UT = 280 * MiB;
constexpr size_t WS_YMIX = 416 * MiB;
constexpr size_t WS_FT = 485 * MiB;
constexpr size_t WS_END = 502 * MiB;

constexpr int CW_QUEUE = 4096;

typedef unsigned short bf16_t;
typedef float f32x4 __attribute__((ext_vector_type(4)));
typedef float f32x2 __attribute__((ext_vector_type(2)));
typedef unsigned u32x4 __attribute__((ext_vector_type(4)));
typedef unsigned u32x2 __attribute__((ext_vector_type(2)));

struct Args {
    const float* in[23];
    float* out;
    unsigned char* ws;
    int ph_lo, ph_hi;
    int rep_phase, rep_count;
};

__device__ __forceinline__ float bf2f(unsigned b) { return __uint_as_float(b << 16); }
__device__ __forceinline__ unsigned f2bf(float f) { unsigned u = __float_as_uint(f); return (u + 0x7fffu + ((u >> 16) & 1u)) >> 16; }
__device__ __forceinline__ unsigned pk2(float lo, float hi) { return f2bf(lo) | (f2bf(hi) << 16); }
__device__ __forceinline__ float bflo(unsigned x) { return __uint_as_float(x << 16); }
__device__ __forceinline__ float bfhi(unsigned x) { return __uint_as_float(x & 0xffff0000u); }
__device__ __forceinline__ float silu_f(float x) { return x * __builtin_amdgcn_rcpf(1.f + __expf(-x)); }
__device__ __forceinline__ float sigmoid_f(float x) { return __builtin_amdgcn_rcpf(1.f + __expf(-x)); }
typedef const Args __attribute__((address_space(4)))* KArgsP;
__device__ __forceinline__ Args kargs() {
    int z = 0; asm volatile("" : "+s"(z));
    KArgsP p = (KArgsP)((const char __attribute__((address_space(4)))*)__builtin_amdgcn_kernarg_segment_ptr() + z);
    Args a;
#pragma unroll
    for (int i = 0; i < 23; ++i) a.in[i] = p->in[i];
    a.out = p->out; a.ws = p->ws; a.ph_lo = p->ph_lo; a.ph_hi = p->ph_hi; a.rep_phase = p->rep_phase; a.rep_count = p->rep_count;
    return a;
}
__device__ __forceinline__ int opaque_tid() { int t = threadIdx.x; asm volatile("" : "+v"(t)); return t; }
__device__ __forceinline__ float wave_sum(float v) {
#pragma unroll
    for (int o = 1; o < 64; o <<= 1) v += __shfl_xor(v, o);
    return v;
}

__device__ __forceinline__ void phase_prep(const Args& a, unsigned char* lds) {
    const int tid = opaque_tid(), G = gridDim.x;
    float* scr = (float*)lds;
    constexpr int IT_WIN = 2 * 16 * 72, IT_WOUT = 2 * 16 * 16, IT_MOD = 2 * 48, IT_HDN = 132, IT_WG = 2;
    constexpr int NIT = IT_WIN + IT_WOUT + IT_MOD + IT_HDN + IT_WG;
    bool s_loaded = false;
    for (int it = blockIdx.x; it < NIT; it += G) {
        int r = it;
        if (r < IT_WIN + IT_WOUT) {
            const float* W; bf16_t* WT; int N, kb, nb, srccol;
            if (r < IT_WIN) { const int l = r / (16 * 72); r %= 16 * 72; kb = r / 72; nb = r % 72; N = DIN;
                W = a.in[8] + (size_t)l * DM * DIN; WT = (bf16_t*)(a.ws + WS_WINT) + (size_t)l * NPK * DM; srccol = nb * 64 + (nb >= 40 ? 16 : 0); }
            else { r -= IT_WIN; const int l = r / 256; r %= 256; kb = r / 16; nb = r % 16; N = DM;
                W = a.in[22] + (size_t)l * DM * DM; WT = (bf16_t*)(a.ws + WS_WOUTT) + (size_t)l * DM * DM; srccol = nb * 64; }
            __syncthreads();
#pragma unroll
            for (int i = 0; i < 8; ++i) { const int e = tid + i * 512, kk = e >> 6, nn = e & 63; scr[kk * 65 + nn] = W[(size_t)(kb * 64 + kk) * N + srccol + nn]; }
            __syncthreads();
            { const int nn = tid >> 3, k8 = (tid & 7) * 8; u32x4 o;
              o.x = pk2(scr[(k8 + 0) * 65 + nn], scr[(k8 + 1) * 65 + nn]); o.y = pk2(scr[(k8 + 2) * 65 + nn], scr[(k8 + 3) * 65 + nn]);
              o.z = pk2(scr[(k8 + 4) * 65 + nn], scr[(k8 + 5) * 65 + nn]); o.w = pk2(scr[(k8 + 6) * 65 + nn], scr[(k8 + 7) * 65 + nn]);
              *(u32x4*)(WT + (size_t)(nb * 64 + nn) * DM + kb * 64 + k8) = o; }
            continue;
        }
        r -= IT_WIN + IT_WOUT;
        if (r < IT_MOD) {
            const int l = r / 48, cb = r % 48;
            float* S = scr + 8192;
            float* P = scr;
            __syncthreads();
            if (!s_loaded) {
                for (int i = tid; i < 9 * 1024; i += 512) { const int v = i >> 10, k = i & 1023; const float cv = (v < 8) ? a.in[1][v * 1024 + k] : a.in[3][k]; S[i] = silu_f(cv); }
                s_loaded = true;
            }
            __syncthreads();
            const int kg = tid >> 6, col = cb * 64 + (tid & 63);
            const float* W = a.in[4] + (size_t)l * DM * 3072;
            float acc[9];
#pragma unroll
            for (int v = 0; v < 9; ++v) acc[v] = 0.f;
            for (int k = kg * 128; k < kg * 128 + 128; ++k) { const float w = W[(size_t)k * 3072 + col];
#pragma unroll
                for (int v = 0; v < 9; ++v) acc[v] += S[v * 1024 + k] * w; }
#pragma unroll
            for (int v = 0; v < 9; ++v) P[(kg * 9 + v) * 64 + (tid & 63)] = acc[v];
            __syncthreads();
            for (int i = tid; i < 9 * 64; i += 512) { const int v = i >> 6, cc = i & 63; float s = a.in[5][l * 3072 + cb * 64 + cc];
#pragma unroll
                for (int g = 0; g < 8; ++g) s += P[(g * 9 + v) * 64 + cc];
                ((float*)(a.ws + WS_MOD))[(size_t)(l * 9 + v) * 3072 + cb * 64 + cc] = s; }
            continue;
        }
        r -= IT_MOD;
        if (r >= IT_HDN) {
            const int l = r - IT_HDN; const float* w = a.in[8] + (size_t)l * DM * DIN; bf16_t* wg = (bf16_t*)(a.ws + WS_WGT) + (size_t)l * 16 * 1024;
            for (int i = tid; i < 16384; i += 512) wg[(i & 15) * 1024 + (i >> 4)] = (bf16_t)f2bf(w[(size_t)(i >> 4) * DIN + 2560 + (i & 15)]);
            continue;
        }
        {
            __syncthreads();
            float* W1 = scr;
            float* W2 = scr + 17 * 64;
            float* B1 = W2 + 64 * 64; float* B2 = B1 + 64; float* F0 = B2 + 64; float* F1 = F0 + 64;
            float* FT = F1 + 64;
            float* H1 = FT + 8 * 17;
            const int lb = ((r * 64) < 8192) ? ((r * 64) >> 12) : 0;
            for (int i = tid; i < 17 * 64; i += 512) W1[i] = a.in[15][lb * 17 * 64 + i];
            for (int i = tid; i < 64 * 64; i += 512) W2[i] = a.in[18][lb * 64 * 64 + i];
            if (tid < 64) { B1[tid] = a.in[16][lb * 64 + tid]; B2[tid] = a.in[19][lb * 64 + tid]; F0[tid] = a.in[17][lb * 128 + tid]; F1[tid] = a.in[17][lb * 128 + 64 + tid]; }
            const int j = tid & 63, pg = tid >> 6;
            for (int sub = 0; sub < 8; ++sub) {
                const int p = r * 64 + sub * 8 + pg;
                const int L = (p < 8192) ? 4096 : 256; const int pos = (p < 8192) ? (p & 4095) : (p - 8192);
                __syncthreads();
                if (j < 17) { float f;
                    if (j == 0) f = (float)pos / (float)L;
                    else { const int bnd = (j <= 8) ? j : j - 8; const float ang = (6.283185307179586f / (float)L) * (float)pos * (float)bnd; f = (j <= 8) ? sinf(ang) : cosf(ang); }
                    FT[pg * 17 + j] = f; }
                __syncthreads();
                { float s = B1[j];
#pragma unroll
                  for (int f = 0; f < 17; ++f) s += FT[pg * 17 + f] * W1[f * 64 + j];
                  H1[pg * 64 + j] = sinf(F0[j] * s); }
                __syncthreads();
                { float s = B2[j];
#pragma unroll 8
                  for (int i = 0; i < 64; ++i) s += H1[pg * 64 + i] * W2[i * 64 + j];
                  float* dst = (p < 8192) ? (float*)(a.ws + WS_HDN) + (size_t)p * 64 : (float*)(a.ws + WS_HDNC) + (size_t)pos * 64;
                  dst[j] = sinf(F1[j] * s); }
            }
        }
    }
    __syncthreads();
}

__device__ __forceinline__ void phase_norm(const Args& a, int l, bool has_prev, bool do_next, unsigned char* lds) {
    const int tid = opaque_tid(), G = gridDim.x, lane = tid & 63, wave = tid >> 6;
    const float* MOD = (const float*)(a.ws + WS_MOD);
    const bf16_t* Y = (const bf16_t*)(a.ws + WS_U1);
    bf16_t* HB = (bf16_t*)(a.ws + WS_HB);
    float* XC1 = (float*)(a.ws + WS_XC1);
    const int nrows = do_next ? MT : MLAT;
    const bool from_out = !(l == 0 || (has_prev && l == 1));
    const float* xlat = from_out ? (const float*)a.out : a.in[0]; const float* xctx = a.in[2];
#define XSRC(row) (((row) >= MLAT) ? xctx + (size_t)((row) - MLAT) * DM : xlat + (size_t)(row) * DM)
    const int stride = G * 8;
    f32x4 nx[2][4]; u32x2 ny[2][4];
    int row = blockIdx.x * 8 + wave;
#pragma unroll
    for (int q = 0; q < 2; ++q) { const int rq = row + q * stride;
        if (rq < nrows) {
#pragma unroll
            for (int j = 0; j < 4; ++j) { nx[q][j] = ((const f32x4*)XSRC(rq))[lane + 64 * j]; ny[q][j] = has_prev ? ((const u32x2*)(Y + (size_t)rq * DM))[lane + 64 * j] : (u32x2){0u, 0u}; }
        } else {
#pragma unroll
            for (int j = 0; j < 4; ++j) { nx[q][j] = (f32x4){0.f, 0.f, 0.f, 0.f}; ny[q][j] = (u32x2){0u, 0u}; } } }
    for (; row < nrows; row += 2 * stride) {
        f32x4 xq[2][4]; u32x2 yq[2][4];
#pragma unroll
        for (int q = 0; q < 2; ++q)
#pragma unroll
            for (int j = 0; j < 4; ++j) { xq[q][j] = nx[q][j]; yq[q][j] = ny[q][j]; }
#pragma unroll
        for (int q = 0; q < 2; ++q) { const int rq = row + (2 + q) * stride;
            if (rq < nrows) {
#pragma unroll
                for (int j = 0; j < 4; ++j) { nx[q][j] = ((const f32x4*)XSRC(rq))[lane + 64 * j]; ny[q][j] = has_prev ? ((const u32x2*)(Y + (size_t)rq * DM))[lane + 64 * j] : (u32x2){0u, 0u}; } } }
#pragma unroll
        for (int q = 0; q < 2; ++q) {
            const int rw = row + q * stride;
            if (rw < nrows) {
                const bool is_ctx = rw >= MLAT; const int mv = is_ctx ? 8 : (rw >> 12);
                float* xout = is_ctx ? XC1 + (size_t)(rw - MLAT) * DM : a.out + (size_t)rw * DM;
                f32x4 xv[4];
#pragma unroll
                for (int j = 0; j < 4; ++j) xv[j] = xq[q][j];
                if (has_prev) {
                    const int lp = l - 1;
                    f32x4 yv[4]; float ss = 0.f;
#pragma unroll
                    for (int j = 0; j < 4; ++j) { yv[j] = (f32x4){bflo(yq[q][j].x), bfhi(yq[q][j].x), bflo(yq[q][j].y), bfhi(yq[q][j].y)}; ss += yv[j].x * yv[j].x + yv[j].y * yv[j].y + yv[j].z * yv[j].z + yv[j].w * yv[j].w; }
                    const float r = rsqrtf(wave_sum(ss) * (1.f / DM) + RMS_EPS);
#pragma unroll
                    for (int j = 0; j < 4; ++j) { const f32x4 gt = ((const f32x4*)(MOD + (size_t)(lp * 9 + mv) * 3072 + 2048))[lane + 64 * j]; const f32x4 pg = ((const f32x4*)(a.in[7] + lp * DM))[lane + 64 * j];
                        xv[j] = xv[j] + gt * (yv[j] * r * pg); ((f32x4*)xout)[lane + 64 * j] = xv[j]; }
                }
                if (do_next) {
                    float ss = 0.f;
#pragma unroll
                    for (int j = 0; j < 4; ++j) ss += xv[j].x * xv[j].x + xv[j].y * xv[j].y + xv[j].z * xv[j].z + xv[j].w * xv[j].w;
                    const float r = rsqrtf(wave_sum(ss) * (1.f / DM) + RMS_EPS);
#pragma unroll
                    for (int j = 0; j < 4; ++j) {
                        const f32x4 pg = ((const f32x4*)(a.in[6] + l * DM))[lane + 64 * j];
                        const f32x4 sh = ((const f32x4*)(MOD + (size_t)(l * 9 + mv) * 3072))[lane + 64 * j];
                        const f32x4 sc = ((const f32x4*)(MOD + (size_t)(l * 9 + mv) * 3072 + 1024))[lane + 64 * j];
                        const f32x4 h = xv[j] * r * pg * (sc + 1.f) + sh;
                        u32x2 o; o.x = pk2(h.x, h.y); o.y = pk2(h.z, h.w);
                        ((u32x2*)(HB + (size_t)rw * DM))[lane + 64 * j] = o;
                    }
                }
            }
        }
    }
#undef XSRC
    __syncthreads();
}

__device__ __forceinline__ void gemm_naive(const bf16_t* A, const bf16_t* Bt, int M, int N, int K, void* out, int ldo, int mode, unsigned char* lds) {
    const int tid = opaque_tid(), G = gridDim.x;
    float* As = (float*)lds;
    float* Bs = As + 64 * 33;
    const int ntm = M / 64, ntn = N / 64;
    const int ty = tid >> 4, tx = tid & 15;
    for (int t = blockIdx.x; t < ntm * ntn; t += G) {
        const int tm = t / ntn, tn = t % ntn;
        float acc[2][4] = {};
        for (int k0 = 0; k0 < K; k0 += 32) {
            __syncthreads();
            { const int r = tid >> 3, c4 = (tid & 7) * 4;
              const u32x2 va = *(const u32x2*)(A + (size_t)(tm * 64 + r) * K + k0 + c4);
              As[r * 33 + c4] = bf2f(va.x & 0xffff); As[r * 33 + c4 + 1] = bf2f(va.x >> 16); As[r * 33 + c4 + 2] = bf2f(va.y & 0xffff); As[r * 33 + c4 + 3] = bf2f(va.y >> 16);
              const u32x2 vb = *(const u32x2*)(Bt + (size_t)(tn * 64 + r) * K + k0 + c4);
              Bs[r * 33 + c4] = bf2f(vb.x & 0xffff); Bs[r * 33 + c4 + 1] = bf2f(vb.x >> 16); Bs[r * 33 + c4 + 2] = bf2f(vb.y & 0xffff); Bs[r * 33 + c4 + 3] = bf2f(vb.y >> 16); }
            __syncthreads();
#pragma unroll 8
            for (int kk = 0; kk < 32; ++kk) {
                const float a0 = As[(ty * 2) * 33 + kk], a1 = As[(ty * 2 + 1) * 33 + kk];
#pragma unroll
                for (int j = 0; j < 4; ++j) { const float b = Bs[(tx * 4 + j) * 33 + kk]; acc[0][j] += a0 * b; acc[1][j] += a1 * b; }
            }
        }
#pragma unroll
        for (int i = 0; i < 2; ++i)
#pragma unroll
            for (int j = 0; j < 4; ++j) { const size_t r = tm * 64 + ty * 2 + i, c = tn * 64 + tx * 4 + j;
                if (mode == 0) ((bf16_t*)out)[r * ldo + c] = (bf16_t)f2bf(acc[i][j]);
                else if (mode == 1) ((bf16_t*)out)[c * ldo + r] = (bf16_t)f2bf(acc[i][j]);
                else ((float*)out)[r * ldo + c] = acc[i][j]; }
    }
    __syncthreads();
}


namespace pg8 {
#define PG8_LAS __attribute__((address_space(3)))
typedef short bf16x8 __attribute__((ext_vector_type(8)));
constexpr int BM = 256, BK = 64, HALF = 128, HTB = HALF * BK * 2, STAGE_BYTES = 8 * HTB, NXCD = 8, WGM = 8;
__device__ __forceinline__ int lds_byte(int r, int c) { const int st = (r >> 4) * 2 + (c >> 5), rr = r & 15, cc = c & 31, ob = rr * 64 + cc * 2; return st * 1024 + (ob ^ (((ob >> 9) & 1) << 5)); }
__device__ __forceinline__ void stage_rc(int b, int& R, int& C) { const int st = b / 1024, sb = b % 1024, swz = sb ^ (((sb >> 9) & 1) << 5); R = (st >> 1) * 16 + swz / 64; C = (st & 1) * 32 + (swz % 64) / 2; }
__device__ __forceinline__ int perm32(int rho) { const int n = rho >> 4, i = rho & 15; return 8 * (i >> 2) + 4 * n + (i & 3); }
__device__ __forceinline__ unsigned cvt_pk_bf16(float lo, float hi) { unsigned r; asm volatile("v_cvt_pk_bf16_f32 %0, %1, %2" : "=v"(r) : "v"(lo), "v"(hi)); return r; }

struct Unit { const char* A; const char* B; char* out; int ldo, r0, c0, bjs; };

template <class Dec> struct GridOrder {
    int nM, nN, nwg, G, c; Dec dec;
    __device__ void init(int nM_, int nN_, int G_, int c_, const Dec& d) { nM = nM_; nN = nN_; nwg = nM * nN; G = G_; c = c_; dec = d; }
    __device__ bool next(int i, Unit& u) const {
        const long L = (long)i * G + c; if (L >= nwg) return false;
        int wgid = (int)L; { const int q = nwg / NXCD, r = nwg % NXCD, xcd = wgid % NXCD, off = wgid / NXCD; wgid = (xcd < r ? xcd * (q + 1) : r * (q + 1) + (xcd - r) * q) + off; }
        const int nig = WGM * nN, gid = wgid / nig, fm = gid * WGM, gsz = (nM - fm) < WGM ? (nM - fm) : WGM;
        const int pm = fm + ((wgid % nig) % gsz), pn = (wgid % nig) / gsz; dec(pm, pn, u); return true;
    }
};

template <bool PERM, class Sched>
__device__ __forceinline__ void gemm_phase(PG8_LAS unsigned char* lds, const int K, const Sched& S) {
    const int tid = opaque_tid(), wid = __builtin_amdgcn_readfirstlane(tid >> 6), lane = tid & 63, wr = wid >> 2, wc = wid & 3, fr = lane & 15, fq = lane >> 4;
    const int nt = K / BK;
    unsigned voffA[2], voffB[2];
#pragma unroll
    for (int i = 0; i < 2; ++i) { int R, C; stage_rc(tid * 16 + i * 8192, R, C); const int Rb = PERM ? ((R & ~31) + perm32(R & 31)) : R;
        voffA[i] = (unsigned)(R * K + C) * 2u; voffB[i] = (unsigned)(Rb * K + C) * 2u; }
    const size_t kstep = (size_t)(BK * 2);
    const size_t hstep = (size_t)HALF * K * 2;
    const unsigned ldsw = (unsigned)wid * 1024u;
    const int aoff = lds_byte(wr * 64 + fr, fq * 8), boff = lds_byte(wc * 32 + fr, fq * 8);
#define PG8_SA(b, h) (((b) * 2 + (h)) * HTB)
#define PG8_SB(b, h) ((4 + (b) * 2 + (h)) * HTB)
#define PG8_STAGE(bufoff, gbase, voff) do { _Pragma("unroll") for (int _i = 0; _i < 2; ++_i) \
        __builtin_amdgcn_global_load_lds((const unsigned*)((const char*)(gbase) + (voff)[_i]), (PG8_LAS unsigned*)(lds + (bufoff) + ldsw + _i * 8192), 16, 0, 0); } while (0)
#define PG8_LDA(dst, b, h) do { _Pragma("unroll") for (int m = 0; m < 4; ++m) _Pragma("unroll") for (int k = 0; k < 2; ++k) dst[m][k] = *(const PG8_LAS bf16x8*)(lds + PG8_SA(b, h) + aoff + m * 2048 + k * 1024); } while (0)
#define PG8_LDB(dst, b, h) do { _Pragma("unroll") for (int n = 0; n < 2; ++n) _Pragma("unroll") for (int k = 0; k < 2; ++k) dst[n][k] = *(const PG8_LAS bf16x8*)(lds + PG8_SB(b, h) + boff + n * 2048 + k * 1024); } while (0)
#define PG8_MMA(ai, bj, At, Bt) do { __builtin_amdgcn_s_setprio(1); _Pragma("unroll") for (int m = 0; m < 4; ++m) _Pragma("unroll") for (int n = 0; n < 2; ++n) _Pragma("unroll") for (int k = 0; k < 2; ++k) \
        acc[ai][bj][m][n] = __builtin_amdgcn_mfma_f32_16x16x32_bf16(Bt[n][k], At[m][k], acc[ai][bj][m][n], 0, 0, 0); __builtin_amdgcn_s_setprio(0); } while (0)
#define PG8_WAIT_V(n) asm volatile("s_waitcnt vmcnt(" #n ")" ::: "memory")
#define PG8_WAIT_L(n) asm volatile("s_waitcnt lgkmcnt(" #n ")" ::: "memory")
#define PG8_BAR __builtin_amdgcn_s_barrier()
#define PG8_SCHED __builtin_amdgcn_sched_barrier(0)
    Unit cur, nxt; int ui = 0;
    if (!S.next(0, cur)) return;
    f32x4 acc[2][2][4][2];
#pragma unroll
    for (int a = 0; a < 2; ++a)
#pragma unroll
        for (int b = 0; b < 2; ++b)
#pragma unroll
            for (int m = 0; m < 4; ++m)
#pragma unroll
                for (int n = 0; n < 2; ++n) acc[a][b][m][n] = (f32x4){0.f, 0.f, 0.f, 0.f};
    bf16x8 At[4][2], B0[2][2], B1[2][2];
    const char* cA = cur.A; const char* cB = cur.B;
    PG8_STAGE(PG8_SB(0, 0), cB, voffB); PG8_STAGE(PG8_SA(0, 0), cA, voffA); PG8_STAGE(PG8_SB(0, 1), cB + hstep, voffB); PG8_STAGE(PG8_SA(0, 1), cA + hstep, voffA);
    if (wr == 1) PG8_BAR;
    PG8_WAIT_V(4); PG8_BAR;
    PG8_STAGE(PG8_SB(1, 0), cB + kstep, voffB); PG8_STAGE(PG8_SA(1, 0), cA + kstep, voffA); PG8_STAGE(PG8_SB(1, 1), cB + hstep + kstep, voffB);
    PG8_WAIT_V(6); PG8_BAR;
    for (;;) {
        const bool has_next = S.next(ui + 1, nxt);
        const char* nA = has_next ? nxt.A : cA; const char* nB = has_next ? nxt.B : cB;
        for (int t = 0; t < nt; t += 2) {
            const bool last = (t == nt - 2);
            const char* a1 = cA + (size_t)(t + 1) * kstep;
            const char* a2 = last ? nA : cA + (size_t)(t + 2) * kstep; const char* b2 = last ? nB : cB + (size_t)(t + 2) * kstep;
            const char* a3 = a2 + kstep; const char* b3 = b2 + kstep;
            PG8_LDB(B0, 0, 0); PG8_SCHED; PG8_LDA(At, 0, 0); PG8_STAGE(PG8_SA(1, 1), a1 + hstep, voffA);
            PG8_WAIT_L(8); PG8_BAR; PG8_WAIT_L(0); PG8_MMA(0, 0, At, B0); PG8_BAR; PG8_SCHED;
            PG8_LDB(B1, 0, 1); PG8_STAGE(PG8_SB(0, 0), b2, voffB);
            PG8_BAR; PG8_WAIT_L(0); PG8_MMA(0, 1, At, B1); PG8_BAR;
            PG8_LDA(At, 0, 1); PG8_STAGE(PG8_SA(0, 0), a2, voffA);
            PG8_BAR; PG8_WAIT_L(0); PG8_MMA(1, 0, At, B0); PG8_BAR; PG8_SCHED;
            PG8_STAGE(PG8_SB(0, 1), b2 + hstep, voffB);
            PG8_WAIT_V(6); PG8_BAR; PG8_MMA(1, 1, At, B1); PG8_BAR;
            PG8_LDB(B0, 1, 0); PG8_SCHED; PG8_LDA(At, 1, 0); PG8_STAGE(PG8_SA(0, 1), a2 + hstep, voffA);
            PG8_WAIT_L(8); PG8_BAR; PG8_WAIT_L(0); PG8_MMA(0, 0, At, B0); PG8_BAR; PG8_SCHED;
            PG8_LDB(B1, 1, 1); PG8_STAGE(PG8_SB(1, 0), b3, voffB);
            PG8_BAR; PG8_WAIT_L(0); PG8_MMA(0, 1, At, B1); PG8_BAR;
            PG8_LDA(At, 1, 1); PG8_STAGE(PG8_SA(1, 0), a3, voffA);
            PG8_BAR; PG8_WAIT_L(0); PG8_MMA(1, 0, At, B0); PG8_BAR; PG8_SCHED;
            PG8_STAGE(PG8_SB(1, 1), b3 + hstep, voffB);
            PG8_WAIT_V(6); PG8_BAR; PG8_MMA(1, 1, At, B1); PG8_BAR;
        }
        {
            const int row0 = cur.r0 + wr * 64 + fr;
            if (PERM) {
                bf16_t* base = (bf16_t*)cur.out; const int col0 = cur.c0 + wc * 32 + 8 * fq;
#pragma unroll
                for (int ai = 0; ai < 2; ++ai)
#pragma unroll
                    for (int m = 0; m < 4; ++m) { bf16_t* rowp = base + (size_t)(row0 + ai * HALF + m * 16) * cur.ldo + col0;
#pragma unroll
                        for (int bj = 0; bj < 2; ++bj) { const f32x4 v0 = acc[ai][bj][m][0], v1 = acc[ai][bj][m][1];
                            u32x4 w; w.x = cvt_pk_bf16(v0[0], v0[1]); w.y = cvt_pk_bf16(v0[2], v0[3]); w.z = cvt_pk_bf16(v1[0], v1[1]); w.w = cvt_pk_bf16(v1[2], v1[3]);
                            *(u32x4*)(rowp + bj * cur.bjs) = w; } }
            } else {
                float* base = (float*)cur.out; const int col0 = cur.c0 + wc * 32 + 4 * fq;
#pragma unroll
                for (int ai = 0; ai < 2; ++ai)
#pragma unroll
                    for (int m = 0; m < 4; ++m) { float* rowp = base + (size_t)(row0 + ai * HALF + m * 16) * cur.ldo + col0;
#pragma unroll
                        for (int bj = 0; bj < 2; ++bj)
#pragma unroll
                            for (int n = 0; n < 2; ++n) *(f32x4*)(rowp + bj * cur.bjs + n * 16) = acc[ai][bj][m][n]; }
            }
        }
        if (!has_next) break;
#pragma unroll
        for (int a = 0; a < 2; ++a)
#pragma unroll
            for (int b = 0; b < 2; ++b)
#pragma unroll
                for (int m = 0; m < 4; ++m)
#pragma unroll
                    for (int n = 0; n < 2; ++n) acc[a][b][m][n] = (f32x4){0.f, 0.f, 0.f, 0.f};
        cur = nxt; cA = nA; cB = nB; ++ui;
    }
    PG8_WAIT_V(0);
    if (wr == 0) PG8_BAR;
    PG8_BAR;
#undef PG8_SA
#undef PG8_SB
#undef PG8_STAGE
#undef PG8_LDA
#undef PG8_LDB
#undef PG8_MMA
#undef PG8_WAIT_V
#undef PG8_WAIT_L
#undef PG8_BAR
#undef PG8_SCHED
}
}

struct DecIn {
    const char* HB; const char* W; char* U1; char* UT;
    __device__ void operator()(int pm, int pn, pg8::Unit& u) const {
        const char* tp = HB + (size_t)pm * 256 * DM * 2; const char* wp = W + (size_t)pn * 256 * DM * 2;
        u.bjs = 128;
        if (pn < 4) { u.A = tp; u.B = wp; u.out = U1; u.ldo = LDU1; u.r0 = pm * 256; u.c0 = pn * 256; }
        else if (pn < 6) {
            const int bb = pm < 128 ? pm >> 4 : pm - 128, srow0 = pm < 128 ? LCTX + (pm & 15) * 256 : 0;
            u.A = tp; u.B = wp; u.out = U1 + (WS_V2 - WS_U1) + ((size_t)(bb * 4 + 2 * (pn - 4)) * (LCTX + LSEQ) + srow0) * 128 * 2; u.ldo = 128; u.r0 = 0; u.c0 = 0; u.bjs = (LCTX + LSEQ) * 128; }
        else if (pn < 10) { u.A = tp; u.B = wp; u.out = U1; u.ldo = LDU1; u.r0 = pm * 256; u.c0 = (pn - 2) * 256; }
        else { u.A = wp; u.B = tp; u.out = UT; u.ldo = MT; u.r0 = (pn - 10) * 256; u.c0 = pm * 256; }
    }
};
struct DecOut {
    const char* YM; const char* W; char* Y;
    __device__ void operator()(int pm, int pn, pg8::Unit& u) const {
        u.A = YM + (size_t)pm * 256 * DM * 2; u.B = W + (size_t)pn * 256 * DM * 2; u.out = Y; u.ldo = DM; u.r0 = pm * 256; u.c0 = pn * 256; u.bjs = 128;
    }
};

__device__ __forceinline__ void mlstm_naive(const Args& a, int l, unsigned char* lds) {
    const int tid = opaque_tid(), G = gridDim.x;
    const bf16_t* U1 = (const bf16_t*)(a.ws + WS_U1);
    const float* GATES = (const float*)(a.ws + WS_GATES);
    bf16_t* HDo = (bf16_t*)(a.ws + WS_HB);
    float* qs = (float*)lds; float* ks = qs + 128; float* vs = ks + 128; float* sc = vs + 32;
    float* pnum = sc + 8;
    float* pden = pnum + 512;
    const float* cw = a.in[10] + (size_t)l * 3 * 1024; const float* cb = a.in[11] + (size_t)l * 1024;
    for (int it = blockIdx.x; it < 256; it += G) {
        const int dvs = it & 3, dir = (it >> 2) & 1, hh = (it >> 3) & 3, b = it >> 5;
        float C[8], nn[8];
#pragma unroll
        for (int i = 0; i < 8; ++i) { C[i] = 0.f; nn[i] = 0.f; }
        float m = 0.f;
        const int j = tid & 31, dg = tid >> 5;
        for (int step = 0; step < LCTX + LSEQ; ++step) {
            int seqlen, tt, rowbase; bool is_ctx = step < LCTX;
            if (is_ctx) { seqlen = LCTX; tt = dir ? (LCTX - 1 - step) : step; rowbase = MLAT + b * LCTX; }
            else { seqlen = LSEQ; const int s2 = step - LCTX; tt = dir ? (LSEQ - 1 - s2) : s2; rowbase = b * LSEQ; }
            const int row = rowbase + tt;
            if (tid < 256) {
                const int ch = (tid < 128) ? (hh * 128 + tid) : (512 + hh * 128 + (tid - 128));
                bool has_l, has_r;
                if (is_ctx) { has_l = tt > 0; has_r = tt < seqlen - 1; } else { has_l = (tt & 63) != 0; has_r = (tt & 63) != 63; }
                float v = bf2f(U1[(size_t)row * NU1 + ch]) * cw[1024 + ch] + cb[ch];
                if (has_l) v += bf2f(U1[(size_t)(row - 1) * NU1 + ch]) * cw[ch];
                if (has_r) v += bf2f(U1[(size_t)(row + 1) * NU1 + ch]) * cw[2048 + ch];
                v = silu_f(v);
                if (tid < 128) qs[tid] = v; else ks[tid - 128] = v * 0.08838834764831845f;
            } else if (tid < 288) {
                vs[tid - 256] = bf2f(U1[(size_t)row * NU1 + 1024 + hh * 128 + dvs * 32 + (tid - 256)]);
            } else if (tid == 288) {
                const float ip = GATES[(size_t)row * 16 + (2 * dir) * 4 + hh], fp = GATES[(size_t)row * 16 + (2 * dir + 1) * 4 + hh];
                const float logf = fminf(fp, 0.f) - log1pf(__expf(-fabsf(fp)));
                const float mn = fmaxf(logf + m, ip);
                sc[0] = __expf(logf + m - mn); sc[1] = __expf(ip - mn); sc[2] = __expf(-mn);
                m = mn;
            }
            __syncthreads();
            const float fw = sc[0], iw = sc[1];
            float pn = 0.f, pd = 0.f;
#pragma unroll
            for (int dd = 0; dd < 8; ++dd) { const int d = dg * 8 + dd; const float kk = ks[d], qq = qs[d];
                C[dd] = fw * C[dd] + iw * kk * vs[j]; nn[dd] = fw * nn[dd] + iw * kk; pn += qq * C[dd]; pd += qq * nn[dd]; }
            pnum[dg * 32 + j] = pn; if (j == 0) pden[dg] = pd;
            __syncthreads();
            if (tid < 32) { float num = 0.f, den = 0.f;
#pragma unroll
                for (int g = 0; g < 16; ++g) { num += pnum[g * 32 + tid]; den += pden[g]; }
                const float h = num / fmaxf(fabsf(den), sc[2]);
                HDo[((size_t)dir * MT + row) * DML + hh * 128 + dvs * 32 + tid] = (bf16_t)f2bf(h); }
        }
        __syncthreads();
    }
}


#define LAS __attribute__((address_space(3)))
typedef short bf16x8 __attribute__((ext_vector_type(8)));
__device__ __forceinline__ u32x4 ldg16_or_zero(const bf16_t* p, bool ok) { u32x4 z = {0u, 0u, 0u, 0u}; return ok ? *(const u32x4*)p : z; }


__device__ __forceinline__ void filt_item(const Args& a, int l, unsigned char* lds_, int fi);
__device__ __forceinline__ void phase_mprep(const Args& a, int l, unsigned char* lds_, int rep) {
    const int tid = opaque_tid(), lane = tid & 63, wave = __builtin_amdgcn_readfirstlane(tid >> 6), fr = lane & 15, fq = lane >> 4;
    LAS float* P = (LAS float*)lds_;
    LAS float* Gs = P + 2048;
    LAS bf16_t* WgS = (LAS bf16_t*)((LAS unsigned char*)lds_ + 32768);
    LAS unsigned* qslot = (LAS unsigned*)((LAS unsigned char*)lds_ + (LDS_BYTES - 32));
    const bf16_t* U1 = (const bf16_t*)(a.ws + WS_U1);
    const bf16_t* HB = (const bf16_t*)(a.ws + WS_HB);
    const bf16_t* WgT = (const bf16_t*)(a.ws + WS_WGT) + (size_t)l * 16 * 1024;
    bf16_t* QK = (bf16_t*)(a.ws + WS_YMIX);
    float* GP = (float*)(a.ws + WS_GP);
    const float* cw = a.in[10] + (size_t)l * 3072; const float* cb = a.in[11] + (size_t)l * 1024;
    unsigned* ctr = (unsigned*)(a.ws + WS_CTL) + CW_QUEUE + 64 * (16 + l * 8 + rep);
    const int co = tid & 127, rg4 = tid >> 7;
    __syncthreads();
    for (int i = tid; i < 16 * 128; i += NTHR) { const int g = i >> 7, c8 = (i & 127) * 8; *(LAS u32x4*)(WgS + g * 1032 + c8) = *(const u32x4*)(WgT + g * 1024 + c8); }
    for (;;) {
        __syncthreads();
        if (tid == 0) *qslot = __hip_atomic_fetch_add(ctr, 1u, __ATOMIC_RELAXED, __HIP_MEMORY_SCOPE_AGENT);
        __syncthreads();
        const int item = (int)*qslot;
        if (item >= 128 + MT / 64) break;
        if (item < 128) { filt_item(a, l, lds_, item); continue; }
        const int ch = item - 128;
        const int rowbase = ch * 64;
        const bool is_ctx = rowbase >= MLAT; const int cc = is_ctx ? ((rowbase - MLAT) >> 6) & 3 : 0;
        const bool has_lo = is_ctx && cc > 0, has_hi = is_ctx && cc < 3;
        {
            const int rt = wave & 3, kh = wave >> 2;
            f32x4 acc = {0.f, 0.f, 0.f, 0.f};
            const bf16_t* ap = HB + (size_t)(rowbase + rt * 16 + fr) * DM + kh * 512 + fq * 8;
            LAS const bf16_t* bp = WgS + fr * 1032 + kh * 512 + fq * 8;
            bf16x8 af[16];
#pragma unroll
            for (int ks = 0; ks < 16; ++ks) af[ks] = *(const bf16x8*)(ap + ks * 32);
#pragma unroll
            for (int ks = 0; ks < 16; ++ks) { const bf16x8 bf = *(const LAS bf16x8*)(bp + ks * 32); acc = __builtin_amdgcn_mfma_f32_16x16x32_bf16(af[ks], bf, acc, 0, 0, 0); }
#pragma unroll
            for (int jj = 0; jj < 4; ++jj) P[(kh * 64 + rt * 16 + 4 * fq + jj) * 16 + fr] = acc[jj];
        }
        {
            float w0[8], w1[8], w2[8], bb[8];
#pragma unroll
            for (int e = 0; e < 8; ++e) { w0[e] = cw[co * 8 + e]; w1[e] = cw[1024 + co * 8 + e]; w2[e] = cw[2048 + co * 8 + e]; bb[e] = cb[co * 8 + e]; }
            u32x4 r0, r1, r2;
            { const int tt = rg4 * 16 - 1; r0 = ldg16_or_zero(U1 + (size_t)(rowbase + tt) * LDU1 + co * 8, tt >= 0 || has_lo); }
            r1 = *(const u32x4*)(U1 + (size_t)(rowbase + rg4 * 16) * LDU1 + co * 8);
            const int qb = is_ctx ? (rowbase - MLAT) >> 8 : rowbase >> 12, srow0 = is_ctx ? (rowbase - MLAT) & 255 : LCTX + (rowbase & 4095);
            unsigned char* qdst = (unsigned char*)QK + (size_t)(qb * 4 + ((co & 63) >> 4)) * QK8_STRIDE + (size_t)srow0 * 256 + (co >> 6) * 128 + (co & 15) * 8;
#pragma unroll 4
            for (int i = 0; i < 16; ++i) { const int tt = rg4 * 16 + i;
                r2 = ldg16_or_zero(U1 + (size_t)(rowbase + tt + 1) * LDU1 + co * 8, tt + 1 <= 63 || has_hi);
                float fv[8];
#pragma unroll
                for (int e2 = 0; e2 < 4; ++e2) {
                    fv[2 * e2] = silu_f(bflo(r0[e2]) * w0[2 * e2] + bflo(r1[e2]) * w1[2 * e2] + bflo(r2[e2]) * w2[2 * e2] + bb[2 * e2]);
                    fv[2 * e2 + 1] = silu_f(bfhi(r0[e2]) * w0[2 * e2 + 1] + bfhi(r1[e2]) * w1[2 * e2 + 1] + bfhi(r2[e2]) * w2[2 * e2 + 1] + bb[2 * e2 + 1]); }
                int p0 = 0, p1 = 0;
                p0 = __builtin_amdgcn_cvt_pk_fp8_f32(fv[0], fv[1], p0, false); p0 = __builtin_amdgcn_cvt_pk_fp8_f32(fv[2], fv[3], p0, true);
                p1 = __builtin_amdgcn_cvt_pk_fp8_f32(fv[4], fv[5], p1, false); p1 = __builtin_amdgcn_cvt_pk_fp8_f32(fv[6], fv[7], p1, true);
                *(u32x2*)(qdst + (size_t)tt * 256) = (u32x2){(unsigned)p0, (unsigned)p1};
                r0 = r1; r1 = r2; }
        }
        __syncthreads();
        for (int i = tid; i < 1024; i += NTHR) Gs[i] = P[i] + P[1024 + i] + a.in[9][l * 16 + (i & 15)];
        __syncthreads();
        {
            const int dir = wave >> 2, hh = wave & 3, tt = dir ? 63 - lane : lane;
            const float gi = Gs[tt * 16 + (2 * dir) * 4 + hh], gf = Gs[tt * 16 + (2 * dir + 1) * 4 + hh];
            const float logf = fminf(gf, 0.f) - log1pf(__expf(-fabsf(gf)));
            float bc = logf;
#pragma unroll
            for (int ofs = 1; ofs < 64; ofs <<= 1) { const float t = __shfl_up(bc, ofs); if (lane >= ofs) bc += t; }
            const float av = gi - bc;
            float cm = av;
#pragma unroll
            for (int ofs = 1; ofs < 64; ofs <<= 1) { const float t = __shfl_up(cm, ofs); if (lane >= ofs) cm = fmaxf(cm, t); }
            float* gp = GP + ((size_t)ch * 8 + wave) * 192;
            gp[lane] = bc; gp[64 + lane] = av; gp[128 + lane] = cm;
        }
    }
    __syncthreads();
}

__device__ __forceinline__ void dec16_fp8(const u32x4 raw, float (&f)[16]) {
#pragma unroll
    for (int e = 0; e < 4; ++e) { const f32x2 lo = __builtin_amdgcn_cvt_pk_f32_fp8((int)raw[e], false), hi = __builtin_amdgcn_cvt_pk_f32_fp8((int)raw[e], true);
        f[4 * e] = lo.x; f[4 * e + 1] = lo.y; f[4 * e + 2] = hi.x; f[4 * e + 3] = hi.y; }
}
__device__ __forceinline__ void mlstm_item(const Args& a, int l, unsigned char* lds_, int it, bool do_store) {
    const int tid = opaque_tid(), lane = tid & 63, wave = __builtin_amdgcn_readfirstlane(tid >> 6), fr = lane & 15, fq = lane >> 4;
    LAS unsigned char* lds = (LAS unsigned char*)lds_;
    LAS bf16_t* Qs = (LAS bf16_t*)(lds);
    LAS bf16_t* Ks = (LAS bf16_t*)(lds + 17408);
    LAS bf16_t* KTs = (LAS bf16_t*)(lds + 34816);
    LAS bf16_t* VTs = (LAS bf16_t*)(lds + 53248);
    LAS bf16_t* Ss = (LAS bf16_t*)(lds + 73984);
    LAS bf16_t* CTs = (LAS bf16_t*)(lds + 83200);
    LAS float* F = (LAS float*)(lds + 122368);
    LAS float* Aa = F; LAS float* Gg = F + 64; LAS float* WI = F + 128; LAS float* EM = F + 192;
    const unsigned char* QK8 = (const unsigned char*)(a.ws + WS_YMIX);
    const bf16_t* V2 = (const bf16_t*)(a.ws + WS_V2);
    const float* GP = (const float*)(a.ws + WS_GP);
    bf16_t* HDo = (bf16_t*)(a.ws + WS_HB);
    const int dir = it & 1, hh = (it >> 1) & 3, b = it >> 3;
    const int c16 = wave * 16;
    const int rpos = dir ? 63 - lane : lane;
    __syncthreads();
    for (int i = tid; i < 144 * 136 / 2; i += NTHR) ((LAS unsigned*)CTs)[i] = 0u;
    for (int i = tid; i < 16 * 72 / 2; i += NTHR) ((LAS unsigned*)(VTs + 128 * 72))[i] = (i < 36) ? 0x3f803f80u : 0u;
    f32x4 accC[9];
#pragma unroll
    for (int j = 0; j < 9; ++j) accC[j] = (f32x4){0.f, 0.f, 0.f, 0.f};
    float m_prev = 0.f;
    struct OpSet { u32x4 rq8, rk8, v0, v1; float ga, gbc, gav, gcm, g_bl, g_cm63; };
    auto chunk_rowbase = [&](int cs) -> int {
        const bool is_ctx = cs < 4; const int cc = is_ctx ? (dir ? 3 - cs : cs) : (dir ? 63 - (cs - 4) : cs - 4);
        return is_ctx ? MLAT + b * LCTX + cc * 64 : b * LSEQ + cc * 64; };
    auto prefetch = [&](int cs_, OpSet& o) {
        const int cs = cs_ < 68 ? cs_ : 67;
        const int rowbase = chunk_rowbase(cs);
        const int srow0 = (rowbase >= MLAT) ? (rowbase - MLAT) & 255 : LCTX + (rowbase & 4095);
        const unsigned char* qp = QK8 + (size_t)(b * 4 + hh) * QK8_STRIDE + (size_t)(srow0 + lane) * 256 + c16;
        o.rq8 = *(const u32x4*)qp; o.rk8 = *(const u32x4*)(qp + 128);
        const bf16_t* vp = V2 + ((size_t)(b * 4 + hh) * (LCTX + LSEQ) + srow0 + lane) * 128 + c16;
        o.v0 = *(const u32x4*)vp; o.v1 = *(const u32x4*)(vp + 8);
        const float* gp = GP + ((size_t)(rowbase >> 6) * 8 + dir * 4 + hh) * 192;
        o.g_bl = gp[63]; o.g_cm63 = gp[128 + 63]; o.ga = gp[64 + rpos];
        o.gbc = gp[lane]; o.gav = gp[64 + lane]; o.gcm = gp[128 + lane];
    };
    OpSet os0, os1, os2;
    prefetch(0, os0); prefetch(1, os1); prefetch(2, os2);
    __syncthreads();
    u32x2 hold[4]; int hold_row = -1;
#pragma unroll
    for (int j = 0; j < 4; ++j) hold[j] = (u32x2){0u, 0u};
    auto flush = [&]() {
        if (hold_row >= 0 && do_store) { bf16_t* op = HDo + (((size_t)dir * 32 + b * 4 + hh) * (LCTX + LSEQ) + hold_row) * 128 + (wave >> 2) * 64 + 4 * fq;
#pragma unroll
            for (int j = 0; j < 4; ++j) *(u32x2*)(op + j * 16) = hold[j]; } };
    auto step = [&](const int cs, OpSet& o) {
        const int rowbase = chunk_rowbase(cs);
        const u32x4 rq8 = o.rq8, rk8 = o.rk8; u32x4 vraw[2]; vraw[0] = o.v0; vraw[1] = o.v1;
        const float ga = o.ga, gbc = o.gbc, gav = o.gav, gcm = o.gcm, g_bl = o.g_bl, g_cm63 = o.g_cm63;
        const float g63 = fmaxf(m_prev, g_cm63), wc = __expf(m_prev - g63);
        {
            float f[16];
            dec16_fp8(rq8, f);
            { u32x4 w0, w1;
#pragma unroll
              for (int e = 0; e < 4; ++e) { w0[e] = pg8::cvt_pk_bf16(f[2 * e], f[2 * e + 1]); w1[e] = pg8::cvt_pk_bf16(f[8 + 2 * e], f[8 + 2 * e + 1]); }
              *(LAS u32x4*)(Qs + rpos * 136 + c16) = w0; *(LAS u32x4*)(Qs + rpos * 136 + c16 + 8) = w1; }
            dec16_fp8(rk8, f);
            { u32x4 w0, w1;
#pragma unroll
              for (int e = 0; e < 16; ++e) f[e] *= 0.08838834764831845f;
#pragma unroll
              for (int e = 0; e < 4; ++e) { w0[e] = pg8::cvt_pk_bf16(f[2 * e], f[2 * e + 1]); w1[e] = pg8::cvt_pk_bf16(f[8 + 2 * e], f[8 + 2 * e + 1]); }
              *(LAS u32x4*)(Ks + rpos * 136 + c16) = w0; *(LAS u32x4*)(Ks + rpos * 136 + c16 + 8) = w1;
              const float ws = __expf(ga - g63);
#pragma unroll
              for (int e = 0; e < 8; ++e) { const unsigned pw = pg8::cvt_pk_bf16(f[2 * e] * ws, f[2 * e + 1] * ws);
                  KTs[(c16 + 2 * e) * 72 + rpos] = (bf16_t)(pw & 0xffffu); KTs[(c16 + 2 * e + 1) * 72 + rpos] = (bf16_t)(pw >> 16); } }
#pragma unroll
            for (int h2 = 0; h2 < 2; ++h2)
#pragma unroll
                for (int e2 = 0; e2 < 4; ++e2) { VTs[(c16 + h2 * 8 + 2 * e2) * 72 + rpos] = (bf16_t)(vraw[h2][e2] & 0xffffu); VTs[(c16 + h2 * 8 + 2 * e2 + 1) * 72 + rpos] = (bf16_t)(vraw[h2][e2] >> 16); }
            if (wave == 7) { const float g = fmaxf(m_prev, gcm); Aa[lane] = gav; Gg[lane] = g; WI[lane] = __expf(m_prev - g); EM[lane] = __expf(-(gbc + g)); }
        }
        m_prev = g_bl + g63;
        flush();
        prefetch(cs + 3, o);
        __syncthreads();
        {
            const int tb = wave >> 1;
#pragma unroll
            for (int q2 = 0; q2 < 2; ++q2) {
                const int sb = (wave & 1) * 2 + q2;
                f32x4 acc = {0.f, 0.f, 0.f, 0.f};
                if (sb <= tb) {
                    bf16x8 kf[4], qf[4];
#pragma unroll
                    for (int ks = 0; ks < 4; ++ks) { kf[ks] = *(const LAS bf16x8*)(Ks + (sb * 16 + fr) * 136 + ks * 32 + fq * 8); qf[ks] = *(const LAS bf16x8*)(Qs + (tb * 16 + fr) * 136 + ks * 32 + fq * 8); }
#pragma unroll
                    for (int ks = 0; ks < 4; ++ks) acc = __builtin_amdgcn_mfma_f32_16x16x32_bf16(kf[ks], qf[ks], acc, 0, 0, 0);
                    const int t = tb * 16 + fr, s0 = sb * 16 + 4 * fq; const float g = Gg[t];
                    const f32x4 av = *(const LAS f32x4*)(Aa + s0);
#pragma unroll
                    for (int jj = 0; jj < 4; ++jj) acc[jj] = (s0 + jj <= t) ? acc[jj] * __expf(av[jj] - g) : 0.f;
                }
                u32x2 w; w.x = pg8::cvt_pk_bf16(acc[0], acc[1]); w.y = pg8::cvt_pk_bf16(acc[2], acc[3]);
                *(LAS u32x2*)(Ss + (tb * 16 + fr) * 72 + sb * 16 + 4 * fq) = w;
            }
        }
        __syncthreads();
        {
            const int tb = wave & 3, half = wave >> 2, t = tb * 16 + fr;
            f32x4 acc[5];
#pragma unroll
            for (int j = 0; j < 5; ++j) acc[j] = (f32x4){0.f, 0.f, 0.f, 0.f};
#pragma unroll
            for (int ks = 0; ks < 4; ++ks) {
                const bf16x8 qf = *(const LAS bf16x8*)(Qs + t * 136 + ks * 32 + fq * 8);
#pragma unroll
                for (int j = 0; j < 5; ++j) { const int jrow = (j < 4) ? (half * 4 + j) * 16 : 128;
                    const bf16x8 cf = *(const LAS bf16x8*)(CTs + (jrow + fr) * 136 + ks * 32 + fq * 8);
                    acc[j] = __builtin_amdgcn_mfma_f32_16x16x32_bf16(cf, qf, acc[j], 0, 0, 0); }
            }
            const float wi = WI[t];
#pragma unroll
            for (int j = 0; j < 5; ++j) acc[j] = acc[j] * wi;
#pragma unroll
            for (int ks = 0; ks < 2; ++ks) {
                const bf16x8 sf = *(const LAS bf16x8*)(Ss + t * 72 + ks * 32 + fq * 8);
#pragma unroll
                for (int j = 0; j < 5; ++j) { const int jrow = (j < 4) ? (half * 4 + j) * 16 : 128;
                    const bf16x8 vf = *(const LAS bf16x8*)(VTs + (jrow + fr) * 72 + ks * 32 + fq * 8);
                    acc[j] = __builtin_amdgcn_mfma_f32_16x16x32_bf16(vf, sf, acc[j], 0, 0, 0); }
            }
            const float den = __shfl(acc[4][0], fr);
            const float inv = __builtin_amdgcn_rcpf(fmaxf(fabsf(den), EM[t]));
#pragma unroll
            for (int j = 0; j < 4; ++j) { hold[j].x = pg8::cvt_pk_bf16(acc[j][0] * inv, acc[j][1] * inv); hold[j].y = pg8::cvt_pk_bf16(acc[j][2] * inv, acc[j][3] * inv); }
            hold_row = ((rowbase >= MLAT) ? (rowbase - MLAT) & 255 : LCTX + (rowbase & 4095)) + (dir ? 63 - t : t);
            const int d0 = wave * 16;
#pragma unroll
            for (int j = 0; j < 9; ++j) accC[j] = accC[j] * wc;
#pragma unroll
            for (int ks = 0; ks < 2; ++ks) {
                const bf16x8 kf = *(const LAS bf16x8*)(KTs + (d0 + fr) * 72 + ks * 32 + fq * 8);
#pragma unroll
                for (int j = 0; j < 9; ++j) { const bf16x8 vf = *(const LAS bf16x8*)(VTs + (j * 16 + fr) * 72 + ks * 32 + fq * 8);
                    accC[j] = __builtin_amdgcn_mfma_f32_16x16x32_bf16(kf, vf, accC[j], 0, 0, 0); }
            }
        }
        __syncthreads();
        {
            const int d0 = wave * 16;
#pragma unroll
            for (int j = 0; j < 9; ++j) { u32x2 w; w.x = pg8::cvt_pk_bf16(accC[j][0], accC[j][1]); w.y = pg8::cvt_pk_bf16(accC[j][2], accC[j][3]);
                *(LAS u32x2*)(CTs + (j * 16 + fr) * 136 + d0 + 4 * fq) = w; }
        }
    };
#pragma unroll 1
    for (int cs = 0; cs < 66; cs += 3) { step(cs, os0); step(cs + 1, os1); step(cs + 2, os2); }
    step(66, os0); step(67, os1);
    flush();
    __syncthreads();
}

__device__ __forceinline__ float conv3_at(const bf16_t* rowp, int t, int seglen, float w0, float w1, float w2, float bias) {
    const int tl = t % seglen;
    float v = bf2f(rowp[t]) * w1 + bias;
    if (tl > 0) v += bf2f(rowp[t - 1]) * w0;
    if (tl < seglen - 1) v += bf2f(rowp[t + 1]) * w2;
    return v;
}
__device__ __forceinline__ void hyena_naive(const Args& a, int l, unsigned char* lds, int pass_lo, bool do_store) {
    const int tid = opaque_tid(), G = gridDim.x;
    bf16_t* UT = (bf16_t*)(a.ws + WS_UT);
    float* H = (float*)lds;
    float* Ub = H + 8192;
    float* Zb = Ub + 4096;
    float* red = Zb + 4096;
    float* w3s = red + 64;
    const float* hw = a.in[13] + (size_t)l * 3 * 1536; const float* hb = a.in[14] + (size_t)l * 1536;
    const float MIN_DECAY = -3.0701134573253946f, MAX_DECAY = -15.350567286626973f;
    for (int c = blockIdx.x; c < DHY; c += G) {
        const float rate = fabsf(MIN_DECAY + (MAX_DECAY - MIN_DECAY) * (float)c / 511.f);
        const float fb0 = a.in[21][(l * 2 + 0) * 512 + c], fb1 = a.in[21][(l * 2 + 1) * 512 + c];
        float cwv[3][3], cbv[3];
#pragma unroll
        for (int g = 0; g < 3; ++g) { cbv[g] = hb[g * 512 + c];
#pragma unroll
            for (int t3 = 0; t3 < 3; ++t3) cwv[g][t3] = hw[t3 * 1536 + g * 512 + c]; }
        for (int pass = pass_lo; pass < (l == 0 ? 2 : 1); ++pass) {
            const int L = pass ? LCTX : LSEQ;
            const float* hdn = pass ? (const float*)(a.ws + WS_HDNC) : (const float*)(a.ws + WS_HDN) + (size_t)l * 4096 * 64;
            __syncthreads();
            if (tid < 128) w3s[tid] = a.in[20][(size_t)l * 64 * 1024 + (tid & 63) * 1024 + (tid >> 6) * 512 + c];
            __syncthreads();
            float ssq0 = 0.f, ssq1 = 0.f;
            for (int t = tid; t < L; t += 512) { float s0 = 0.f, s1 = 0.f;
                for (int jj = 0; jj < 64; ++jj) { const float hv = hdn[(size_t)t * 64 + jj]; s0 += hv * w3s[jj]; s1 += hv * w3s[64 + jj]; }
                const float off = fabsf((float)t - (float)(L / 2)) / (float)(L / 2); const float dec = __expf(-off * rate);
                s0 *= dec; s1 *= dec; H[t] = s0; H[4096 + t] = s1; ssq0 += s0 * s0; ssq1 += s1 * s1; }
            ssq0 = wave_sum(ssq0); ssq1 = wave_sum(ssq1);
            if ((tid & 63) == 0) { red[tid >> 6] = ssq0; red[8 + (tid >> 6)] = ssq1; }
            __syncthreads();
            float t0 = 0.f, t1 = 0.f;
            for (int w = 0; w < 8; ++w) { t0 += red[w]; t1 += red[8 + w]; }
            const float n0 = rsqrtf(t0 + RMS_EPS), n1 = rsqrtf(t1 + RMS_EPS);
            __syncthreads();
            for (int t = tid; t < L; t += 512) { H[t] *= n0; H[4096 + t] *= n1; }
            __syncthreads();
            for (int b = 0; b < NB; ++b) {
                const size_t col0 = pass ? (size_t)MLAT + (size_t)b * LCTX : (size_t)b * LSEQ;
                const int seglen = pass ? LCTX : 64;
                const bf16_t* rv = UT + (size_t)c * MT + col0; const bf16_t* r1 = UT + (size_t)(512 + c) * MT + col0;
                const bf16_t* r2 = UT + (size_t)(1024 + c) * MT + col0; const bf16_t* rz = UT + (size_t)(1536 + c) * MT + col0;
                for (int t = tid; t < L; t += 512) Ub[t] = conv3_at(rv, t, seglen, cwv[0][0], cwv[0][1], cwv[0][2], cbv[0]);
                __syncthreads();
                for (int t = tid; t < L; t += 512) { float y = 0.f;
                    int slo = t + L / 2 - (L - 1); if (slo < 0) slo = 0; int shi = t + L / 2; if (shi > L - 1) shi = L - 1;
                    for (int s = slo; s <= shi; ++s) y += Ub[s] * H[t + L / 2 - s];
                    const float x1 = conv3_at(r1, t, seglen, cwv[1][0], cwv[1][1], cwv[1][2], cbv[1]);
                    Zb[t] = x1 * (y + Ub[t] * fb0); }
                __syncthreads();
                for (int t = tid; t < L; t += 512) { float y = 0.f;
                    int slo = t + L / 2 - (L - 1); if (slo < 0) slo = 0; int shi = t + L / 2; if (shi > L - 1) shi = L - 1;
                    for (int s = slo; s <= shi; ++s) y += Zb[s] * H[4096 + t + L / 2 - s];
                    const float x2 = conv3_at(r2, t, seglen, cwv[2][0], cwv[2][1], cwv[2][2], cbv[2]);
                    const float o = x2 * (y + Zb[t] * fb1) * silu_f(bf2f(rz[t]));
                    Ub[t] = o; }
                __syncthreads();
                if (do_store) for (int t = tid; t < L; t += 512) UT[(size_t)c * MT + col0 + t] = (bf16_t)f2bf(Ub[t]);
                __syncthreads();
            }
        }
    }
    __syncthreads();
}


typedef float cf __attribute__((ext_vector_type(2)));
__device__ __forceinline__ cf cmul(cf a, cf b) { const cf sw = __builtin_shufflevector(a, a, 1, 0); return a * b.x + sw * cf{-b.y, b.y}; }
__host__ __device__ constexpr float tw32c(int e) { return e == 0 ? 1.f : e == 1 ? 0.98078528040323043f : e == 2 ? 0.92387953251128674f : e == 3 ? 0.83146961230254524f : e == 4 ? 0.70710678118654752f : e == 5 ? 0.55557023301960218f :
    e == 6 ? 0.38268343236508977f : e == 7 ? 0.19509032201612825f : e == 8 ? 0.f : e == 9 ? -0.19509032201612825f : e == 10 ? -0.38268343236508977f : e == 11 ? -0.55557023301960218f : e == 12 ? -0.70710678118654752f :
    e == 13 ? -0.83146961230254524f : e == 14 ? -0.92387953251128674f : -0.98078528040323043f; }
template <int E32> __device__ __forceinline__ cf twmul(cf d) {
    if (E32 == 0) return d;
    if (E32 == 8) return cf{d.y, -d.x};
    constexpr float c = tw32c(E32), sn = tw32c(E32 < 8 ? 8 - E32 : E32 - 8);
    const cf sw = __builtin_shufflevector(d, d, 1, 0);
    return d * c + sw * cf{sn, -sn};
}
template <int R, int HALF, int I> struct DftStage {
    static __device__ __forceinline__ void run(cf (&v)[R]) {
        if constexpr ((I & HALF) == 0) {
            constexpr int E32 = (I % HALF) * (R / (2 * HALF)) * (32 / R);
            const cf a = v[I], b = v[I + HALF];
            v[I] = a + b;
            v[I + HALF] = twmul<E32>(a - b);
        }
        if constexpr (I + 1 < R) DftStage<R, HALF, I + 1>::run(v);
    }
};
template <int R, int HALF> struct DftAll {
    static __device__ __forceinline__ void run(cf (&v)[R]) { DftStage<R, HALF, 0>::run(v); if constexpr (HALF > 1) DftAll<R, HALF / 2>::run(v); }
};
__host__ __device__ constexpr int bitrev_c(int x, int bits) { int r = 0; for (int i = 0; i < bits; ++i) r = (r << 1) | ((x >> i) & 1); return r; }
__device__ __forceinline__ int PADI(int i) { return i + (i >> 4); }
constexpr int FFT_W_ELEMS = 8192 + 512;
template <int R, int I> struct StoreRev {
    static __device__ __forceinline__ void run(LAS cf* Wp, int pstride, const cf (&v)[R]) {
        constexpr int bits = (R == 32) ? 5 : 4;
        Wp[I * pstride] = v[bitrev_c(I, bits)];
        if constexpr (I + 1 < R) StoreRev<R, I + 1>::run(Wp, pstride, v);
    }
};
template <int R, int NS> __device__ __forceinline__ void fft_pass(LAS cf* W, int tid_) {
    int tid = tid_; asm volatile("" : "+v"(tid));
    constexpr int NT = 8192 / R;
    cf v[R];
    const bool act = tid < NT;
    if (act) {
#pragma unroll
        for (int r = 0; r < R; ++r) v[r] = W[PADI(tid) + r * (NT + NT / 16)];
    }
    __syncthreads();
    if (act) {
        const int k = tid % NS;
        if (NS > 1) {
            const float fr_ = -(float)k * (1.f / (float)(NS * R)); const float sn = __builtin_amdgcn_sinf(fr_), cs = __builtin_amdgcn_cosf(fr_);
            const cf w = cf{cs, sn}; cf cur = w;
#pragma unroll
            for (int r = 1; r < R; ++r) { v[r] = cmul(v[r], cur); cur = cmul(cur, w); }
        }
        DftAll<R, R / 2>::run(v);
        const int idx = (tid / NS) * NS * R + k;
        StoreRev<R, 0>::run(W + PADI(idx), NS >= 16 ? NS + NS / 16 : 1, v);
    }
    __syncthreads();
}
__device__ __forceinline__ void fft_pass2(LAS cf* W, int tid_) {
    int tid = tid_; asm volatile("" : "+v"(tid));
#pragma unroll 2
    for (int m = 0; m < 8; ++m) { const int j = tid + 512 * m; const int pj = PADI(j); const cf a = W[pj]; cf b = W[pj + 4352];
        const float fr_ = -(float)j * (1.f / 8192.f); b = cmul(b, cf{__builtin_amdgcn_cosf(fr_), __builtin_amdgcn_sinf(fr_)});
        W[pj] = cf{a.x + b.x, a.y + b.y}; W[pj + 4352] = cf{a.x - b.x, a.y - b.y}; }
    __syncthreads();
}
__device__ __forceinline__ void fft8192(LAS cf* W, int tid) { fft_pass<16, 1>(W, tid); fft_pass<16, 16>(W, tid); fft_pass<16, 256>(W, tid); fft_pass2(W, tid); }

template <int NS> __device__ __forceinline__ void fft4k_pass(LAS cf* Wb, int j_) {
    int j = j_; asm volatile("" : "+v"(j));
    cf v[16];
#pragma unroll
    for (int r = 0; r < 16; ++r) v[r] = Wb[PADI(j) + r * 272];
    __syncthreads();
    const int k = j % NS;
    if (NS > 1) {
        const float fr_ = -(float)k * (1.f / (float)(NS * 16)); const float sn = __builtin_amdgcn_sinf(fr_), cs = __builtin_amdgcn_cosf(fr_);
        const cf w = cf{cs, sn}; cf cur = w;
#pragma unroll
        for (int r = 1; r < 16; ++r) { v[r] = cmul(v[r], cur); cur = cmul(cur, w); }
    }
    DftAll<16, 8>::run(v);
    const int idx = (j / NS) * NS * 16 + k;
    StoreRev<16, 0>::run(Wb + PADI(idx), NS >= 16 ? NS + NS / 16 : 1, v);
    __syncthreads();
}
__device__ __forceinline__ void fft4k_x2(LAS cf* Wb, int j) { fft4k_pass<1>(Wb, j); fft4k_pass<16>(Wb, j); fft4k_pass<256>(Wb, j); }

__device__ __forceinline__ void conv8(const u32x4 rv, int tid, float w0, float w1, float w2, float bias, float (&o)[8]) {
    float x[8];
#pragma unroll
    for (int e = 0; e < 4; ++e) { x[2 * e] = bflo(rv[e]); x[2 * e + 1] = bfhi(rv[e]); }
    float left = __shfl_up(x[7], 1), right = __shfl_down(x[0], 1);
    if ((tid & 7) == 0) left = 0.f;
    if ((tid & 7) == 7) right = 0.f;
#pragma unroll
    for (int e = 0; e < 8; ++e) { const float xm = (e == 0) ? left : x[e - 1], xp = (e == 7) ? right : x[e + 1]; o[e] = w0 * xm + w1 * x[e] + w2 * xp + bias; }
}

__device__ __forceinline__ void hyena_item(const Args& a, int l, unsigned char* lds_, int item, bool do_store) {
    const int tid = opaque_tid();
    const int c = item >> 1, half = item & 1;
    LAS unsigned char* lds = (LAS unsigned char*)lds_;
    LAS cf* W = (LAS cf*)lds;
    LAS cf* He0 = (LAS cf*)(lds + 69632);
    LAS cf* Ho0 = He0 + 2049;
    LAS cf* He1 = Ho0 + 2048;
    LAS cf* Ho1 = He1 + 2049;
    const int sel = tid >> 8, j = tid & 255;
    LAS cf* Wb = W + sel * 4352;
    bf16_t* UT = (bf16_t*)(a.ws + WS_UT);
    const float* FT = (const float*)(a.ws + WS_FT);
    const float* hw = a.in[13] + (size_t)l * 3 * 1536; const float* hb = a.in[14] + (size_t)l * 1536;
    const float fb0 = a.in[21][(l * 2 + 0) * 512 + c], fb1 = a.in[21][(l * 2 + 1) * 512 + c];
    const int pi0 = PADI(tid * 8);
    __syncthreads();
    {
        const f32x4 ha = *(const f32x4*)(FT + (size_t)c * 4096 + tid * 8), hb2 = *(const f32x4*)(FT + (size_t)c * 4096 + tid * 8 + 4);
        const f32x4 ga = *(const f32x4*)(FT + (size_t)(512 + c) * 4096 + tid * 8), gb2 = *(const f32x4*)(FT + (size_t)(512 + c) * 4096 + tid * 8 + 4);
        const float fn0 = FT[(size_t)1024 * 4096 + c], fn1 = FT[(size_t)1024 * 4096 + 512 + c];
#pragma unroll
        for (int e = 0; e < 8; ++e) { const cf f = cf{(e < 4 ? ha[e & 3] : hb2[e & 3]) * fn0, (e < 4 ? ga[e & 3] : gb2[e & 3]) * fn1};
            const float fr_ = -(float)(tid * 8 + e) * (1.f / 8192.f);
            W[pi0 + e] = f; W[4352 + pi0 + e] = cmul(f, cf{__builtin_amdgcn_cosf(fr_), __builtin_amdgcn_sinf(fr_)}); }
        __syncthreads();
        fft4k_x2(Wb, j);
        for (int m = tid; m <= 2048; m += NTHR) { const cf A = W[PADI(m & 4095)], Bm = W[PADI((4096 - m) & 4095)];
            He0[m] = cf{0.5f * (A.x + Bm.x), 0.5f * (A.y - Bm.y)}; He1[m] = cf{0.5f * (A.y + Bm.y), -0.5f * (A.x - Bm.x)}; }
        for (int m = tid; m < 2048; m += NTHR) { const cf A = W[4352 + PADI(m)], Bm = W[4352 + PADI(4095 - m)];
            Ho0[m] = cf{0.5f * (A.x + Bm.x), 0.5f * (A.y - Bm.y)}; Ho1[m] = cf{0.5f * (A.y + Bm.y), -0.5f * (A.x - Bm.x)}; }
        __syncthreads();
    }
    float cwv[3][3], cbv[3];
#pragma unroll
    for (int g = 0; g < 3; ++g) { cbv[g] = hb[g * 512 + c];
#pragma unroll
        for (int t3 = 0; t3 < 3; ++t3) cwv[g][t3] = hw[t3 * 1536 + g * 512 + c]; }
#pragma unroll 1
    for (int bp = half * 2; bp < half * 2 + 2; ++bp) {
        const size_t o0 = (size_t)(2 * bp) * LSEQ + tid * 8, o1 = o0 + LSEQ;
        bf16_t* rv = UT + (size_t)c * MT; const bf16_t* r1 = UT + (size_t)(512 + c) * MT; const bf16_t* r2 = UT + (size_t)(1024 + c) * MT; const bf16_t* rz = UT + (size_t)(1536 + c) * MT;
        const u32x4 qv0 = *(const u32x4*)(rv + o0), qv1 = *(const u32x4*)(rv + o1), qa0 = *(const u32x4*)(r1 + o0), qa1 = *(const u32x4*)(r1 + o1);
        const u32x4 qb0 = *(const u32x4*)(r2 + o0), qb1 = *(const u32x4*)(r2 + o1), qz0 = *(const u32x4*)(rz + o0), qz1 = *(const u32x4*)(rz + o1);
        float z0[8], z1[8];
        conv8(qv0, tid, cwv[0][0], cwv[0][1], cwv[0][2], cbv[0], z0);
        conv8(qv1, tid, cwv[0][0], cwv[0][1], cwv[0][2], cbv[0], z1);
#pragma unroll 1
        for (int ord = 0; ord < 2; ++ord) {
#pragma unroll
            for (int e = 0; e < 8; ++e) { const cf f = cf{z0[e], z1[e]}; const float fr_ = -(float)(tid * 8 + e) * (1.f / 8192.f);
                W[pi0 + e] = f; W[4352 + pi0 + e] = cmul(f, cf{__builtin_amdgcn_cosf(fr_), __builtin_amdgcn_sinf(fr_)}); }
            __syncthreads();
            fft4k_x2(Wb, j);
            {
                LAS const cf* Hs = sel ? (ord ? Ho1 : Ho0) : (ord ? He1 : He0);
                const int top = sel ? 4095 : 4096, lim = sel ? 2047 : 2048;
#pragma unroll 4
                for (int i = 0; i < 16; ++i) { const int m = j + 256 * i; const int pm = PADI(m); const cf zv = Wb[pm];
                    cf hk; if (m <= lim) hk = Hs[m]; else { hk = Hs[top - m]; hk.y = -hk.y; }
                    const cf y = cmul(zv, hk); Wb[pm] = cf{y.x, -y.y}; }
            }
            __syncthreads();
            fft4k_x2(Wb, j);
            float x0[8], x1[8];
            conv8(ord ? qb0 : qa0, tid, cwv[1 + ord][0], cwv[1 + ord][1], cwv[1 + ord][2], cbv[1 + ord], x0);
            conv8(ord ? qb1 : qa1, tid, cwv[1 + ord][0], cwv[1 + ord][1], cwv[1 + ord][2], cbv[1 + ord], x1);
            const float fb = ord ? fb1 : fb0;
            const int pr = PADI((2048 + tid * 8) & 4095);
#pragma unroll
            for (int e = 0; e < 8; ++e) { const float fr_ = -(float)(2048 + tid * 8 + e) * (1.f / 8192.f);
                const cf ev = W[pr + e], ov = cmul(W[4352 + pr + e], cf{__builtin_amdgcn_cosf(fr_), __builtin_amdgcn_sinf(fr_)});
                const float y0 = (ev.x + ov.x) * (1.f / 8192.f), y1 = -(ev.y + ov.y) * (1.f / 8192.f);
                z0[e] = x0[e] * (y0 + z0[e] * fb); z1[e] = x1[e] * (y1 + z1[e] * fb); }
            __syncthreads();
        }
        {
            u32x4 w0, w1;
#pragma unroll
            for (int e = 0; e < 4; ++e) { w0[e] = pg8::cvt_pk_bf16(z0[2 * e] * silu_f(bflo(qz0[e])), z0[2 * e + 1] * silu_f(bfhi(qz0[e])));
                w1[e] = pg8::cvt_pk_bf16(z1[2 * e] * silu_f(bflo(qz1[e])), z1[2 * e + 1] * silu_f(bfhi(qz1[e]))); }
            if (do_store) { *(u32x4*)(rv + o0) = w0; *(u32x4*)(rv + o1) = w1; } }
    }
    __syncthreads();
}

__device__ __forceinline__ void filt_item(const Args& a, int l, unsigned char* lds_, int fi) {
    const int tid = opaque_tid();
    LAS float* w3s = (LAS float*)lds_ + 4096;
    LAS float* red = w3s + 512;
    float* FT = (float*)(a.ws + WS_FT);
    const float* hdn = (const float*)(a.ws + WS_HDN) + (size_t)l * 4096 * 64;
    const float MIN_DECAY = -3.0701134573253946f, MAX_DECAY = -15.350567286626973f;
    __syncthreads();
    w3s[tid] = a.in[20][(size_t)l * 64 * 1024 + (size_t)(tid >> 3) * 1024 + fi * 8 + (tid & 7)];
    __syncthreads();
    float rate[8], ssq[8];
#pragma unroll
    for (int cc = 0; cc < 8; ++cc) { const int ch = (fi * 8 + cc) & 511; rate[cc] = fabsf(MIN_DECAY + (MAX_DECAY - MIN_DECAY) * (float)ch / 511.f); ssq[cc] = 0.f; }
#pragma unroll 1
    for (int it2 = 0; it2 < 2; ++it2) {
        float acc[4][8];
#pragma unroll
        for (int q = 0; q < 4; ++q)
#pragma unroll
            for (int cc = 0; cc < 8; ++cc) acc[q][cc] = 0.f;
        const f32x4* hp = (const f32x4*)(hdn + (size_t)(it2 * 2048 + tid) * 64);
        f32x4 hn[4];
#pragma unroll
        for (int q = 0; q < 4; ++q) hn[q] = hp[(size_t)q * 512 * 16];
#pragma unroll 1
        for (int j4 = 0; j4 < 16; ++j4) {
            f32x4 hv[4];
#pragma unroll
            for (int q = 0; q < 4; ++q) hv[q] = hn[q];
            if (j4 < 15) {
#pragma unroll
                for (int q = 0; q < 4; ++q) hn[q] = hp[(size_t)q * 512 * 16 + j4 + 1]; }
#pragma unroll
            for (int jj = 0; jj < 4; ++jj) { const f32x4 wa = *(const LAS f32x4*)(w3s + (4 * j4 + jj) * 8), wb = *(const LAS f32x4*)(w3s + (4 * j4 + jj) * 8 + 4);
#pragma unroll
                for (int q = 0; q < 4; ++q) { const float h = hv[q][jj];
                    acc[q][0] += h * wa.x; acc[q][1] += h * wa.y; acc[q][2] += h * wa.z; acc[q][3] += h * wa.w; acc[q][4] += h * wb.x; acc[q][5] += h * wb.y; acc[q][6] += h * wb.z; acc[q][7] += h * wb.w; } }
        }
#pragma unroll
        for (int q = 0; q < 4; ++q) { const int t = it2 * 2048 + tid + 512 * q; const float off = fabsf((float)t - 2048.f) * (1.f / 2048.f);
#pragma unroll
            for (int cc = 0; cc < 8; ++cc) { const float v = acc[q][cc] * __expf(-off * rate[cc]); ssq[cc] += v * v; FT[(size_t)(fi * 8 + cc) * 4096 + t] = v; } }
    }
#pragma unroll
    for (int cc = 0; cc < 8; ++cc) { const float sv = wave_sum(ssq[cc]); if ((tid & 63) == 0) red[(tid >> 6) * 8 + cc] = sv; }
    __syncthreads();
    if (tid < 8) { float tsum = 0.f;
#pragma unroll
        for (int w = 0; w < 8; ++w) tsum += red[w * 8 + tid];
        FT[(size_t)1024 * 4096 + fi * 8 + tid] = rsqrtf(tsum + RMS_EPS); }
}

__device__ __forceinline__ float ctx_conv3(LAS const bf16_t* rowp, int t, float w0, float w1, float w2, float bias) {
    return bf2f(rowp[t - 1]) * w0 + bf2f(rowp[t]) * w1 + bf2f(rowp[t + 1]) * w2 + bias;
}
__device__ __forceinline__ void hyena_ctx_item(const Args& a, unsigned char* lds_, int c, bool do_store) {
    const int tid = opaque_tid();
    LAS float* Hc = (LAS float*)lds_;
    LAS float* U = Hc + 512;
    LAS float* Z = U + 2048;
    LAS float* red = Z + 2048;
    LAS float* w3s = red + 16;
    LAS bf16_t* RAW = (LAS bf16_t*)(w3s + 128);
    LAS bf16_t* OUT = RAW + 4 * 8 * 272;
    bf16_t* UT = (bf16_t*)(a.ws + WS_UT);
    const float* hdn = (const float*)(a.ws + WS_HDNC);
    const float* hw = a.in[13]; const float* hb = a.in[14];
    const float MIN_DECAY = -3.0701134573253946f, MAX_DECAY = -15.350567286626973f;
    const int t = tid & 255, bh = tid >> 8;
    {
        const float rate = fabsf(MIN_DECAY + (MAX_DECAY - MIN_DECAY) * (float)c / 511.f);
        const float fb0 = a.in[21][c], fb1 = a.in[21][512 + c];
        __syncthreads();
        if (tid < 128) w3s[tid] = a.in[20][(size_t)(tid & 63) * 1024 + (tid >> 6) * 512 + c];
#pragma unroll
        for (int i = 0; i < 2; ++i) { const int pp = tid + 512 * i, arr = pp >> 8, bb = (pp >> 5) & 7, seg = pp & 31;
            *(LAS u32x4*)(RAW + (arr * 8 + bb) * 272 + 8 + seg * 8) = *(const u32x4*)(UT + (size_t)(arr * 512 + c) * MT + MLAT + (size_t)bb * LCTX + seg * 8); }
        if (tid < 64) RAW[(tid >> 1) * 272 + ((tid & 1) ? 264 : 7)] = (bf16_t)0;
        __syncthreads();
        {
            float sv = 0.f;
            const f32x4* hp = (const f32x4*)(hdn + (size_t)t * 64);
#pragma unroll 4
            for (int j4 = 0; j4 < 16; ++j4) { const f32x4 hv = hp[j4]; sv += hv.x * w3s[bh * 64 + 4 * j4] + hv.y * w3s[bh * 64 + 4 * j4 + 1] + hv.z * w3s[bh * 64 + 4 * j4 + 2] + hv.w * w3s[bh * 64 + 4 * j4 + 3]; }
            sv *= __expf(-fabsf((float)t - 128.f) * (1.f / 128.f) * rate);
            const float ss = wave_sum(sv * sv);
            if ((tid & 63) == 0) red[tid >> 6] = ss;
            __syncthreads();
            const float tot = red[bh * 4] + red[bh * 4 + 1] + red[bh * 4 + 2] + red[bh * 4 + 3];
            Hc[bh * 256 + t] = sv * rsqrtf(tot + RMS_EPS);
        }
        float vv[4];
#pragma unroll
        for (int i = 0; i < 4; ++i) vv[i] = ctx_conv3(RAW + (0 * 8 + bh * 4 + i) * 272 + 8, t, hw[c], hw[1536 + c], hw[3072 + c], hb[c]);
        *(LAS f32x4*)(U + t * 8 + bh * 4) = (f32x4){vv[0], vv[1], vv[2], vv[3]};
        __syncthreads();
        const int slo = (t - 127 > 0) ? t - 127 : 0, shi = (t + 128 < 255) ? t + 128 : 255;
        f32x4 acc = {0.f, 0.f, 0.f, 0.f};
        for (int s2 = slo; s2 <= shi; ++s2) { const float h = Hc[t + 128 - s2]; const f32x4 u = *(const LAS f32x4*)(U + s2 * 8 + bh * 4); acc = acc + u * h; }
        float zz[4];
#pragma unroll
        for (int i = 0; i < 4; ++i) { const float x1 = ctx_conv3(RAW + (1 * 8 + bh * 4 + i) * 272 + 8, t, hw[512 + c], hw[1536 + 512 + c], hw[3072 + 512 + c], hb[512 + c]);
            zz[i] = x1 * (acc[i] + vv[i] * fb0); }
        *(LAS f32x4*)(Z + t * 8 + bh * 4) = (f32x4){zz[0], zz[1], zz[2], zz[3]};
        __syncthreads();
        acc = (f32x4){0.f, 0.f, 0.f, 0.f};
        for (int s2 = slo; s2 <= shi; ++s2) { const float h = Hc[256 + t + 128 - s2]; const f32x4 u = *(const LAS f32x4*)(Z + s2 * 8 + bh * 4); acc = acc + u * h; }
#pragma unroll
        for (int i = 0; i < 4; ++i) { const float x2 = ctx_conv3(RAW + (2 * 8 + bh * 4 + i) * 272 + 8, t, hw[1024 + c], hw[1536 + 1024 + c], hw[3072 + 1024 + c], hb[1024 + c]);
            OUT[(bh * 4 + i) * 256 + t] = (bf16_t)f2bf(x2 * (acc[i] + zz[i] * fb1) * silu_f(bf2f(RAW[(3 * 8 + bh * 4 + i) * 272 + 8 + t]))); }
        __syncthreads();
        if (do_store && tid < 256) *(u32x4*)(UT + (size_t)c * MT + MLAT + (size_t)(tid >> 5) * LCTX + (tid & 31) * 8) = *(LAS const u32x4*)(OUT + (tid >> 5) * 256 + (tid & 31) * 8);
    }
    __syncthreads();
}


__device__ __forceinline__ void phase_mixers(const Args& a, int l, unsigned char* lds, int rep, bool do_mlstm, bool do_hy, bool do_hyctx) {
    LAS unsigned* qslot = (LAS unsigned*)((LAS unsigned char*)lds + (LDS_BYTES - 32));
    if (do_mlstm && (blockIdx.x & 3) == 0 && (blockIdx.x >> 2) < 64) mlstm_item(a, l, lds, blockIdx.x >> 2, rep == 0);
    unsigned* ctr = (unsigned*)(a.ws + WS_CTL) + CW_QUEUE + 64 * (l * 8 + rep);
    const int n_lat = do_hy ? 2 * DHY : 0, n_ctx = (l == 0 && do_hyctx) ? DHY : 0;
    for (;;) {
        __syncthreads();
        if (threadIdx.x == 0) *qslot = __hip_atomic_fetch_add(ctr, 1u, __ATOMIC_RELAXED, __HIP_MEMORY_SCOPE_AGENT);
        __syncthreads();
        const int item = (int)*qslot;
        if (item >= n_lat + n_ctx) break;
        if (item < n_lat) hyena_item(a, l, lds, item, rep == 0);
        else hyena_ctx_item(a, lds, item - n_lat, rep == 0);
    }
    __syncthreads();
}

__device__ __forceinline__ void phase_combine(const Args& a, int l, unsigned char* lds) {
    const int tid = opaque_tid(), G = gridDim.x, lane = tid & 63, wave = tid >> 6;
    const bf16_t* U1 = (const bf16_t*)(a.ws + WS_U1);
    const bf16_t* HDi = (const bf16_t*)(a.ws + WS_HB);
    const bf16_t* UT = (const bf16_t*)(a.ws + WS_UT);
    bf16_t* YM = (bf16_t*)(a.ws + WS_YMIX);
    bf16_t* T = (bf16_t*)lds;
    const int nblk = (l == 0 ? MT : MLAT) / 64;
    float mgv[8];
#pragma unroll
    for (int i = 0; i < 8; ++i) mgv[i] = a.in[12][l * 512 + lane * 8 + i];
    const size_t dstride = (size_t)32 * (LCTX + LSEQ) * 128;
    for (int blk = blockIdx.x; blk < nblk; blk += G) {
        const int r0 = blk * 64;
        __syncthreads();
#pragma unroll
        for (int i = 0; i < 8; ++i) { const int e = tid + i * 512, ch = e >> 3, pc = e & 7;
            *(u32x4*)(T + ch * 72 + ((pc ^ ((ch >> 3) & 7)) * 8)) = *(const u32x4*)(UT + (size_t)ch * MT + r0 + pc * 8); }
        const int cb = r0 >= MLAT ? (r0 - MLAT) >> 8 : r0 >> 12, csr0 = r0 >= MLAT ? (r0 - MLAT) & 255 : LCTX + (r0 & 4095);
        const bf16_t* hbase = HDi + ((size_t)(cb * 4 + (lane >> 4)) * (LCTX + LSEQ) + csr0) * 128 + (lane & 15) * 8;
#pragma unroll 1
        for (int rr = wave; rr < 64; rr += 16) {
            u32x4 hf[2], hb[2], ov[2], zv[2];
#pragma unroll
            for (int q = 0; q < 2; ++q) { const int r1 = rr + 8 * q; const size_t row = r0 + r1;
                hf[q] = *(const u32x4*)(hbase + (size_t)r1 * 128); hb[q] = *(const u32x4*)(hbase + (size_t)r1 * 128 + dstride);
                ov[q] = *(const u32x4*)(U1 + row * LDU1 + 1024 + lane * 8); zv[q] = *(const u32x4*)(U1 + row * LDU1 + 1536 + lane * 8); }
#pragma unroll
            for (int q = 0; q < 2; ++q) { const size_t row = r0 + rr + 8 * q;
                float hg[8]; float ss = 0.f;
#pragma unroll
                for (int i = 0; i < 4; ++i) {
                    hg[2 * i] = (bflo(hf[q][i]) + bflo(hb[q][i])) * sigmoid_f(bflo(ov[q][i]));
                    hg[2 * i + 1] = (bfhi(hf[q][i]) + bfhi(hb[q][i])) * sigmoid_f(bfhi(ov[q][i]));
                    ss += hg[2 * i] * hg[2 * i] + hg[2 * i + 1] * hg[2 * i + 1]; }
                ss += __shfl_xor(ss, 1); ss += __shfl_xor(ss, 2); ss += __shfl_xor(ss, 4); ss += __shfl_xor(ss, 8);
                const float r = rsqrtf(ss * (1.f / 128.f) + RMS_EPS);
                u32x4 o4;
#pragma unroll
                for (int i = 0; i < 4; ++i) o4[i] = pk2(hg[2 * i] * r * mgv[2 * i] * silu_f(bflo(zv[q][i])), hg[2 * i + 1] * r * mgv[2 * i + 1] * silu_f(bfhi(zv[q][i])));
                *(u32x4*)(YM + row * DM + lane * 8) = o4; }
        }
        __syncthreads();
        for (int rr = wave; rr < 64; rr += 8) {
            const int col = (((rr >> 3) ^ (lane & 7)) << 3) | (rr & 7);
            u32x4 o4;
#pragma unroll
            for (int i = 0; i < 4; ++i) o4[i] = (unsigned)T[(lane * 8 + 2 * i) * 72 + col] | ((unsigned)T[(lane * 8 + 2 * i + 1) * 72 + col] << 16);
            *(u32x4*)(YM + (size_t)(r0 + rr) * DM + 512 + lane * 8) = o4;
        }
    }
    __syncthreads();
}


#define XB_TMO      128
#define XB_XCNT(j)  (256  + 64 * (j))
#define XB_XSUB(j)  (1280 + 64 * (j))
#define XB_XGEN(j)  (2304 + 64 * (j))
#define XB_TOP      3328
#define XB_TOPGEN   3392
#define XCD_BAR_WORDS 3456
#define XB_SPIN_CAP (1u << 18)
__device__ __forceinline__ unsigned xb_ld(unsigned* p)              { return __hip_atomic_load(p, __ATOMIC_RELAXED, __HIP_MEMORY_SCOPE_AGENT); }
__device__ __forceinline__ unsigned xb_add(unsigned* p, unsigned v) { return __hip_atomic_fetch_add(p, v, __ATOMIC_RELAXED, __HIP_MEMORY_SCOPE_AGENT); }
__device__ __forceinline__ unsigned xb_xcc_id() { return (unsigned)__builtin_amdgcn_s_getreg((3 << 11) | 20) & 0xFu; }
#define XB_SPIN(cond, bar) do { unsigned _sp = 0; while (cond) { __builtin_amdgcn_s_sleep(1); \
    if ((++_sp & 255u) == 0u) { if (xb_ld(&(bar)[XB_TMO])) break; if (_sp > XB_SPIN_CAP) { atomicAdd(&(bar)[XB_TMO], 1u); break; } } } } while (0)
struct XcdBarrier { unsigned* bar; unsigned x; volatile __attribute__((address_space(3))) unsigned* st; };
__device__ __forceinline__ XcdBarrier xcd_barrier_post(unsigned* bar, volatile __attribute__((address_space(3))) unsigned* st) {
    XcdBarrier b; b.bar = bar; b.x = xb_xcc_id(); b.st = st;
    if (threadIdx.x == 0) (void)xb_add(&bar[XB_XCNT(b.x)], 1u);
    return b;
}
__device__ __forceinline__ void xcd_barrier_complete(unsigned* bar, unsigned x, unsigned& nloc, unsigned& nx) {
    const unsigned G = gridDim.x * gridDim.y * gridDim.z;
    unsigned sum, cnt, mine, sp = 0u;
    for (;;) {
        sum = 0u; cnt = 0u; mine = 0u;
#pragma unroll
        for (unsigned j = 0; j < 16; ++j) { const unsigned c = xb_ld(&bar[XB_XCNT(j)]); sum += c; cnt += (c > 0u) ? 1u : 0u; mine = (j == x) ? c : mine; }
        if (sum == G) break;
        __builtin_amdgcn_s_sleep(1);
        if ((++sp & 255u) == 0u) { if (xb_ld(&bar[XB_TMO])) break; if (sp > XB_SPIN_CAP) { atomicAdd(&bar[XB_TMO], 1u); break; } }
    }
    nloc = mine > 0u ? mine : 1u; nx = cnt > 0u ? cnt : 1u;
}
__device__ __forceinline__ void xcd_barrier(const XcdBarrier& b) {
    asm volatile("s_waitcnt vmcnt(0)" ::: "memory");
    __syncthreads();
    if (threadIdx.x == 0) {
        unsigned* bar = b.bar;
        __builtin_amdgcn_s_waitcnt(0);
        unsigned nloc = b.st[0], nx = b.st[1];
        if (nloc == 0u) { xcd_barrier_complete(bar, b.x, nloc, nx); b.st[0] = nloc; b.st[1] = nx; }
        const unsigned old = xb_add(&bar[XB_XSUB(b.x)], 1u);
        const unsigned gen = old / nloc;
        if (old + 1u == (gen + 1u) * nloc) {
            __builtin_amdgcn_fence(__ATOMIC_RELEASE, "agent");
            asm volatile("s_waitcnt vmcnt(0)" ::: "memory");
            const unsigned og = xb_add(&bar[XB_TOP], 1u);
            const unsigned tg = og / nx;
            if (og + 1u == (tg + 1u) * nx) xb_add(&bar[XB_TOPGEN], 1u);
            else XB_SPIN(xb_ld(&bar[XB_TOPGEN]) == tg, bar);
            __builtin_amdgcn_fence(__ATOMIC_ACQUIRE, "agent");
            xb_add(&bar[XB_XGEN(b.x)], 1u);
            asm volatile("s_waitcnt vmcnt(0)" ::: "memory");
        } else {
            XB_SPIN(xb_ld(&bar[XB_XGEN(b.x)]) == gen, bar);
            __builtin_amdgcn_fence(__ATOMIC_ACQUIRE, "agent");
            asm volatile("s_waitcnt vmcnt(0)" ::: "memory");
        }
    }
    __syncthreads();
}

__global__ void __launch_bounds__(NTHR, 2) fwd(Args a_) {
    extern __shared__ __attribute__((aligned(16))) unsigned char lds[];
    cg::grid_group grid = cg::this_grid();
    const int lo = a_.ph_lo, hi = a_.ph_hi; const int rp_phase = a_.rep_phase, rp_count = a_.rep_count & 255;
#define IN(k) (lo <= (k) && (k) < hi)
    volatile __attribute__((address_space(3))) unsigned* bst = (volatile __attribute__((address_space(3))) unsigned*)((__attribute__((address_space(3))) unsigned char*)lds + (LDS_BYTES - 64));
    if (threadIdx.x < 2) bst[threadIdx.x] = 0u;
    __syncthreads();
    const XcdBarrier xbar = xcd_barrier_post((unsigned*)(a_.ws + WS_CTL), bst);
    if (lo < 0) grid.sync();
#define SEAM(k) do { if (IN(k) && IN((k) + 1)) xcd_barrier(xbar); } while (0)
    if (IN(0)) _Pragma("unroll 1") for (int rep = 0, nrep = (rp_phase == 0) ? rp_count : 1; rep < nrep; ++rep) phase_prep(kargs(), lds);
    SEAM(0);
    if (IN(1)) _Pragma("unroll 1") for (int rep = 0, nrep = (rp_phase == 1) ? rp_count : 1; rep < nrep; ++rep) phase_norm(kargs(), 0, false, true, lds);
    SEAM(1);
    for (int l = 0; l < DEPTH; ++l) {
        const int p = 2 + 6 * l;
        if (IN(p)) {
            unsigned char* ws = kargs().ws;
            const bf16_t* HB = (const bf16_t*)(ws + WS_HB);
            const bf16_t* WinT = (const bf16_t*)(ws + WS_WINT) + (size_t)l * NPK * DM;
#if NAIVE_GEMM
            gemm_naive(HB, WinT, MT, NU1, DM, ws + WS_U1, NU1, 0, lds);
            gemm_naive(HB, WinT + (size_t)NU1 * DM, MT, NU2, DM, ws + WS_UT, MT, 1, lds);
#else
            DecIn d{(const char*)HB, (const char*)WinT, (char*)(ws + WS_U1), (char*)(ws + WS_UT)};
            pg8::GridOrder<DecIn> S; S.init(MT / 256, NPK / 256, gridDim.x, blockIdx.x, d);
            _Pragma("unroll 1") for (int rep = 0, nrep = (rp_phase == 2) ? rp_count : 1; rep < nrep; ++rep) pg8::gemm_phase<true>((PG8_LAS unsigned char*)lds, DM, S);
#endif
        }
        SEAM(p);
        if (IN(p + 1)) _Pragma("unroll 1") for (int rep = 0, nrep = (rp_phase == 9) ? rp_count : 1; rep < nrep; ++rep) phase_mprep(kargs(), l, lds, rep);
        SEAM(p + 1);
        if (IN(p + 2)) {
            const int nrep = (rp_phase == 3 || rp_phase == 4 || rp_phase == 5 || rp_phase == 11) ? rp_count : 1;
            _Pragma("unroll 1") for (int rep = 0; rep < nrep; ++rep)
                phase_mixers(kargs(), l, lds, rep, rep == 0 || rp_phase == 3 || rp_phase == 11, rep == 0 || rp_phase == 4 || rp_phase == 11, rep == 0 || rp_phase == 5 || rp_phase == 11);
        }
        SEAM(p + 2);
        if (IN(p + 3)) _Pragma("unroll 1") for (int rep = 0, nrep = (rp_phase == 6) ? rp_count : 1; rep < nrep; ++rep) phase_combine(kargs(), l, lds);
        SEAM(p + 3);
        if (IN(p + 4)) {
            unsigned char* ws = kargs().ws;
            const bf16_t* WoutT = (const bf16_t*)(ws + WS_WOUTT) + (size_t)l * DM * DM;
#if NAIVE_GEMM
            gemm_naive((const bf16_t*)(ws + WS_YMIX), WoutT, (l == 0) ? MT : MLAT, DM, DM, ws + WS_U1, DM, 2, lds);
#else
            DecOut d{(const char*)(ws + WS_YMIX), (const char*)WoutT, (char*)(ws + WS_U1)};
            pg8::GridOrder<DecOut> S; S.init(((l == 0) ? MT : MLAT) / 256, DM / 256, gridDim.x, blockIdx.x, d);
            _Pragma("unroll 1") for (int rep = 0, nrep = (rp_phase == 7) ? rp_count : 1; rep < nrep; ++rep) pg8::gemm_phase<true>((PG8_LAS unsigned char*)lds, DM, S);
#endif
        }
        SEAM(p + 4);
        if (IN(p + 5)) _Pragma("unroll 1") for (int rep = 0, nrep = (rp_phase == 8 && l == 0) ? rp_count : 1; rep < nrep; ++rep) phase_norm(kargs(), l + 1, true, l + 1 < DEPTH, lds);
        SEAM(p + 5);
    }
    if (rp_phase == 10) for (int rep = 0; rep < rp_count; ++rep) xcd_barrier(xbar);
#undef IN
#undef SEAM
}

constexpr int NPHASES = 2 + 6 * DEPTH;

extern "C" void kernel_launch(void* const* d_in, const int* in_sizes, int n_in, void* d_out, int out_size, void* d_ws, size_t ws_size, hipStream_t stream) {
    static int grid = 0;
    if (grid == 0) {
        if (n_in != 23 || out_size != MLAT * DM || ws_size < WS_END) { fprintf(stderr, "kernel_launch: unexpected shapes n_in %d out %d ws %zu\n", n_in, out_size, ws_size); grid = -1; return; }
        int dev = 0, cus = 0, per_cu = 0;
        (void)hipGetDevice(&dev);
        (void)hipDeviceGetAttribute(&cus, hipDeviceAttributeMultiprocessorCount, dev);
        (void)hipFuncSetAttribute((const void*)fwd, hipFuncAttributeMaxDynamicSharedMemorySize, LDS_BYTES);
        (void)hipOccupancyMaxActiveBlocksPerMultiprocessor(&per_cu, (const void*)fwd, NTHR, LDS_BYTES);
        if (per_cu < 1) per_cu = 1;
        grid = cus * per_cu;
        fprintf(stderr, "kernel_launch: cus %d per_cu %d grid %d ws %zu\n", cus, per_cu, grid, ws_size);
    }
    if (grid < 0) return;
    Args a{};
    for (int i = 0; i < 23; ++i) a.in[i] = (const float*)d_in[i];
    a.out = (float*)d_out; a.ws = (unsigned char*)d_ws;
    (void)hipMemsetAsync((char*)d_ws + WS_CTL, 0, 32768, stream);
    a.ph_lo = 0; a.ph_hi = NPHASES; a.rep_phase = PROBE_PHASE; a.rep_count = PROBE_COUNT;
    void* kargs[] = {&a};
    hipError_t e = hipLaunchCooperativeKernel((const void*)fwd, dim3(grid), dim3(NTHR), kargs, LDS_BYTES, stream);
    if (e != hipSuccess) fprintf(stderr, "kernel_launch: cooperative launch failed: %s (grid %d)\n", hipGetErrorString(e), grid);
}
```

```cpp
#include <hip/hip_runtime.h>
#include <hip/hip_cooperative_groups.h>
#include <cstdio>
#include <cstdint>
namespace cg = cooperative_groups;

constexpr int NB = 8, LSEQ = 4096, DM = 1024, LCTX = 256, DEPTH = 2;
constexpr int MLAT = NB * LSEQ, MCTX = NB * LCTX, MT = MLAT + MCTX;
constexpr int DIN = 4624, NU1 = 2560, NU2 = 2048, NPK = NU1 + NU2;
constexpr int QK8_STRIDE = (LCTX + LSEQ) * 256 + 8192;
constexpr int LDU1 = 2048;
constexpr int NH = 4, HD = 128, DML = 512, DHY = 512;
constexpr float RMS_EPS = 1e-6f;
constexpr int NTHR = 512;
constexpr int LDS_BYTES = 147456;
#ifndef PROBE_PHASE
#define PROBE_PHASE -1
#endif
#ifndef PROBE_COUNT
#define PROBE_COUNT 1
#endif
#ifndef REP_PREP
#define REP_PREP 1
#endif
#ifndef REP_NORM
#define REP_NORM 1
#endif
#ifndef REP_GEMM1
#define REP_GEMM1 1
#endif
#ifndef REP_MLSTM
#define REP_MLSTM 1
#endif
#ifndef REP_HYENA
#define REP_HYENA 1
#endif
#ifndef REP_HYCTX
#define REP_HYCTX 1
#endif
#ifndef REP_COMB
#define REP_COMB 1
#endif
#ifndef REP_GEMM2
#define REP_GEMM2 1
#endif
#ifndef NAIVE_MLSTM
#define NAIVE_MLSTM 0
#endif
#ifndef NAIVE_HYENA
#define NAIVE_HYENA 0
#endif
#ifndef NAIVE_GEMM
#define NAIVE_GEMM 0
#endif

constexpr size_t MiB = 1u << 20;
constexpr size_t WS_CTL = 0;
constexpr size_t WS_MOD = 1 * MiB;
constexpr size_t WS_HDN = 2 * MiB;
constexpr size_t WS_HDNC = 4 * MiB;
constexpr size_t WS_GATES = 5 * MiB;
constexpr size_t WS_WGT = 512 * 1024;
constexpr size_t WS_GP = 4 * MiB + 256 * 1024;
constexpr size_t WS_XC1 = 8 * MiB;
constexpr size_t WS_WINT = 16 * MiB;
constexpr size_t WS_WOUTT = 34 * MiB;
constexpr size_t WS_HB = 40 * MiB;
constexpr size_t WS_U1 = 108 * MiB;
constexpr size_t WS_V2 = 244 * MiB;
constexpr size_t WS_UT = 280 * MiB;
constexpr size_t WS_YMIX = 416 * MiB;
constexpr size_t WS_FT = 485 * MiB;
constexpr size_t WS_END = 502 * MiB;

constexpr int CW_QUEUE = 4096;

typedef unsigned short bf16_t;
typedef float f32x4 __attribute__((ext_vector_type(4)));
typedef float f32x2 __attribute__((ext_vector_type(2)));
typedef unsigned u32x4 __attribute__((ext_vector_type(4)));
typedef unsigned u32x2 __attribute__((ext_vector_type(2)));

struct Args {
    const float* in[23];
    float* out;
    unsigned char* ws;
    int ph_lo, ph_hi;
    int rep_phase, rep_count;
};

__device__ __forceinline__ float bf2f(unsigned b) { return __uint_as_float(b << 16); }
__device__ __forceinline__ unsigned f2bf(float f) { unsigned u = __float_as_uint(f); return (u + 0x7fffu + ((u >> 16) & 1u)) >> 16; }
__device__ __forceinline__ unsigned pk2(float lo, float hi) { return f2bf(lo) | (f2bf(hi) << 16); }
__device__ __forceinline__ float bflo(unsigned x) { return __uint_as_float(x << 16); }
__device__ __forceinline__ float bfhi(unsigned x) { return __uint_as_float(x & 0xffff0000u); }
__device__ __forceinline__ float silu_f(float x) { return x * __builtin_amdgcn_rcpf(1.f + __expf(-x)); }
__device__ __forceinline__ float sigmoid_f(float x) { return __builtin_amdgcn_rcpf(1.f + __expf(-x)); }
typedef const Args __attribute__((address_space(4)))* KArgsP;
__device__ __forceinline__ Args kargs() {
    int z = 0; asm volatile("" : "+s"(z));
    KArgsP p = (KArgsP)((const char __attribute__((address_space(4)))*)__builtin_amdgcn_kernarg_segment_ptr() + z);
    Args a;
#pragma unroll
    for (int i = 0; i < 23; ++i) a.in[i] = p->in[i];
    a.out = p->out; a.ws = p->ws; a.ph_lo = p->ph_lo; a.ph_hi = p->ph_hi; a.rep_phase = p->rep_phase; a.rep_count = p->rep_count;
    return a;
}
__device__ __forceinline__ int opaque_tid() { int t = threadIdx.x; asm volatile("" : "+v"(t)); return t; }
__device__ __forceinline__ float wave_sum(float v) {
#pragma unroll
    for (int o = 1; o < 64; o <<= 1) v += __shfl_xor(v, o);
    return v;
}

__device__ __forceinline__ void phase_prep(const Args& a, unsigned char* lds) {
    const int tid = opaque_tid(), G = gridDim.x;
    float* scr = (float*)lds;
    constexpr int IT_WIN = 2 * 16 * 72, IT_WOUT = 2 * 16 * 16, IT_MOD = 2 * 48, IT_HDN = 132, IT_WG = 2;
    constexpr int NIT = IT_WIN + IT_WOUT + IT_MOD + IT_HDN + IT_WG;
    bool s_loaded = false;
    for (int it = blockIdx.x; it < NIT; it += G) {
        int r = it;
        if (r < IT_WIN + IT_WOUT) {
            const float* W; bf16_t* WT; int N, kb, nb, srccol;
            if (r < IT_WIN) { const int l = r / (16 * 72); r %= 16 * 72; kb = r / 72; nb = r % 72; N = DIN;
                W = a.in[8] + (size_t)l * DM * DIN; WT = (bf16_t*)(a.ws + WS_WINT) + (size_t)l * NPK * DM; srccol = nb * 64 + (nb >= 40 ? 16 : 0); }
            else { r -= IT_WIN; const int l = r / 256; r %= 256; kb = r / 16; nb = r % 16; N = DM;
                W = a.in[22] + (size_t)l * DM * DM; WT = (bf16_t*)(a.ws + WS_WOUTT) + (size_t)l * DM * DM; srccol = nb * 64; }
            __syncthreads();
#pragma unroll
            for (int i = 0; i < 8; ++i) { const int e = tid + i * 512, kk = e >> 6, nn = e & 63; scr[kk * 65 + nn] = W[(size_t)(kb * 64 + kk) * N + srccol + nn]; }
            __syncthreads();
            { const int nn = tid >> 3, k8 = (tid & 7) * 8; u32x4 o;
              o.x = pk2(scr[(k8 + 0) * 65 + nn], scr[(k8 + 1) * 65 + nn]); o.y = pk2(scr[(k8 + 2) * 65 + nn], scr[(k8 + 3) * 65 + nn]);
              o.z = pk2(scr[(k8 + 4) * 65 + nn], scr[(k8 + 5) * 65 + nn]); o.w = pk2(scr[(k8 + 6) * 65 + nn], scr[(k8 + 7) * 65 + nn]);
              *(u32x4*)(WT + (size_t)(nb * 64 + nn) * DM + kb * 64 + k8) = o; }
            continue;
        }
        r -= IT_WIN + IT_WOUT;
        if (r < IT_MOD) {
            const int l = r / 48, cb = r % 48;
            float* S = scr + 8192;
            float* P = scr;
            __syncthreads();
            if (!s_loaded) {
                for (int i = tid; i < 9 * 1024; i += 512) { const int v = i >> 10, k = i & 1023; const float cv = (v < 8) ? a.in[1][v * 1024 + k] : a.in[3][k]; S[i] = silu_f(cv); }
                s_loaded = true;
            }
            __syncthreads();
            const int kg = tid >> 6, col = cb * 64 + (tid & 63);
            const float* W = a.in[4] + (size_t)l * DM * 3072;
            float acc[9];
#pragma unroll
            for (int v = 0; v < 9; ++v) acc[v] = 0.f;
            for (int k = kg * 128; k < kg * 128 + 128; ++k) { const float w = W[(size_t)k * 3072 + col];
#pragma unroll
                for (int v = 0; v < 9; ++v) acc[v] += S[v * 1024 + k] * w; }
#pragma unroll
            for (int v = 0; v < 9; ++v) P[(kg * 9 + v) * 64 + (tid & 63)] = acc[v];
            __syncthreads();
            for (int i = tid; i < 9 * 64; i += 512) { const int v = i >> 6, cc = i & 63; float s = a.in[5][l * 3072 + cb * 64 + cc];
#pragma unroll
                for (int g = 0; g < 8; ++g) s += P[(g * 9 + v) * 64 + cc];
                ((float*)(a.ws + WS_MOD))[(size_t)(l * 9 + v) * 3072 + cb * 64 + cc] = s; }
            continue;
        }
        r -= IT_MOD;
        if (r >= IT_HDN) {
            const int l = r - IT_HDN; const float* w = a.in[8] + (size_t)l * DM * DIN; bf16_t* wg = (bf16_t*)(a.ws + WS_WGT) + (size_t)l * 16 * 1024;
            for (int i = tid; i < 16384; i += 512) wg[(i & 15) * 1024 + (i >> 4)] = (bf16_t)f2bf(w[(size_t)(i >> 4) * DIN + 2560 + (i & 15)]);
            continue;
        }
        {
            __syncthreads();
            float* W1 = scr;
            float* W2 = scr + 17 * 64;
            float* B1 = W2 + 64 * 64; float* B2 = B1 + 64; float* F0 = B2 + 64; float* F1 = F0 + 64;
            float* FT = F1 + 64;
            float* H1 = FT + 8 * 17;
            const int lb = ((r * 64) < 8192) ? ((r * 64) >> 12) : 0;
            for (int i = tid; i < 17 * 64; i += 512) W1[i] = a.in[15][lb * 17 * 64 + i];
            for (int i = tid; i < 64 * 64; i += 512) W2[i] = a.in[18][lb * 64 * 64 + i];
            if (tid < 64) { B1[tid] = a.in[16][lb * 64 + tid]; B2[tid] = a.in[19][lb * 64 + tid]; F0[tid] = a.in[17][lb * 128 + tid]; F1[tid] = a.in[17][lb * 128 + 64 + tid]; }
            const int j = tid & 63, pg = tid >> 6;
            for (int sub = 0; sub < 8; ++sub) {
                const int p = r * 64 + sub * 8 + pg;
                const int L = (p < 8192) ? 4096 : 256; const int pos = (p < 8192) ? (p & 4095) : (p - 8192);
                __syncthreads();
                if (j < 17) { float f;
                    if (j == 0) f = (float)pos / (float)L;
                    else { const int bnd = (j <= 8) ? j : j - 8; const float ang = (6.283185307179586f / (float)L) * (float)pos * (float)bnd; f = (j <= 8) ? sinf(ang) : cosf(ang); }
                    FT[pg * 17 + j] = f; }
                __syncthreads();
                { float s = B1[j];
#pragma unroll
                  for (int f = 0; f < 17; ++f) s += FT[pg * 17 + f] * W1[f * 64 + j];
                  H1[pg * 64 + j] = sinf(F0[j] * s); }
                __syncthreads();
                { float s = B2[j];
#pragma unroll 8
                  for (int i = 0; i < 64; ++i) s += H1[pg * 64 + i] * W2[i * 64 + j];
                  float* dst = (p < 8192) ? (float*)(a.ws + WS_HDN) + (size_t)p * 64 : (float*)(a.ws + WS_HDNC) + (size_t)pos * 64;
                  dst[j] = sinf(F1[j] * s); }
            }
        }
    }
    __syncthreads();
}

__device__ __forceinline__ void phase_norm(const Args& a, int l, bool has_prev, bool do_next, unsigned char* lds) {
    const int tid = opaque_tid(), G = gridDim.x, lane = tid & 63, wave = tid >> 6;
    const float* MOD = (const float*)(a.ws + WS_MOD);
    const bf16_t* Y = (const bf16_t*)(a.ws + WS_U1);
    bf16_t* HB = (bf16_t*)(a.ws + WS_HB);
    float* XC1 = (float*)(a.ws + WS_XC1);
    const int nrows = do_next ? MT : MLAT;
    const bool from_out = !(l == 0 || (has_prev && l == 1));
    const float* xlat = from_out ? (const float*)a.out : a.in[0]; const float* xctx = a.in[2];
#define XSRC(row) (((row) >= MLAT) ? xctx + (size_t)((row) - MLAT) * DM : xlat + (size_t)(row) * DM)
    const int stride = G * 8;
    f32x4 nx[2][4]; u32x2 ny[2][4];
    int row = blockIdx.x * 8 + wave;
#pragma unroll
    for (int q = 0; q < 2; ++q) { const int rq = row + q * stride;
        if (rq < nrows) {
#pragma unroll
            for (int j = 0; j < 4; ++j) { nx[q][j] = ((const f32x4*)XSRC(rq))[lane + 64 * j]; ny[q][j] = has_prev ? ((const u32x2*)(Y + (size_t)rq * DM))[lane + 64 * j] : (u32x2){0u, 0u}; }
        } else {
#pragma unroll
            for (int j = 0; j < 4; ++j) { nx[q][j] = (f32x4){0.f, 0.f, 0.f, 0.f}; ny[q][j] = (u32x2){0u, 0u}; } } }
    for (; row < nrows; row += 2 * stride) {
        f32x4 xq[2][4]; u32x2 yq[2][4];
#pragma unroll
        for (int q = 0; q < 2; ++q)
#pragma unroll
            for (int j = 0; j < 4; ++j) { xq[q][j] = nx[q][j]; yq[q][j] = ny[q][j]; }
#pragma unroll
        for (int q = 0; q < 2; ++q) { const int rq = row + (2 + q) * stride;
            if (rq < nrows) {
#pragma unroll
                for (int j = 0; j < 4; ++j) { nx[q][j] = ((const f32x4*)XSRC(rq))[lane + 64 * j]; ny[q][j] = has_prev ? ((const u32x2*)(Y + (size_t)rq * DM))[lane + 64 * j] : (u32x2){0u, 0u}; } } }
#pragma unroll
        for (int q = 0; q < 2; ++q) {
            const int rw = row + q * stride;
            if (rw < nrows) {
                const bool is_ctx = rw >= MLAT; const int mv = is_ctx ? 8 : (rw >> 12);
                float* xout = is_ctx ? XC1 + (size_t)(rw - MLAT) * DM : a.out + (size_t)rw * DM;
                f32x4 xv[4];
#pragma unroll
                for (int j = 0; j < 4; ++j) xv[j] = xq[q][j];
                if (has_prev) {
                    const int lp = l - 1;
                    f32x4 yv[4]; float ss = 0.f;
#pragma unroll
                    for (int j = 0; j < 4; ++j) { yv[j] = (f32x4){bflo(yq[q][j].x), bfhi(yq[q][j].x), bflo(yq[q][j].y), bfhi(yq[q][j].y)}; ss += yv[j].x * yv[j].x + yv[j].y * yv[j].y + yv[j].z * yv[j].z + yv[j].w * yv[j].w; }
                    const float r = rsqrtf(wave_sum(ss) * (1.f / DM) + RMS_EPS);
#pragma unroll
                    for (int j = 0; j < 4; ++j) { const f32x4 gt = ((const f32x4*)(MOD + (size_t)(lp * 9 + mv) * 3072 + 2048))[lane + 64 * j]; const f32x4 pg = ((const f32x4*)(a.in[7] + lp * DM))[lane + 64 * j];
                        xv[j] = xv[j] + gt * (yv[j] * r * pg); ((f32x4*)xout)[lane + 64 * j] = xv[j]; }
                }
                if (do_next) {
                    float ss = 0.f;
#pragma unroll
                    for (int j = 0; j < 4; ++j) ss += xv[j].x * xv[j].x + xv[j].y * xv[j].y + xv[j].z * xv[j].z + xv[j].w * xv[j].w;
                    const float r = rsqrtf(wave_sum(ss) * (1.f / DM) + RMS_EPS);
#pragma unroll
                    for (int j = 0; j < 4; ++j) {
                        const f32x4 pg = ((const f32x4*)(a.in[6] + l * DM))[lane + 64 * j];
                        const f32x4 sh = ((const f32x4*)(MOD + (size_t)(l * 9 + mv) * 3072))[lane + 64 * j];
                        const f32x4 sc = ((const f32x4*)(MOD + (size_t)(l * 9 + mv) * 3072 + 1024))[lane + 64 * j];
                        const f32x4 h = xv[j] * r * pg * (sc + 1.f) + sh;
                        u32x2 o; o.x = pk2(h.x, h.y); o.y = pk2(h.z, h.w);
                        ((u32x2*)(HB + (size_t)rw * DM))[lane + 64 * j] = o;
                    }
                }
            }
        }
    }
#undef XSRC
    __syncthreads();
}

__device__ __forceinline__ void gemm_naive(const bf16_t* A, const bf16_t* Bt, int M, int N, int K, void* out, int ldo, int mode, unsigned char* lds) {
    const int tid = opaque_tid(), G = gridDim.x;
    float* As = (float*)lds;
    float* Bs = As + 64 * 33;
    const int ntm = M / 64, ntn = N / 64;
    const int ty = tid >> 4, tx = tid & 15;
    for (int t = blockIdx.x; t < ntm * ntn; t += G) {
        const int tm = t / ntn, tn = t % ntn;
        float acc[2][4] = {};
        for (int k0 = 0; k0 < K; k0 += 32) {
            __syncthreads();
            { const int r = tid >> 3, c4 = (tid & 7) * 4;
              const u32x2 va = *(const u32x2*)(A + (size_t)(tm * 64 + r) * K + k0 + c4);
              As[r * 33 + c4] = bf2f(va.x & 0xffff); As[r * 33 + c4 + 1] = bf2f(va.x >> 16); As[r * 33 + c4 + 2] = bf2f(va.y & 0xffff); As[r * 33 + c4 + 3] = bf2f(va.y >> 16);
              const u32x2 vb = *(const u32x2*)(Bt + (size_t)(tn * 64 + r) * K + k0 + c4);
              Bs[r * 33 + c4] = bf2f(vb.x & 0xffff); Bs[r * 33 + c4 + 1] = bf2f(vb.x >> 16); Bs[r * 33 + c4 + 2] = bf2f(vb.y & 0xffff); Bs[r * 33 + c4 + 3] = bf2f(vb.y >> 16); }
            __syncthreads();
#pragma unroll 8
            for (int kk = 0; kk < 32; ++kk) {
                const float a0 = As[(ty * 2) * 33 + kk], a1 = As[(ty * 2 + 1) * 33 + kk];
#pragma unroll
                for (int j = 0; j < 4; ++j) { const float b = Bs[(tx * 4 + j) * 33 + kk]; acc[0][j] += a0 * b; acc[1][j] += a1 * b; }
            }
        }
#pragma unroll
        for (int i = 0; i < 2; ++i)
#pragma unroll
            for (int j = 0; j < 4; ++j) { const size_t r = tm * 64 + ty * 2 + i, c = tn * 64 + tx * 4 + j;
                if (mode == 0) ((bf16_t*)out)[r * ldo + c] = (bf16_t)f2bf(acc[i][j]);
                else if (mode == 1) ((bf16_t*)out)[c * ldo + r] = (bf16_t)f2bf(acc[i][j]);
                else ((float*)out)[r * ldo + c] = acc[i][j]; }
    }
    __syncthreads();
}


namespace pg8 {
#define PG8_LAS __attribute__((address_space(3)))
typedef short bf16x8 __attribute__((ext_vector_type(8)));
constexpr int BM = 256, BK = 64, HALF = 128, HTB = HALF * BK * 2, STAGE_BYTES = 8 * HTB, NXCD = 8, WGM = 8;
__device__ __forceinline__ int lds_byte(int r, int c) { const int st = (r >> 4) * 2 + (c >> 5), rr = r & 15, cc = c & 31, ob = rr * 64 + cc * 2; return st * 1024 + (ob ^ (((ob >> 9) & 1) << 5)); }
__device__ __forceinline__ void stage_rc(int b, int& R, int& C) { const int st = b / 1024, sb = b % 1024, swz = sb ^ (((sb >> 9) & 1) << 5); R = (st >> 1) * 16 + swz / 64; C = (st & 1) * 32 + (swz % 64) / 2; }
__device__ __forceinline__ int perm32(int rho) { const int n = rho >> 4, i = rho & 15; return 8 * (i >> 2) + 4 * n + (i & 3); }
__device__ __forceinline__ unsigned cvt_pk_bf16(float lo, float hi) { unsigned r; asm volatile("v_cvt_pk_bf16_f32 %0, %1, %2" : "=v"(r) : "v"(lo), "v"(hi)); return r; }

struct Unit { const char* A; const char* B; char* out; int ldo, r0, c0, bjs; };

template <class Dec> struct GridOrder {
    int nM, nN, nwg, G, c; Dec dec;
    __device__ void init(int nM_, int nN_, int G_, int c_, const Dec& d) { nM = nM_; nN = nN_; nwg = nM * nN; G = G_; c = c_; dec = d; }
    __device__ bool next(int i, Unit& u) const {
        const long L = (long)i * G + c; if (L >= nwg) return false;
        int wgid = (int)L; { const int q = nwg / NXCD, r = nwg % NXCD, xcd = wgid % NXCD, off = wgid / NXCD; wgid = (xcd < r ? xcd * (q + 1) : r * (q + 1) + (xcd - r) * q) + off; }
        const int nig = WGM * nN, gid = wgid / nig, fm = gid * WGM, gsz = (nM - fm) < WGM ? (nM - fm) : WGM;
        const int pm = fm + ((wgid % nig) % gsz), pn = (wgid % nig) / gsz; dec(pm, pn, u); return true;
    }
};

template <bool PERM, class Sched>
__device__ __forceinline__ void gemm_phase(PG8_LAS unsigned char* lds, const int K, const Sched& S) {
    const int tid = opaque_tid(), wid = __builtin_amdgcn_readfirstlane(tid >> 6), lane = tid & 63, wr = wid >> 2, wc = wid & 3, fr = lane & 15, fq = lane >> 4;
    const int nt = K / BK;
    unsigned voffA[2], voffB[2];
#pragma unroll
    for (int i = 0; i < 2; ++i) { int R, C; stage_rc(tid * 16 + i * 8192, R, C); const int Rb = PERM ? ((R & ~31) + perm32(R & 31)) : R;
        voffA[i] = (unsigned)(R * K + C) * 2u; voffB[i] = (unsigned)(Rb * K + C) * 2u; }
    const size_t kstep = (size_t)(BK * 2);
    const size_t hstep = (size_t)HALF * K * 2;
    const unsigned ldsw = (unsigned)wid * 1024u;
    const int aoff = lds_byte(wr * 64 + fr, fq * 8), boff = lds_byte(wc * 32 + fr, fq * 8);
#define PG8_SA(b, h) (((b) * 2 + (h)) * HTB)
#define PG8_SB(b, h) ((4 + (b) * 2 + (h)) * HTB)
#define PG8_STAGE(bufoff, gbase, voff) do { _Pragma("unroll") for (int _i = 0; _i < 2; ++_i) \
        __builtin_amdgcn_global_load_lds((const unsigned*)((const char*)(gbase) + (voff)[_i]), (PG8_LAS unsigned*)(lds + (bufoff) + ldsw + _i * 8192), 16, 0, 0); } while (0)
#define PG8_LDA(dst, b, h) do { _Pragma("unroll") for (int m = 0; m < 4; ++m) _Pragma("unroll") for (int k = 0; k < 2; ++k) dst[m][k] = *(const PG8_LAS bf16x8*)(lds + PG8_SA(b, h) + aoff + m * 2048 + k * 1024); } while (0)
#define PG8_LDB(dst, b, h) do { _Pragma("unroll") for (int n = 0; n < 2; ++n) _Pragma("unroll") for (int k = 0; k < 2; ++k) dst[n][k] = *(const PG8_LAS bf16x8*)(lds + PG8_SB(b, h) + boff + n * 2048 + k * 1024); } while (0)
#define PG8_MMA(ai, bj, At, Bt) do { __builtin_amdgcn_s_setprio(1); _Pragma("unroll") for (int m = 0; m < 4; ++m) _Pragma("unroll") for (int n = 0; n < 2; ++n) _Pragma("unroll") for (int k = 0; k < 2; ++k) \
        acc[ai][bj][m][n] = __builtin_amdgcn_mfma_f32_16x16x32_bf16(Bt[n][k], At[m][k], acc[ai][bj][m][n], 0, 0, 0); __builtin_amdgcn_s_setprio(0); } while (0)
#define PG8_WAIT_V(n) asm volatile("s_waitcnt vmcnt(" #n ")" ::: "memory")
#define PG8_WAIT_L(n) asm volatile("s_waitcnt lgkmcnt(" #n ")" ::: "memory")
#define PG8_BAR __builtin_amdgcn_s_barrier()
#define PG8_SCHED __builtin_amdgcn_sched_barrier(0)
    Unit cur, nxt; int ui = 0;
    if (!S.next(0, cur)) return;
    f32x4 acc[2][2][4][2];
#pragma unroll
    for (int a = 0; a < 2; ++a)
#pragma unroll
        for (int b = 0; b < 2; ++b)
#pragma unroll
            for (int m = 0; m < 4; ++m)
#pragma unroll
                for (int n = 0; n < 2; ++n) acc[a][b][m][n] = (f32x4){0.f, 0.f, 0.f, 0.f};
    bf16x8 At[4][2], B0[2][2], B1[2][2];
    const char* cA = cur.A; const char* cB = cur.B;
    PG8_STAGE(PG8_SB(0, 0), cB, voffB); PG8_STAGE(PG8_SA(0, 0), cA, voffA); PG8_STAGE(PG8_SB(0, 1), cB + hstep, voffB); PG8_STAGE(PG8_SA(0, 1), cA + hstep, voffA);
    if (wr == 1) PG8_BAR;
    PG8_WAIT_V(4); PG8_BAR;
    PG8_STAGE(PG8_SB(1, 0), cB + kstep, voffB); PG8_STAGE(PG8_SA(1, 0), cA + kstep, voffA); PG8_STAGE(PG8_SB(1, 1), cB + hstep + kstep, voffB);
    PG8_WAIT_V(6); PG8_BAR;
    for (;;) {
        const bool has_next = S.next(ui + 1, nxt);
        const char* nA = has_next ? nxt.A : cA; const char* nB = has_next ? nxt.B : cB;
        for (int t = 0; t < nt; t += 2) {
            const bool last = (t == nt - 2);
            const char* a1 = cA + (size_t)(t + 1) * kstep;
            const char* a2 = last ? nA : cA + (size_t)(t + 2) * kstep; const char* b2 = last ? nB : cB + (size_t)(t + 2) * kstep;
            const char* a3 = a2 + kstep; const char* b3 = b2 + kstep;
            PG8_LDB(B0, 0, 0); PG8_SCHED; PG8_LDA(At, 0, 0); PG8_STAGE(PG8_SA(1, 1), a1 + hstep, voffA);
            PG8_WAIT_L(8); PG8_BAR; PG8_WAIT_L(0); PG8_MMA(0, 0, At, B0); PG8_BAR; PG8_SCHED;
            PG8_LDB(B1, 0, 1); PG8_STAGE(PG8_SB(0, 0), b2, voffB);
            PG8_BAR; PG8_WAIT_L(0); PG8_MMA(0, 1, At, B1); PG8_BAR;
            PG8_LDA(At, 0, 1); PG8_STAGE(PG8_SA(0, 0), a2, voffA);
            PG8_BAR; PG8_WAIT_L(0); PG8_MMA(1, 0, At, B0); PG8_BAR; PG8_SCHED;
            PG8_STAGE(PG8_SB(0, 1), b2 + hstep, voffB);
            PG8_WAIT_V(6); PG8_BAR; PG8_MMA(1, 1, At, B1); PG8_BAR;
            PG8_LDB(B0, 1, 0); PG8_SCHED; PG8_LDA(At, 1, 0); PG8_STAGE(PG8_SA(0, 1), a2 + hstep, voffA);
            PG8_WAIT_L(8); PG8_BAR; PG8_WAIT_L(0); PG8_MMA(0, 0, At, B0); PG8_BAR; PG8_SCHED;
            PG8_LDB(B1, 1, 1); PG8_STAGE(PG8_SB(1, 0), b3, voffB);
            PG8_BAR; PG8_WAIT_L(0); PG8_MMA(0, 1, At, B1); PG8_BAR;
            PG8_LDA(At, 1, 1); PG8_STAGE(PG8_SA(1, 0), a3, voffA);
            PG8_BAR; PG8_WAIT_L(0); PG8_MMA(1, 0, At, B0); PG8_BAR; PG8_SCHED;
            PG8_STAGE(PG8_SB(1, 1), b3 + hstep, voffB);
            PG8_WAIT_V(6); PG8_BAR; PG8_MMA(1, 1, At, B1); PG8_BAR;
        }
        {
            const int row0 = cur.r0 + wr * 64 + fr;
            if (PERM) {
                bf16_t* base = (bf16_t*)cur.out; const int col0 = cur.c0 + wc * 32 + 8 * fq;
#pragma unroll
                for (int ai = 0; ai < 2; ++ai)
#pragma unroll
                    for (int m = 0; m < 4; ++m) { bf16_t* rowp = base + (size_t)(row0 + ai * HALF + m * 16) * cur.ldo + col0;
#pragma unroll
                        for (int bj = 0; bj < 2; ++bj) { const f32x4 v0 = acc[ai][bj][m][0], v1 = acc[ai][bj][m][1];
                            u32x4 w; w.x = cvt_pk_bf16(v0[0], v0[1]); w.y = cvt_pk_bf16(v0[2], v0[3]); w.z = cvt_pk_bf16(v1[0], v1[1]); w.w = cvt_pk_bf16(v1[2], v1[3]);
                            *(u32x4*)(rowp + bj * cur.bjs) = w; } }
            } else {
                float* base = (float*)cur.out; const int col0 = cur.c0 + wc * 32 + 4 * fq;
#pragma unroll
                for (int ai = 0; ai < 2; ++ai)
#pragma unroll
                    for (int m = 0; m < 4; ++m) { float* rowp = base + (size_t)(row0 + ai * HALF + m * 16) * cur.ldo + col0;
#pragma unroll
                        for (int bj = 0; bj < 2; ++bj)
#pragma unroll
                            for (int n = 0; n < 2; ++n) *(f32x4*)(rowp + bj * cur.bjs + n * 16) = acc[ai][bj][m][n]; }
            }
        }
        if (!has_next) break;
#pragma unroll
        for (int a = 0; a < 2; ++a)
#pragma unroll
            for (int b = 0; b < 2; ++b)
#pragma unroll
                for (int m = 0; m < 4; ++m)
#pragma unroll
                    for (int n = 0; n < 2; ++n) acc[a][b][m][n] = (f32x4){0.f, 0.f, 0.f, 0.f};
        cur = nxt; cA = nA; cB = nB; ++ui;
    }
    PG8_WAIT_V(0);
    if (wr == 0) PG8_BAR;
    PG8_BAR;
#undef PG8_SA
#undef PG8_SB
#undef PG8_STAGE
#undef PG8_LDA
#undef PG8_LDB
#undef PG8_MMA
#undef PG8_WAIT_V
#undef PG8_WAIT_L
#undef PG8_BAR
#undef PG8_SCHED
}
}

struct DecIn {
    const char* HB; const char* W; char* U1; char* UT;
    __device__ void operator()(int pm, int pn, pg8::Unit& u) const {
        const char* tp = HB + (size_t)pm * 256 * DM * 2; const char* wp = W + (size_t)pn * 256 * DM * 2;
        u.bjs = 128;
        if (pn < 4) { u.A = tp; u.B = wp; u.out = U1; u.ldo = LDU1; u.r0 = pm * 256; u.c0 = pn * 256; }
        else if (pn < 6) {
            const int bb = pm < 128 ? pm >> 4 : pm - 128, srow0 = pm < 128 ? LCTX + (pm & 15) * 256 : 0;
            u.A = tp; u.B = wp; u.out = U1 + (WS_V2 - WS_U1) + ((size_t)(bb * 4 + 2 * (pn - 4)) * (LCTX + LSEQ) + srow0) * 128 * 2; u.ldo = 128; u.r0 = 0; u.c0 = 0; u.bjs = (LCTX + LSEQ) * 128; }
        else if (pn < 10) { u.A = tp; u.B = wp; u.out = U1; u.ldo = LDU1; u.r0 = pm * 256; u.c0 = (pn - 2) * 256; }
        else { u.A = wp; u.B = tp; u.out = UT; u.ldo = MT; u.r0 = (pn - 10) * 256; u.c0 = pm * 256; }
    }
};
struct DecOut {
    const char* YM; const char* W; char* Y;
    __device__ void operator()(int pm, int pn, pg8::Unit& u) const {
        u.A = YM + (size_t)pm * 256 * DM * 2; u.B = W + (size_t)pn * 256 * DM * 2; u.out = Y; u.ldo = DM; u.r0 = pm * 256; u.c0 = pn * 256; u.bjs = 128;
    }
};

__device__ __forceinline__ void mlstm_naive(const Args& a, int l, unsigned char* lds) {
    const int tid = opaque_tid(), G = gridDim.x;
    const bf16_t* U1 = (const bf16_t*)(a.ws + WS_U1);
    const float* GATES = (const float*)(a.ws + WS_GATES);
    bf16_t* HDo = (bf16_t*)(a.ws + WS_HB);
    float* qs = (float*)lds; float* ks = qs + 128; float* vs = ks + 128; float* sc = vs + 32;
    float* pnum = sc + 8;
    float* pden = pnum + 512;
    const float* cw = a.in[10] + (size_t)l * 3 * 1024; const float* cb = a.in[11] + (size_t)l * 1024;
    for (int it = blockIdx.x; it < 256; it += G) {
        const int dvs = it & 3, dir = (it >> 2) & 1, hh = (it >> 3) & 3, b = it >> 5;
        float C[8], nn[8];
#pragma unroll
        for (int i = 0; i < 8; ++i) { C[i] = 0.f; nn[i] = 0.f; }
        float m = 0.f;
        const int j = tid & 31, dg = tid >> 5;
        for (int step = 0; step < LCTX + LSEQ; ++step) {
            int seqlen, tt, rowbase; bool is_ctx = step < LCTX;
            if (is_ctx) { seqlen = LCTX; tt = dir ? (LCTX - 1 - step) : step; rowbase = MLAT + b * LCTX; }
            else { seqlen = LSEQ; const int s2 = step - LCTX; tt = dir ? (LSEQ - 1 - s2) : s2; rowbase = b * LSEQ; }
            const int row = rowbase + tt;
            if (tid < 256) {
                const int ch = (tid < 128) ? (hh * 128 + tid) : (512 + hh * 128 + (tid - 128));
                bool has_l, has_r;
                if (is_ctx) { has_l = tt > 0; has_r = tt < seqlen - 1; } else { has_l = (tt & 63) != 0; has_r = (tt & 63) != 63; }
                float v = bf2f(U1[(size_t)row * NU1 + ch]) * cw[1024 + ch] + cb[ch];
                if (has_l) v += bf2f(U1[(size_t)(row - 1) * NU1 + ch]) * cw[ch];
                if (has_r) v += bf2f(U1[(size_t)(row + 1) * NU1 + ch]) * cw[2048 + ch];
                v = silu_f(v);
                if (tid < 128) qs[tid] = v; else ks[tid - 128] = v * 0.08838834764831845f;
            } else if (tid < 288) {
                vs[tid - 256] = bf2f(U1[(size_t)row * NU1 + 1024 + hh * 128 + dvs * 32 + (tid - 256)]);
            } else if (tid == 288) {
                const float ip = GATES[(size_t)row * 16 + (2 * dir) * 4 + hh], fp = GATES[(size_t)row * 16 + (2 * dir + 1) * 4 + hh];
                const float logf = fminf(fp, 0.f) - log1pf(__expf(-fabsf(fp)));
                const float mn = fmaxf(logf + m, ip);
                sc[0] = __expf(logf + m - mn); sc[1] = __expf(ip - mn); sc[2] = __expf(-mn);
                m = mn;
            }
            __syncthreads();
            const float fw = sc[0], iw = sc[1];
            float pn = 0.f, pd = 0.f;
#pragma unroll
            for (int dd = 0; dd < 8; ++dd) { const int d = dg * 8 + dd; const float kk = ks[d], qq = qs[d];
                C[dd] = fw * C[dd] + iw * kk * vs[j]; nn[dd] = fw * nn[dd] + iw * kk; pn += qq * C[dd]; pd += qq * nn[dd]; }
            pnum[dg * 32 + j] = pn; if (j == 0) pden[dg] = pd;
            __syncthreads();
            if (tid < 32) { float num = 0.f, den = 0.f;
#pragma unroll
                for (int g = 0; g < 16; ++g) { num += pnum[g * 32 + tid]; den += pden[g]; }
                const float h = num / fmaxf(fabsf(den), sc[2]);
                HDo[((size_t)dir * MT + row) * DML + hh * 128 + dvs * 32 + tid] = (bf16_t)f2bf(h); }
        }
        __syncthreads();
    }
}


#define LAS __attribute__((address_space(3)))
typedef short bf16x8 __attribute__((ext_vector_type(8)));
__device__ __forceinline__ u32x4 ldg16_or_zero(const bf16_t* p, bool ok) { u32x4 z = {0u, 0u, 0u, 0u}; return ok ? *(const u32x4*)p : z; }


__device__ __forceinline__ void filt_item(const Args& a, int l, unsigned char* lds_, int fi);
__device__ __forceinline__ void phase_mprep(const Args& a, int l, unsigned char* lds_, int rep) {
    const int tid = opaque_tid(), lane = tid & 63, wave = __builtin_amdgcn_readfirstlane(tid >> 6), fr = lane & 15, fq = lane >> 4;
    LAS float* P = (LAS float*)lds_;
    LAS float* Gs = P + 2048;
    LAS bf16_t* WgS = (LAS bf16_t*)((LAS unsigned char*)lds_ + 32768);
    LAS unsigned* qslot = (LAS unsigned*)((LAS unsigned char*)lds_ + (LDS_BYTES - 32));
    const bf16_t* U1 = (const bf16_t*)(a.ws + WS_U1);
    const bf16_t* HB = (const bf16_t*)(a.ws + WS_HB);
    const bf16_t* WgT = (const bf16_t*)(a.ws + WS_WGT) + (size_t)l * 16 * 1024;
    bf16_t* QK = (bf16_t*)(a.ws + WS_YMIX);
    float* GP = (float*)(a.ws + WS_GP);
    const float* cw = a.in[10] + (size_t)l * 3072; const float* cb = a.in[11] + (size_t)l * 1024;
    unsigned* ctr = (unsigned*)(a.ws + WS_CTL) + CW_QUEUE + 64 * (16 + l * 8 + rep);
    const int co = tid & 127, rg4 = tid >> 7;
    __syncthreads();
    for (int i = tid; i < 16 * 128; i += NTHR) { const int g = i >> 7, c8 = (i & 127) * 8; *(LAS u32x4*)(WgS + g * 1032 + c8) = *(const u32x4*)(WgT + g * 1024 + c8); }
    for (;;) {
        __syncthreads();
        if (tid == 0) *qslot = __hip_atomic_fetch_add(ctr, 1u, __ATOMIC_RELAXED, __HIP_MEMORY_SCOPE_AGENT);
        __syncthreads();
        const int item = (int)*qslot;
        if (item >= 128 + MT / 64) break;
        if (item < 128) { filt_item(a, l, lds_, item); continue; }
        const int ch = item - 128;
        const int rowbase = ch * 64;
        const bool is_ctx = rowbase >= MLAT; const int cc = is_ctx ? ((rowbase - MLAT) >> 6) & 3 : 0;
        const bool has_lo = is_ctx && cc > 0, has_hi = is_ctx && cc < 3;
        {
            const int rt = wave & 3, kh = wave >> 2;
            f32x4 acc = {0.f, 0.f, 0.f, 0.f};
            const bf16_t* ap = HB + (size_t)(rowbase + rt * 16 + fr) * DM + kh * 512 + fq * 8;
            LAS const bf16_t* bp = WgS + fr * 1032 + kh * 512 + fq * 8;
            bf16x8 af[16];
#pragma unroll
            for (int ks = 0; ks < 16; ++ks) af[ks] = *(const bf16x8*)(ap + ks * 32);
#pragma unroll
            for (int ks = 0; ks < 16; ++ks) { const bf16x8 bf = *(const LAS bf16x8*)(bp + ks * 32); acc = __builtin_amdgcn_mfma_f32_16x16x32_bf16(af[ks], bf, acc, 0, 0, 0); }
#pragma unroll
            for (int jj = 0; jj < 4; ++jj) P[(kh * 64 + rt * 16 + 4 * fq + jj) * 16 + fr] = acc[jj];
        }
        {
            float w0[8], w1[8], w2[8], bb[8];
#pragma unroll
            for (int e = 0; e < 8; ++e) { w0[e] = cw[co * 8 + e]; w1[e] = cw[1024 + co * 8 + e]; w2[e] = cw[2048 + co * 8 + e]; bb[e] = cb[co * 8 + e]; }
            u32x4 r0, r1, r2;
            { const int tt = rg4 * 16 - 1; r0 = ldg16_or_zero(U1 + (size_t)(rowbase + tt) * LDU1 + co * 8, tt >= 0 || has_lo); }
            r1 = *(const u32x4*)(U1 + (size_t)(rowbase + rg4 * 16) * LDU1 + co * 8);
            const int qb = is_ctx ? (rowbase - MLAT) >> 8 : rowbase >> 12, srow0 = is_ctx ? (rowbase - MLAT) & 255 : LCTX + (rowbase & 4095);
            unsigned char* qdst = (unsigned char*)QK + (size_t)(qb * 4 + ((co & 63) >> 4)) * QK8_STRIDE + (size_t)srow0 * 256 + (co >> 6) * 128 + (co & 15) * 8;
#pragma unroll 4
            for (int i = 0; i < 16; ++i) { const int tt = rg4 * 16 + i;
                r2 = ldg16_or_zero(U1 + (size_t)(rowbase + tt + 1) * LDU1 + co * 8, tt + 1 <= 63 || has_hi);
                float fv[8];
#pragma unroll
                for (int e2 = 0; e2 < 4; ++e2) {
                    fv[2 * e2] = silu_f(bflo(r0[e2]) * w0[2 * e2] + bflo(r1[e2]) * w1[2 * e2] + bflo(r2[e2]) * w2[2 * e2] + bb[2 * e2]);
                    fv[2 * e2 + 1] = silu_f(bfhi(r0[e2]) * w0[2 * e2 + 1] + bfhi(r1[e2]) * w1[2 * e2 + 1] + bfhi(r2[e2]) * w2[2 * e2 + 1] + bb[2 * e2 + 1]); }
                int p0 = 0, p1 = 0;
                p0 = __builtin_amdgcn_cvt_pk_fp8_f32(fv[0], fv[1], p0, false); p0 = __builtin_amdgcn_cvt_pk_fp8_f32(fv[2], fv[3], p0, true);
                p1 = __builtin_amdgcn_cvt_pk_fp8_f32(fv[4], fv[5], p1, false); p1 = __builtin_amdgcn_cvt_pk_fp8_f32(fv[6], fv[7], p1, true);
                *(u32x2*)(qdst + (size_t)tt * 256) = (u32x2){(unsigned)p0, (unsigned)p1};
                r0 = r1; r1 = r2; }
        }
        __syncthreads();
        for (int i = tid; i < 1024; i += NTHR) Gs[i] = P[i] + P[1024 + i] + a.in[9][l * 16 + (i & 15)];
        __syncthreads();
        {
            const int dir = wave >> 2, hh = wave & 3, tt = dir ? 63 - lane : lane;
            const float gi = Gs[tt * 16 + (2 * dir) * 4 + hh], gf = Gs[tt * 16 + (2 * dir + 1) * 4 + hh];
            const float logf = fminf(gf, 0.f) - log1pf(__expf(-fabsf(gf)));
            float bc = logf;
#pragma unroll
            for (int ofs = 1; ofs < 64; ofs <<= 1) { const float t = __shfl_up(bc, ofs); if (lane >= ofs) bc += t; }
            const float av = gi - bc;
            float cm = av;
#pragma unroll
            for (int ofs = 1; ofs < 64; ofs <<= 1) { const float t = __shfl_up(cm, ofs); if (lane >= ofs) cm = fmaxf(cm, t); }
            float* gp = GP + ((size_t)ch * 8 + wave) * 192;
            gp[lane] = bc; gp[64 + lane] = av; gp[128 + lane] = cm;
        }
    }
    __syncthreads();
}

__device__ __forceinline__ void dec16_fp8(const u32x4 raw, float (&f)[16]) {
#pragma unroll
    for (int e = 0; e < 4; ++e) { const f32x2 lo = __builtin_amdgcn_cvt_pk_f32_fp8((int)raw[e], false), hi = __builtin_amdgcn_cvt_pk_f32_fp8((int)raw[e], true);
        f[4 * e] = lo.x; f[4 * e + 1] = lo.y; f[4 * e + 2] = hi.x; f[4 * e + 3] = hi.y; }
}
__device__ __forceinline__ void mlstm_item(const Args& a, int l, unsigned char* lds_, int it, bool do_store) {
    const int tid = opaque_tid(), lane = tid & 63, wave = __builtin_amdgcn_readfirstlane(tid >> 6), fr = lane & 15, fq = lane >> 4;
    LAS unsigned char* lds = (LAS unsigned char*)lds_;
    LAS bf16_t* Qs = (LAS bf16_t*)(lds);
    LAS bf16_t* Ks = (LAS bf16_t*)(lds + 17408);
    LAS bf16_t* KTs = (LAS bf16_t*)(lds + 34816);
    LAS bf16_t* VTs = (LAS bf16_t*)(lds + 53248);
    LAS bf16_t* Ss = (LAS bf16_t*)(lds + 73984);
    LAS bf16_t* CTs = (LAS bf16_t*)(lds + 83200);
    LAS float* F = (LAS float*)(lds + 122368);
    LAS float* Aa = F; LAS float* Gg = F + 64; LAS float* WI = F + 128; LAS float* EM = F + 192;
    const unsigned char* QK8 = (const unsigned char*)(a.ws + WS_YMIX);
    const bf16_t* V2 = (const bf16_t*)(a.ws + WS_V2);
    const float* GP = (const float*)(a.ws + WS_GP);
    bf16_t* HDo = (bf16_t*)(a.ws + WS_HB);
    const int dir = it & 1, hh = (it >> 1) & 3, b = it >> 3;
    const int c16 = wave * 16;
    const int rpos = dir ? 63 - lane : lane;
    __syncthreads();
    for (int i = tid; i < 144 * 136 / 2; i += NTHR) ((LAS unsigned*)CTs)[i] = 0u;
    for (int i = tid; i < 16 * 72 / 2; i += NTHR) ((LAS unsigned*)(VTs + 128 * 72))[i] = (i < 36) ? 0x3f803f80u : 0u;
    f32x4 accC[2][5];
#pragma unroll
    for (int dd = 0; dd < 2; ++dd)
#pragma unroll
        for (int j = 0; j < 5; ++j) accC[dd][j] = (f32x4){0.f, 0.f, 0.f, 0.f};
    float m_prev = 0.f;
    struct OpSet { u32x4 rq8, rk8, v0, v1; float ga, gbc, gav, gcm, g_bl, g_cm63; };
    auto chunk_rowbase = [&](int cs) -> int {
        const bool is_ctx = cs < 4; const int cc = is_ctx ? (dir ? 3 - cs : cs) : (dir ? 63 - (cs - 4) : cs - 4);
        return is_ctx ? MLAT + b * LCTX + cc * 64 : b * LSEQ + cc * 64; };
    auto prefetch = [&](int cs_, OpSet& o) {
        const int cs = cs_ < 68 ? cs_ : 67;
        const int rowbase = chunk_rowbase(cs);
        const int srow0 = (rowbase >= MLAT) ? (rowbase - MLAT) & 255 : LCTX + (rowbase & 4095);
        const unsigned char* qp = QK8 + (size_t)(b * 4 + hh) * QK8_STRIDE + (size_t)(srow0 + lane) * 256 + c16;
        o.rq8 = *(const u32x4*)qp; o.rk8 = *(const u32x4*)(qp + 128);
        const bf16_t* vp = V2 + ((size_t)(b * 4 + hh) * (LCTX + LSEQ) + srow0 + lane) * 128 + c16;
        o.v0 = *(const u32x4*)vp; o.v1 = *(const u32x4*)(vp + 8);
        const float* gp = GP + ((size_t)(rowbase >> 6) * 8 + dir * 4 + hh) * 192;
        o.g_bl = gp[63]; o.g_cm63 = gp[128 + 63]; o.ga = gp[64 + rpos];
        o.gbc = gp[lane]; o.gav = gp[64 + lane]; o.gcm = gp[128 + lane];
    };
    OpSet os0, os1, os2;
    prefetch(0, os0); prefetch(1, os1); prefetch(2, os2);
    __syncthreads();
    u32x2 hold[4]; int hold_row = -1;
#pragma unroll
    for (int j = 0; j < 4; ++j) hold[j] = (u32x2){0u, 0u};
    auto flush = [&]() {
        if (hold_row >= 0 && do_store) { bf16_t* op = HDo + (((size_t)dir * 32 + b * 4 + hh) * (LCTX + LSEQ) + hold_row) * 128 + (wave >> 2) * 64 + 4 * fq;
#pragma unroll
            for (int j = 0; j < 4; ++j) *(u32x2*)(op + j * 16) = hold[j]; } };
    auto step = [&](const int cs, OpSet& o) {
        const int rowbase = chunk_rowbase(cs);
        const u32x4 rq8 = o.rq8, rk8 = o.rk8; u32x4 vraw[2]; vraw[0] = o.v0; vraw[1] = o.v1;
        const float ga = o.ga, gbc = o.gbc, gav = o.gav, gcm = o.gcm, g_bl = o.g_bl, g_cm63 = o.g_cm63;
        const float g63 = fmaxf(m_prev, g_cm63), wc = __expf(m_prev - g63);
        {
            float f[16];
            dec16_fp8(rq8, f);
            { u32x4 w0, w1;
#pragma unroll
              for (int e = 0; e < 4; ++e) { w0[e] = pg8::cvt_pk_bf16(f[2 * e], f[2 * e + 1]); w1[e] = pg8::cvt_pk_bf16(f[8 + 2 * e], f[8 + 2 * e + 1]); }
              *(LAS u32x4*)(Qs + rpos * 136 + c16) = w0; *(LAS u32x4*)(Qs + rpos * 136 + c16 + 8) = w1; }
            dec16_fp8(rk8, f);
            { u32x4 w0, w1;
#pragma unroll
              for (int e = 0; e < 16; ++e) f[e] *= 0.08838834764831845f;
#pragma unroll
              for (int e = 0; e < 4; ++e) { w0[e] = pg8::cvt_pk_bf16(f[2 * e], f[2 * e + 1]); w1[e] = pg8::cvt_pk_bf16(f[8 + 2 * e], f[8 + 2 * e + 1]); }
              *(LAS u32x4*)(Ks + rpos * 136 + c16) = w0; *(LAS u32x4*)(Ks + rpos * 136 + c16 + 8) = w1;
              const float ws = __expf(ga - g63);
#pragma unroll
              for (int e = 0; e < 8; ++e) { const unsigned pw = pg8::cvt_pk_bf16(f[2 * e] * ws, f[2 * e + 1] * ws);
                  KTs[(c16 + 2 * e) * 72 + rpos] = (bf16_t)(pw & 0xffffu); KTs[(c16 + 2 * e + 1) * 72 + rpos] = (bf16_t)(pw >> 16); } }
#pragma unroll
            for (int h2 = 0; h2 < 2; ++h2)
#pragma unroll
                for (int e2 = 0; e2 < 4; ++e2) { VTs[(c16 + h2 * 8 + 2 * e2) * 72 + rpos] = (bf16_t)(vraw[h2][e2] & 0xffffu); VTs[(c16 + h2 * 8 + 2 * e2 + 1) * 72 + rpos] = (bf16_t)(vraw[h2][e2] >> 16); }
            if (wave == 7) { const float g = fmaxf(m_prev, gcm); Aa[lane] = gav; Gg[lane] = g; WI[lane] = __expf(m_prev - g); EM[lane] = __expf(-(gbc + g)); }
        }
        m_prev = g_bl + g63;
        flush();
        prefetch(cs + 3, o);
        __syncthreads();
        {
            const int tb = wave >> 1;
#pragma unroll
            for (int q2 = 0; q2 < 2; ++q2) {
                const int sb = (wave & 1) * 2 + q2;
                f32x4 acc = {0.f, 0.f, 0.f, 0.f};
                if (sb <= tb) {
                    bf16x8 kf[4], qf[4];
#pragma unroll
                    for (int ks = 0; ks < 4; ++ks) { kf[ks] = *(const LAS bf16x8*)(Ks + (sb * 16 + fr) * 136 + ks * 32 + fq * 8); qf[ks] = *(const LAS bf16x8*)(Qs + (tb * 16 + fr) * 136 + ks * 32 + fq * 8); }
#pragma unroll
                    for (int ks = 0; ks < 4; ++ks) acc = __builtin_amdgcn_mfma_f32_16x16x32_bf16(kf[ks], qf[ks], acc, 0, 0, 0);
                    const int t = tb * 16 + fr, s0 = sb * 16 + 4 * fq; const float g = Gg[t];
                    const f32x4 av = *(const LAS f32x4*)(Aa + s0);
#pragma unroll
                    for (int jj = 0; jj < 4; ++jj) acc[jj] = (s0 + jj <= t) ? acc[jj] * __expf(av[jj] - g) : 0.f;
                }
                u32x2 w; w.x = pg8::cvt_pk_bf16(acc[0], acc[1]); w.y = pg8::cvt_pk_bf16(acc[2], acc[3]);
                *(LAS u32x2*)(Ss + (tb * 16 + fr) * 72 + sb * 16 + 4 * fq) = w;
            }
        }
        __syncthreads();
        {
            const int tb = wave & 3, half = wave >> 2, t = tb * 16 + fr;
            f32x4 acc[5];
#pragma unroll
            for (int j = 0; j < 5; ++j) acc[j] = (f32x4){0.f, 0.f, 0.f, 0.f};
#pragma unroll
            for (int ks = 0; ks < 4; ++ks) {
                const bf16x8 qf = *(const LAS bf16x8*)(Qs + t * 136 + ks * 32 + fq * 8);
#pragma unroll
                for (int j = 0; j < 5; ++j) { const int jrow = (j < 4) ? (half * 4 + j) * 16 : 128;
                    const bf16x8 cf = *(const LAS bf16x8*)(CTs + (jrow + fr) * 136 + ks * 32 + fq * 8);
                    acc[j] = __builtin_amdgcn_mfma_f32_16x16x32_bf16(cf, qf, acc[j], 0, 0, 0); }
            }
            const float wi = WI[t];
#pragma unroll
            for (int j = 0; j < 5; ++j) acc[j] = acc[j] * wi;
            bf16x8 vkeep[2][5];
#pragma unroll
            for (int ks = 0; ks < 2; ++ks) {
                const bf16x8 sf = *(const LAS bf16x8*)(Ss + t * 72 + ks * 32 + fq * 8);
#pragma unroll
                for (int j = 0; j < 5; ++j) { const int jrow = (j < 4) ? (half * 4 + j) * 16 : 128;
                    vkeep[ks][j] = *(const LAS bf16x8*)(VTs + (jrow + fr) * 72 + ks * 32 + fq * 8);
                    acc[j] = __builtin_amdgcn_mfma_f32_16x16x32_bf16(vkeep[ks][j], sf, acc[j], 0, 0, 0); }
            }
            const float den = __shfl(acc[4][0], fr);
            const float inv = __builtin_amdgcn_rcpf(fmaxf(fabsf(den), EM[t]));
#pragma unroll
            for (int j = 0; j < 4; ++j) { hold[j].x = pg8::cvt_pk_bf16(acc[j][0] * inv, acc[j][1] * inv); hold[j].y = pg8::cvt_pk_bf16(acc[j][2] * inv, acc[j][3] * inv); }
            hold_row = ((rowbase >= MLAT) ? (rowbase - MLAT) & 255 : LCTX + (rowbase & 4095)) + (dir ? 63 - t : t);
            const int dt0 = (wave & 3) * 2;
#pragma unroll
            for (int dd = 0; dd < 2; ++dd)
#pragma unroll
                for (int j = 0; j < 5; ++j) accC[dd][j] = accC[dd][j] * wc;
#pragma unroll
            for (int ks = 0; ks < 2; ++ks)
#pragma unroll
                for (int dd = 0; dd < 2; ++dd) {
                    const bf16x8 kf = *(const LAS bf16x8*)(KTs + ((dt0 + dd) * 16 + fr) * 72 + ks * 32 + fq * 8);
#pragma unroll
                    for (int j = 0; j < 4; ++j) accC[dd][j] = __builtin_amdgcn_mfma_f32_16x16x32_bf16(kf, vkeep[ks][j], accC[dd][j], 0, 0, 0);
                    if (half) accC[dd][4] = __builtin_amdgcn_mfma_f32_16x16x32_bf16(kf, vkeep[ks][4], accC[dd][4], 0, 0, 0);
                }
        }
        __syncthreads();
        {
            const int dt0 = (wave & 3) * 2, half = wave >> 2;
#pragma unroll
            for (int dd = 0; dd < 2; ++dd)
#pragma unroll
                for (int j = 0; j < 5; ++j) { if (j == 4 && !half) continue;
                    const int jrow = (j < 4) ? (half * 4 + j) * 16 : 128;
                    u32x2 w; w.x = pg8::cvt_pk_bf16(accC[dd][j][0], accC[dd][j][1]); w.y = pg8::cvt_pk_bf16(accC[dd][j][2], accC[dd][j][3]);
                    *(LAS u32x2*)(CTs + (jrow + fr) * 136 + (dt0 + dd) * 16 + 4 * fq) = w; }
        }
    };
#pragma unroll 1
    for (int cs = 0; cs < 66; cs += 3) { step(cs, os0); step(cs + 1, os1); step(cs + 2, os2); }
    step(66, os0); step(67, os1);
    flush();
    __syncthreads();
}

__device__ __forceinline__ float conv3_at(const bf16_t* rowp, int t, int seglen, float w0, float w1, float w2, float bias) {
    const int tl = t % seglen;
    float v = bf2f(rowp[t]) * w1 + bias;
    if (tl > 0) v += bf2f(rowp[t - 1]) * w0;
    if (tl < seglen - 1) v += bf2f(rowp[t + 1]) * w2;
    return v;
}
__device__ __forceinline__ void hyena_naive(const Args& a, int l, unsigned char* lds, int pass_lo, bool do_store) {
    const int tid = opaque_tid(), G = gridDim.x;
    bf16_t* UT = (bf16_t*)(a.ws + WS_UT);
    float* H = (float*)lds;
    float* Ub = H + 8192;
    float* Zb = Ub + 4096;
    float* red = Zb + 4096;
    float* w3s = red + 64;
    const float* hw = a.in[13] + (size_t)l * 3 * 1536; const float* hb = a.in[14] + (size_t)l * 1536;
    const float MIN_DECAY = -3.0701134573253946f, MAX_DECAY = -15.350567286626973f;
    for (int c = blockIdx.x; c < DHY; c += G) {
        const float rate = fabsf(MIN_DECAY + (MAX_DECAY - MIN_DECAY) * (float)c / 511.f);
        const float fb0 = a.in[21][(l * 2 + 0) * 512 + c], fb1 = a.in[21][(l * 2 + 1) * 512 + c];
        float cwv[3][3], cbv[3];
#pragma unroll
        for (int g = 0; g < 3; ++g) { cbv[g] = hb[g * 512 + c];
#pragma unroll
            for (int t3 = 0; t3 < 3; ++t3) cwv[g][t3] = hw[t3 * 1536 + g * 512 + c]; }
        for (int pass = pass_lo; pass < (l == 0 ? 2 : 1); ++pass) {
            const int L = pass ? LCTX : LSEQ;
            const float* hdn = pass ? (const float*)(a.ws + WS_HDNC) : (const float*)(a.ws + WS_HDN) + (size_t)l * 4096 * 64;
            __syncthreads();
            if (tid < 128) w3s[tid] = a.in[20][(size_t)l * 64 * 1024 + (tid & 63) * 1024 + (tid >> 6) * 512 + c];
            __syncthreads();
            float ssq0 = 0.f, ssq1 = 0.f;
            for (int t = tid; t < L; t += 512) { float s0 = 0.f, s1 = 0.f;
                for (int jj = 0; jj < 64; ++jj) { const float hv = hdn[(size_t)t * 64 + jj]; s0 += hv * w3s[jj]; s1 += hv * w3s[64 + jj]; }
                const float off = fabsf((float)t - (float)(L / 2)) / (float)(L / 2); const float dec = __expf(-off * rate);
                s0 *= dec; s1 *= dec; H[t] = s0; H[4096 + t] = s1; ssq0 += s0 * s0; ssq1 += s1 * s1; }
            ssq0 = wave_sum(ssq0); ssq1 = wave_sum(ssq1);
            if ((tid & 63) == 0) { red[tid >> 6] = ssq0; red[8 + (tid >> 6)] = ssq1; }
            __syncthreads();
            float t0 = 0.f, t1 = 0.f;
            for (int w = 0; w < 8; ++w) { t0 += red[w]; t1 += red[8 + w]; }
            const float n0 = rsqrtf(t0 + RMS_EPS), n1 = rsqrtf(t1 + RMS_EPS);
            __syncthreads();
            for (int t = tid; t < L; t += 512) { H[t] *= n0; H[4096 + t] *= n1; }
            __syncthreads();
            for (int b = 0; b < NB; ++b) {
                const size_t col0 = pass ? (size_t)MLAT + (size_t)b * LCTX : (size_t)b * LSEQ;
                const int seglen = pass ? LCTX : 64;
                const bf16_t* rv = UT + (size_t)c * MT + col0; const bf16_t* r1 = UT + (size_t)(512 + c) * MT + col0;
                const bf16_t* r2 = UT + (size_t)(1024 + c) * MT + col0; const bf16_t* rz = UT + (size_t)(1536 + c) * MT + col0;
                for (int t = tid; t < L; t += 512) Ub[t] = conv3_at(rv, t, seglen, cwv[0][0], cwv[0][1], cwv[0][2], cbv[0]);
                __syncthreads();
                for (int t = tid; t < L; t += 512) { float y = 0.f;
                    int slo = t + L / 2 - (L - 1); if (slo < 0) slo = 0; int shi = t + L / 2; if (shi > L - 1) shi = L - 1;
                    for (int s = slo; s <= shi; ++s) y += Ub[s] * H[t + L / 2 - s];
                    const float x1 = conv3_at(r1, t, seglen, cwv[1][0], cwv[1][1], cwv[1][2], cbv[1]);
                    Zb[t] = x1 * (y + Ub[t] * fb0); }
                __syncthreads();
                for (int t = tid; t < L; t += 512) { float y = 0.f;
                    int slo = t + L / 2 - (L - 1); if (slo < 0) slo = 0; int shi = t + L / 2; if (shi > L - 1) shi = L - 1;
                    for (int s = slo; s <= shi; ++s) y += Zb[s] * H[4096 + t + L / 2 - s];
                    const float x2 = conv3_at(r2, t, seglen, cwv[2][0], cwv[2][1], cwv[2][2], cbv[2]);
                    const float o = x2 * (y + Zb[t] * fb1) * silu_f(bf2f(rz[t]));
                    Ub[t] = o; }
                __syncthreads();
                if (do_store) for (int t = tid; t < L; t += 512) UT[(size_t)c * MT + col0 + t] = (bf16_t)f2bf(Ub[t]);
                __syncthreads();
            }
        }
    }
    __syncthreads();
}


typedef float cf __attribute__((ext_vector_type(2)));
__device__ __forceinline__ cf cmul(cf a, cf b) { const cf sw = __builtin_shufflevector(a, a, 1, 0); return a * b.x + sw * cf{-b.y, b.y}; }
__host__ __device__ constexpr float tw32c(int e) { return e == 0 ? 1.f : e == 1 ? 0.98078528040323043f : e == 2 ? 0.92387953251128674f : e == 3 ? 0.83146961230254524f : e == 4 ? 0.70710678118654752f : e == 5 ? 0.55557023301960218f :
    e == 6 ? 0.38268343236508977f : e == 7 ? 0.19509032201612825f : e == 8 ? 0.f : e == 9 ? -0.19509032201612825f : e == 10 ? -0.38268343236508977f : e == 11 ? -0.55557023301960218f : e == 12 ? -0.70710678118654752f :
    e == 13 ? -0.83146961230254524f : e == 14 ? -0.92387953251128674f : -0.98078528040323043f; }
template <int E32> __device__ __forceinline__ cf twmul(cf d) {
    if (E32 == 0) return d;
    if (E32 == 8) return cf{d.y, -d.x};
    constexpr float c = tw32c(E32), sn = tw32c(E32 < 8 ? 8 - E32 : E32 - 8);
    const cf sw = __builtin_shufflevector(d, d, 1, 0);
    return d * c + sw * cf{sn, -sn};
}
template <int R, int HALF, int I> struct DftStage {
    static __device__ __forceinline__ void run(cf (&v)[R]) {
        if constexpr ((I & HALF) == 0) {
            constexpr int E32 = (I % HALF) * (R / (2 * HALF)) * (32 / R);
            const cf a = v[I], b = v[I + HALF];
            v[I] = a + b;
            v[I + HALF] = twmul<E32>(a - b);
        }
        if constexpr (I + 1 < R) DftStage<R, HALF, I + 1>::run(v);
    }
};
template <int R, int HALF> struct DftAll {
    static __device__ __forceinline__ void run(cf (&v)[R]) { DftStage<R, HALF, 0>::run(v); if constexpr (HALF > 1) DftAll<R, HALF / 2>::run(v); }
};
__host__ __device__ constexpr int bitrev_c(int x, int bits) { int r = 0; for (int i = 0; i < bits; ++i) r = (r << 1) | ((x >> i) & 1); return r; }
__device__ __forceinline__ int PADI(int i) { return i + (i >> 4); }
constexpr int FFT_W_ELEMS = 8192 + 512;
template <int R, int I> struct StoreRev {
    static __device__ __forceinline__ void run(LAS cf* Wp, int pstride, const cf (&v)[R]) {
        constexpr int bits = (R == 32) ? 5 : 4;
        Wp[I * pstride] = v[bitrev_c(I, bits)];
        if constexpr (I + 1 < R) StoreRev<R, I + 1>::run(Wp, pstride, v);
    }
};
template <int R, int NS> __device__ __forceinline__ void fft_pass(LAS cf* W, int tid_) {
    int tid = tid_; asm volatile("" : "+v"(tid));
    constexpr int NT = 8192 / R;
    cf v[R];
    const bool act = tid < NT;
    if (act) {
#pragma unroll
        for (int r = 0; r < R; ++r) v[r] = W[PADI(tid) + r * (NT + NT / 16)];
    }
    __syncthreads();
    if (act) {
        const int k = tid % NS;
        if (NS > 1) {
            const float fr_ = -(float)k * (1.f / (float)(NS * R)); const float sn = __builtin_amdgcn_sinf(fr_), cs = __builtin_amdgcn_cosf(fr_);
            const cf w = cf{cs, sn}; cf cur = w;
#pragma unroll
            for (int r = 1; r < R; ++r) { v[r] = cmul(v[r], cur); cur = cmul(cur, w); }
        }
        DftAll<R, R / 2>::run(v);
        const int idx = (tid / NS) * NS * R + k;
        StoreRev<R, 0>::run(W + PADI(idx), NS >= 16 ? NS + NS / 16 : 1, v);
    }
    __syncthreads();
}
__device__ __forceinline__ void fft_pass2(LAS cf* W, int tid_) {
    int tid = tid_; asm volatile("" : "+v"(tid));
#pragma unroll 2
    for (int m = 0; m < 8; ++m) { const int j = tid + 512 * m; const int pj = PADI(j); const cf a = W[pj]; cf b = W[pj + 4352];
        const float fr_ = -(float)j * (1.f / 8192.f); b = cmul(b, cf{__builtin_amdgcn_cosf(fr_), __builtin_amdgcn_sinf(fr_)});
        W[pj] = cf{a.x + b.x, a.y + b.y}; W[pj + 4352] = cf{a.x - b.x, a.y - b.y}; }
    __syncthreads();
}
__device__ __forceinline__ void fft8192(LAS cf* W, int tid) { fft_pass<16, 1>(W, tid); fft_pass<16, 16>(W, tid); fft_pass<16, 256>(W, tid); fft_pass2(W, tid); }

template <int NS> __device__ __forceinline__ void fft4k_pass(LAS cf* Wb, int j_) {
    int j = j_; asm volatile("" : "+v"(j));
    cf v[16];
#pragma unroll
    for (int r = 0; r < 16; ++r) v[r] = Wb[PADI(j) + r * 272];
    __syncthreads();
    const int k = j % NS;
    if (NS > 1) {
        const float fr_ = -(float)k * (1.f / (float)(NS * 16)); const float sn = __builtin_amdgcn_sinf(fr_), cs = __builtin_amdgcn_cosf(fr_);
        const cf w = cf{cs, sn}; cf cur = w;
#pragma unroll
        for (int r = 1; r < 16; ++r) { v[r] = cmul(v[r], cur); cur = cmul(cur, w); }
    }
    DftAll<16, 8>::run(v);
    const int idx = (j / NS) * NS * 16 + k;
    StoreRev<16, 0>::run(Wb + PADI(idx), NS >= 16 ? NS + NS / 16 : 1, v);
    __syncthreads();
}
__device__ __forceinline__ void fft4k_x2(LAS cf* Wb, int j) { fft4k_pass<1>(Wb, j); fft4k_pass<16>(Wb, j); fft4k_pass<256>(Wb, j); }

__device__ __forceinline__ void conv8(const u32x4 rv, int tid, float w0, float w1, float w2, float bias, float (&o)[8]) {
    float x[8];
#pragma unroll
    for (int e = 0; e < 4; ++e) { x[2 * e] = bflo(rv[e]); x[2 * e + 1] = bfhi(rv[e]); }
    float left = __shfl_up(x[7], 1), right = __shfl_down(x[0], 1);
    if ((tid & 7) == 0) left = 0.f;
    if ((tid & 7) == 7) right = 0.f;
#pragma unroll
    for (int e = 0; e < 8; ++e) { const float xm = (e == 0) ? left : x[e - 1], xp = (e == 7) ? right : x[e + 1]; o[e] = w0 * xm + w1 * x[e] + w2 * xp + bias; }
}

__device__ __forceinline__ void hyena_item(const Args& a, int l, unsigned char* lds_, int item, bool do_store) {
    const int tid = opaque_tid();
    const int c = item >> 1, half = item & 1;
    LAS unsigned char* lds = (LAS unsigned char*)lds_;
    LAS cf* W = (LAS cf*)lds;
    LAS cf* He0 = (LAS cf*)(lds + 69632);
    LAS cf* Ho0 = He0 + 2049;
    LAS cf* He1 = Ho0 + 2048;
    LAS cf* Ho1 = He1 + 2049;
    const int sel = tid >> 8, j = tid & 255;
    LAS cf* Wb = W + sel * 4352;
    bf16_t* UT = (bf16_t*)(a.ws + WS_UT);
    const float* FT = (const float*)(a.ws + WS_FT);
    const float* hw = a.in[13] + (size_t)l * 3 * 1536; const float* hb = a.in[14] + (size_t)l * 1536;
    const float fb0 = a.in[21][(l * 2 + 0) * 512 + c], fb1 = a.in[21][(l * 2 + 1) * 512 + c];
    const int pi0 = PADI(tid * 8);
    __syncthreads();
    {
        const f32x4 ha = *(const f32x4*)(FT + (size_t)c * 4096 + tid * 8), hb2 = *(const f32x4*)(FT + (size_t)c * 4096 + tid * 8 + 4);
        const f32x4 ga = *(const f32x4*)(FT + (size_t)(512 + c) * 4096 + tid * 8), gb2 = *(const f32x4*)(FT + (size_t)(512 + c) * 4096 + tid * 8 + 4);
        const float fn0 = FT[(size_t)1024 * 4096 + c], fn1 = FT[(size_t)1024 * 4096 + 512 + c];
#pragma unroll
        for (int e = 0; e < 8; ++e) { const cf f = cf{(e < 4 ? ha[e & 3] : hb2[e & 3]) * fn0, (e < 4 ? ga[e & 3] : gb2[e & 3]) * fn1};
            const float fr_ = -(float)(tid * 8 + e) * (1.f / 8192.f);
            W[pi0 + e] = f; W[4352 + pi0 + e] = cmul(f, cf{__builtin_amdgcn_cosf(fr_), __builtin_amdgcn_sinf(fr_)}); }
        __syncthreads();
        fft4k_x2(Wb, j);
        for (int m = tid; m <= 2048; m += NTHR) { const cf A = W[PADI(m & 4095)], Bm = W[PADI((4096 - m) & 4095)];
            He0[m] = cf{0.5f * (A.x + Bm.x), 0.5f * (A.y - Bm.y)}; He1[m] = cf{0.5f * (A.y + Bm.y), -0.5f * (A.x - Bm.x)}; }
        for (int m = tid; m < 2048; m += NTHR) { const cf A = W[4352 + PADI(m)], Bm = W[4352 + PADI(4095 - m)];
            Ho0[m] = cf{0.5f * (A.x + Bm.x), 0.5f * (A.y - Bm.y)}; Ho1[m] = cf{0.5f * (A.y + Bm.y), -0.5f * (A.x - Bm.x)}; }
        __syncthreads();
    }
    float cwv[3][3], cbv[3];
#pragma unroll
    for (int g = 0; g < 3; ++g) { cbv[g] = hb[g * 512 + c];
#pragma unroll
        for (int t3 = 0; t3 < 3; ++t3) cwv[g][t3] = hw[t3 * 1536 + g * 512 + c]; }
#pragma unroll 1
    for (int bp = half * 2; bp < half * 2 + 2; ++bp) {
        const size_t o0 = (size_t)(2 * bp) * LSEQ + tid * 8, o1 = o0 + LSEQ;
        bf16_t* rv = UT + (size_t)c * MT; const bf16_t* r1 = UT + (size_t)(512 + c) * MT; const bf16_t* r2 = UT + (size_t)(1024 + c) * MT; const bf16_t* rz = UT + (size_t)(1536 + c) * MT;
        const u32x4 qv0 = *(const u32x4*)(rv + o0), qv1 = *(const u32x4*)(rv + o1), qa0 = *(const u32x4*)(r1 + o0), qa1 = *(const u32x4*)(r1 + o1);
        const u32x4 qb0 = *(const u32x4*)(r2 + o0), qb1 = *(const u32x4*)(r2 + o1), qz0 = *(const u32x4*)(rz + o0), qz1 = *(const u32x4*)(rz + o1);
        float z0[8], z1[8];
        conv8(qv0, tid, cwv[0][0], cwv[0][1], cwv[0][2], cbv[0], z0);
        conv8(qv1, tid, cwv[0][0], cwv[0][1], cwv[0][2], cbv[0], z1);
#pragma unroll 1
        for (int ord = 0; ord < 2; ++ord) {
#pragma unroll
            for (int e = 0; e < 8; ++e) { const cf f = cf{z0[e], z1[e]}; const float fr_ = -(float)(tid * 8 + e) * (1.f / 8192.f);
                W[pi0 + e] = f; W[4352 + pi0 + e] = cmul(f, cf{__builtin_amdgcn_cosf(fr_), __builtin_amdgcn_sinf(fr_)}); }
            __syncthreads();
            fft4k_x2(Wb, j);
            {
                LAS const cf* Hs = sel ? (ord ? Ho1 : Ho0) : (ord ? He1 : He0);
                const int top = sel ? 4095 : 4096, lim = sel ? 2047 : 2048;
#pragma unroll 4
                for (int i = 0; i < 16; ++i) { const int m = j + 256 * i; const int pm = PADI(m); const cf zv = Wb[pm];
                    cf hk; if (m <= lim) hk = Hs[m]; else { hk = Hs[top - m]; hk.y = -hk.y; }
                    const cf y = cmul(zv, hk); Wb[pm] = cf{y.x, -y.y}; }
            }
            __syncthreads();
            fft4k_x2(Wb, j);
            float x0[8], x1[8];
            conv8(ord ? qb0 : qa0, tid, cwv[1 + ord][0], cwv[1 + ord][1], cwv[1 + ord][2], cbv[1 + ord], x0);
            conv8(ord ? qb1 : qa1, tid, cwv[1 + ord][0], cwv[1 + ord][1], cwv[1 + ord][2], cbv[1 + ord], x1);
            const float fb = ord ? fb1 : fb0;
            const int pr = PADI((2048 + tid * 8) & 4095);
#pragma unroll
            for (int e = 0; e < 8; ++e) { const float fr_ = -(float)(2048 + tid * 8 + e) * (1.f / 8192.f);
                const cf ev = W[pr + e], ov = cmul(W[4352 + pr + e], cf{__builtin_amdgcn_cosf(fr_), __builtin_amdgcn_sinf(fr_)});
                const float y0 = (ev.x + ov.x) * (1.f / 8192.f), y1 = -(ev.y + ov.y) * (1.f / 8192.f);
                z0[e] = x0[e] * (y0 + z0[e] * fb); z1[e] = x1[e] * (y1 + z1[e] * fb); }
            __syncthreads();
        }
        {
            u32x4 w0, w1;
#pragma unroll
            for (int e = 0; e < 4; ++e) { w0[e] = pg8::cvt_pk_bf16(z0[2 * e] * silu_f(bflo(qz0[e])), z0[2 * e + 1] * silu_f(bfhi(qz0[e])));
                w1[e] = pg8::cvt_pk_bf16(z1[2 * e] * silu_f(bflo(qz1[e])), z1[2 * e + 1] * silu_f(bfhi(qz1[e]))); }
            if (do_store) { *(u32x4*)(rv + o0) = w0; *(u32x4*)(rv + o1) = w1; } }
    }
    __syncthreads();
}

__device__ __forceinline__ void filt_item(const Args& a, int l, unsigned char* lds_, int fi) {
    const int tid = opaque_tid();
    LAS float* w3s = (LAS float*)lds_ + 4096;
    LAS float* red = w3s + 512;
    float* FT = (float*)(a.ws + WS_FT);
    const float* hdn = (const float*)(a.ws + WS_HDN) + (size_t)l * 4096 * 64;
    const float MIN_DECAY = -3.0701134573253946f, MAX_DECAY = -15.350567286626973f;
    __syncthreads();
    w3s[tid] = a.in[20][(size_t)l * 64 * 1024 + (size_t)(tid >> 3) * 1024 + fi * 8 + (tid & 7)];
    __syncthreads();
    float rate[8], ssq[8];
#pragma unroll
    for (int cc = 0; cc < 8; ++cc) { const int ch = (fi * 8 + cc) & 511; rate[cc] = fabsf(MIN_DECAY + (MAX_DECAY - MIN_DECAY) * (float)ch / 511.f); ssq[cc] = 0.f; }
#pragma unroll 1
    for (int it2 = 0; it2 < 2; ++it2) {
        float acc[4][8];
#pragma unroll
        for (int q = 0; q < 4; ++q)
#pragma unroll
            for (int cc = 0; cc < 8; ++cc) acc[q][cc] = 0.f;
        const f32x4* hp = (const f32x4*)(hdn + (size_t)(it2 * 2048 + tid) * 64);
        f32x4 hn[4];
#pragma unroll
        for (int q = 0; q < 4; ++q) hn[q] = hp[(size_t)q * 512 * 16];
#pragma unroll 1
        for (int j4 = 0; j4 < 16; ++j4) {
            f32x4 hv[4];
#pragma unroll
            for (int q = 0; q < 4; ++q) hv[q] = hn[q];
            if (j4 < 15) {
#pragma unroll
                for (int q = 0; q < 4; ++q) hn[q] = hp[(size_t)q * 512 * 16 + j4 + 1]; }
#pragma unroll
            for (int jj = 0; jj < 4; ++jj) { const f32x4 wa = *(const LAS f32x4*)(w3s + (4 * j4 + jj) * 8), wb = *(const LAS f32x4*)(w3s + (4 * j4 + jj) * 8 + 4);
#pragma unroll
                for (int q = 0; q < 4; ++q) { const float h = hv[q][jj];
                    acc[q][0] += h * wa.x; acc[q][1] += h * wa.y; acc[q][2] += h * wa.z; acc[q][3] += h * wa.w; acc[q][4] += h * wb.x; acc[q][5] += h * wb.y; acc[q][6] += h * wb.z; acc[q][7] += h * wb.w; } }
        }
#pragma unroll
        for (int q = 0; q < 4; ++q) { const int t = it2 * 2048 + tid + 512 * q; const float off = fabsf((float)t - 2048.f) * (1.f / 2048.f);
#pragma unroll
            for (int cc = 0; cc < 8; ++cc) { const float v = acc[q][cc] * __expf(-off * rate[cc]); ssq[cc] += v * v; FT[(size_t)(fi * 8 + cc) * 4096 + t] = v; } }
    }
#pragma unroll
    for (int cc = 0; cc < 8; ++cc) { const float sv = wave_sum(ssq[cc]); if ((tid & 63) == 0) red[(tid >> 6) * 8 + cc] = sv; }
    __syncthreads();
    if (tid < 8) { float tsum = 0.f;
#pragma unroll
        for (int w = 0; w < 8; ++w) tsum += red[w * 8 + tid];
        FT[(size_t)1024 * 4096 + fi * 8 + tid] = rsqrtf(tsum + RMS_EPS); }
}

__device__ __forceinline__ float ctx_conv3(LAS const bf16_t* rowp, int t, float w0, float w1, float w2, float bias) {
    return bf2f(rowp[t - 1]) * w0 + bf2f(rowp[t]) * w1 + bf2f(rowp[t + 1]) * w2 + bias;
}
__device__ __forceinline__ void hyena_ctx_item(const Args& a, unsigned char* lds_, int c, bool do_store) {
    const int tid = opaque_tid();
    LAS float* Hc = (LAS float*)lds_;
    LAS float* U = Hc + 512;
    LAS float* Z = U + 2048;
    LAS float* red = Z + 2048;
    LAS float* w3s = red + 16;
    LAS bf16_t* RAW = (LAS bf16_t*)(w3s + 128);
    LAS bf16_t* OUT = RAW + 4 * 8 * 272;
    bf16_t* UT = (bf16_t*)(a.ws + WS_UT);
    const float* hdn = (const float*)(a.ws + WS_HDNC);
    const float* hw = a.in[13]; const float* hb = a.in[14];
    const float MIN_DECAY = -3.0701134573253946f, MAX_DECAY = -15.350567286626973f;
    const int t = tid & 255, bh = tid >> 8;
    {
        const float rate = fabsf(MIN_DECAY + (MAX_DECAY - MIN_DECAY) * (float)c / 511.f);
        const float fb0 = a.in[21][c], fb1 = a.in[21][512 + c];
        __syncthreads();
        if (tid < 128) w3s[tid] = a.in[20][(size_t)(tid & 63) * 1024 + (tid >> 6) * 512 + c];
#pragma unroll
        for (int i = 0; i < 2; ++i) { const int pp = tid + 512 * i, arr = pp >> 8, bb = (pp >> 5) & 7, seg = pp & 31;
            *(LAS u32x4*)(RAW + (arr * 8 + bb) * 272 + 8 + seg * 8) = *(const u32x4*)(UT + (size_t)(arr * 512 + c) * MT + MLAT + (size_t)bb * LCTX + seg * 8); }
        if (tid < 64) RAW[(tid >> 1) * 272 + ((tid & 1) ? 264 : 7)] = (bf16_t)0;
        __syncthreads();
        {
            float sv = 0.f;
            const f32x4* hp = (const f32x4*)(hdn + (size_t)t * 64);
#pragma unroll 4
            for (int j4 = 0; j4 < 16; ++j4) { const f32x4 hv = hp[j4]; sv += hv.x * w3s[bh * 64 + 4 * j4] + hv.y * w3s[bh * 64 + 4 * j4 + 1] + hv.z * w3s[bh * 64 + 4 * j4 + 2] + hv.w * w3s[bh * 64 + 4 * j4 + 3]; }
            sv *= __expf(-fabsf((float)t - 128.f) * (1.f / 128.f) * rate);
            const float ss = wave_sum(sv * sv);
            if ((tid & 63) == 0) red[tid >> 6] = ss;
            __syncthreads();
            const float tot = red[bh * 4] + red[bh * 4 + 1] + red[bh * 4 + 2] + red[bh * 4 + 3];
            Hc[bh * 256 + t] = sv * rsqrtf(tot + RMS_EPS);
        }
        float vv[4];
#pragma unroll
        for (int i = 0; i < 4; ++i) vv[i] = ctx_conv3(RAW + (0 * 8 + bh * 4 + i) * 272 + 8, t, hw[c], hw[1536 + c], hw[3072 + c], hb[c]);
        *(LAS f32x4*)(U + t * 8 + bh * 4) = (f32x4){vv[0], vv[1], vv[2], vv[3]};
        __syncthreads();
        const int slo = (t - 127 > 0) ? t - 127 : 0, shi = (t + 128 < 255) ? t + 128 : 255;
        f32x4 acc = {0.f, 0.f, 0.f, 0.f};
        for (int s2 = slo; s2 <= shi; ++s2) { const float h = Hc[t + 128 - s2]; const f32x4 u = *(const LAS f32x4*)(U + s2 * 8 + bh * 4); acc = acc + u * h; }
        float zz[4];
#pragma unroll
        for (int i = 0; i < 4; ++i) { const float x1 = ctx_conv3(RAW + (1 * 8 + bh * 4 + i) * 272 + 8, t, hw[512 + c], hw[1536 + 512 + c], hw[3072 + 512 + c], hb[512 + c]);
            zz[i] = x1 * (acc[i] + vv[i] * fb0); }
        *(LAS f32x4*)(Z + t * 8 + bh * 4) = (f32x4){zz[0], zz[1], zz[2], zz[3]};
        __syncthreads();
        acc = (f32x4){0.f, 0.f, 0.f, 0.f};
        for (int s2 = slo; s2 <= shi; ++s2) { const float h = Hc[256 + t + 128 - s2]; const f32x4 u = *(const LAS f32x4*)(Z + s2 * 8 + bh * 4); acc = acc + u * h; }
#pragma unroll
        for (int i = 0; i < 4; ++i) { const float x2 = ctx_conv3(RAW + (2 * 8 + bh * 4 + i) * 272 + 8, t, hw[1024 + c], hw[1536 + 1024 + c], hw[3072 + 1024 + c], hb[1024 + c]);
            OUT[(bh * 4 + i) * 256 + t] = (bf16_t)f2bf(x2 * (acc[i] + zz[i] * fb1) * silu_f(bf2f(RAW[(3 * 8 + bh * 4 + i) * 272 + 8 + t]))); }
        __syncthreads();
        if (do_store && tid < 256) *(u32x4*)(UT + (size_t)c * MT + MLAT + (size_t)(tid >> 5) * LCTX + (tid & 31) * 8) = *(LAS const u32x4*)(OUT + (tid >> 5) * 256 + (tid & 31) * 8);
    }
    __syncthreads();
}


__device__ __forceinline__ void phase_mixers(const Args& a, int l, unsigned char* lds, int rep, bool do_mlstm, bool do_hy, bool do_hyctx) {
    LAS unsigned* qslot = (LAS unsigned*)((LAS unsigned char*)lds + (LDS_BYTES - 32));
    if (do_mlstm && (blockIdx.x & 3) == 0 && (blockIdx.x >> 2) < 64) mlstm_item(a, l, lds, blockIdx.x >> 2, rep == 0);
    unsigned* ctr = (unsigned*)(a.ws + WS_CTL) + CW_QUEUE + 64 * (l * 8 + rep);
    const int n_lat = do_hy ? 2 * DHY : 0, n_ctx = (l == 0 && do_hyctx) ? DHY : 0;
    for (;;) {
        __syncthreads();
        if (threadIdx.x == 0) *qslot = __hip_atomic_fetch_add(ctr, 1u, __ATOMIC_RELAXED, __HIP_MEMORY_SCOPE_AGENT);
        __syncthreads();
        const int item = (int)*qslot;
        if (item >= n_lat + n_ctx) break;
        if (item < n_lat) hyena_item(a, l, lds, item, rep == 0);
        else hyena_ctx_item(a, lds, item - n_lat, rep == 0);
    }
    __syncthreads();
}

__device__ __forceinline__ void phase_combine(const Args& a, int l, unsigned char* lds) {
    const int tid = opaque_tid(), G = gridDim.x, lane = tid & 63, wave = tid >> 6;
    const bf16_t* U1 = (const bf16_t*)(a.ws + WS_U1);
    const bf16_t* HDi = (const bf16_t*)(a.ws + WS_HB);
    const bf16_t* UT = (const bf16_t*)(a.ws + WS_UT);
    bf16_t* YM = (bf16_t*)(a.ws + WS_YMIX);
    bf16_t* T = (bf16_t*)lds;
    const int nblk = (l == 0 ? MT : MLAT) / 64;
    float mgv[8];
#pragma unroll
    for (int i = 0; i < 8; ++i) mgv[i] = a.in[12][l * 512 + lane * 8 + i];
    const size_t dstride = (size_t)32 * (LCTX + LSEQ) * 128;
    for (int blk = blockIdx.x; blk < nblk; blk += G) {
        const int r0 = blk * 64;
        __syncthreads();
#pragma unroll
        for (int i = 0; i < 8; ++i) { const int e = tid + i * 512, ch = e >> 3, pc = e & 7;
            *(u32x4*)(T + ch * 72 + ((pc ^ ((ch >> 3) & 7)) * 8)) = *(const u32x4*)(UT + (size_t)ch * MT + r0 + pc * 8); }
        const int cb = r0 >= MLAT ? (r0 - MLAT) >> 8 : r0 >> 12, csr0 = r0 >= MLAT ? (r0 - MLAT) & 255 : LCTX + (r0 & 4095);
        const bf16_t* hbase = HDi + ((size_t)(cb * 4 + (lane >> 4)) * (LCTX + LSEQ) + csr0) * 128 + (lane & 15) * 8;
#pragma unroll 1
        for (int rr = wave; rr < 64; rr += 16) {
            u32x4 hf[2], hb[2], ov[2], zv[2];
#pragma unroll
            for (int q = 0; q < 2; ++q) { const int r1 = rr + 8 * q; const size_t row = r0 + r1;
                hf[q] = *(const u32x4*)(hbase + (size_t)r1 * 128); hb[q] = *(const u32x4*)(hbase + (size_t)r1 * 128 + dstride);
                ov[q] = *(const u32x4*)(U1 + row * LDU1 + 1024 + lane * 8); zv[q] = *(const u32x4*)(U1 + row * LDU1 + 1536 + lane * 8); }
#pragma unroll
            for (int q = 0; q < 2; ++q) { const size_t row = r0 + rr + 8 * q;
                float hg[8]; float ss = 0.f;
#pragma unroll
                for (int i = 0; i < 4; ++i) {
                    hg[2 * i] = (bflo(hf[q][i]) + bflo(hb[q][i])) * sigmoid_f(bflo(ov[q][i]));
                    hg[2 * i + 1] = (bfhi(hf[q][i]) + bfhi(hb[q][i])) * sigmoid_f(bfhi(ov[q][i]));
                    ss += hg[2 * i] * hg[2 * i] + hg[2 * i + 1] * hg[2 * i + 1]; }
                ss += __shfl_xor(ss, 1); ss += __shfl_xor(ss, 2); ss += __shfl_xor(ss, 4); ss += __shfl_xor(ss, 8);
                const float r = rsqrtf(ss * (1.f / 128.f) + RMS_EPS);
                u32x4 o4;
#pragma unroll
                for (int i = 0; i < 4; ++i) o4[i] = pk2(hg[2 * i] * r * mgv[2 * i] * silu_f(bflo(zv[q][i])), hg[2 * i + 1] * r * mgv[2 * i + 1] * silu_f(bfhi(zv[q][i])));
                *(u32x4*)(YM + row * DM + lane * 8) = o4; }
        }
        __syncthreads();
        for (int rr = wave; rr < 64; rr += 8) {
            const int col = (((rr >> 3) ^ (lane & 7)) << 3) | (rr & 7);
            u32x4 o4;
#pragma unroll
            for (int i = 0; i < 4; ++i) o4[i] = (unsigned)T[(lane * 8 + 2 * i) * 72 + col] | ((unsigned)T[(lane * 8 + 2 * i + 1) * 72 + col] << 16);
            *(u32x4*)(YM + (size_t)(r0 + rr) * DM + 512 + lane * 8) = o4;
        }
    }
    __syncthreads();
}


#define XB_TMO      128
#define XB_XCNT(j)  (256  + 64 * (j))
#define XB_XSUB(j)  (1280 + 64 * (j))
#define XB_XGEN(j)  (2304 + 64 * (j))
#define XB_TOP      3328
#define XB_TOPGEN   3392
#define XCD_BAR_WORDS 3456
#define XB_SPIN_CAP (1u << 18)
__device__ __forceinline__ unsigned xb_ld(unsigned* p)              { return __hip_atomic_load(p, __ATOMIC_RELAXED, __HIP_MEMORY_SCOPE_AGENT); }
__device__ __forceinline__ unsigned xb_add(unsigned* p, unsigned v) { return __hip_atomic_fetch_add(p, v, __ATOMIC_RELAXED, __HIP_MEMORY_SCOPE_AGENT); }
__device__ __forceinline__ unsigned xb_xcc_id() { return (unsigned)__builtin_amdgcn_s_getreg((3 << 11) | 20) & 0xFu; }
#define XB_SPIN(cond, bar) do { unsigned _sp = 0; while (cond) { __builtin_amdgcn_s_sleep(1); \
    if ((++_sp & 255u) == 0u) { if (xb_ld(&(bar)[XB_TMO])) break; if (_sp > XB_SPIN_CAP) { atomicAdd(&(bar)[XB_TMO], 1u); break; } } } } while (0)
struct XcdBarrier { unsigned* bar; unsigned x; volatile __attribute__((address_space(3))) unsigned* st; };
__device__ __forceinline__ XcdBarrier xcd_barrier_post(unsigned* bar, volatile __attribute__((address_space(3))) unsigned* st) {
    XcdBarrier b; b.bar = bar; b.x = xb_xcc_id(); b.st = st;
    if (threadIdx.x == 0) (void)xb_add(&bar[XB_XCNT(b.x)], 1u);
    return b;
}
__device__ __forceinline__ void xcd_barrier_complete(unsigned* bar, unsigned x, unsigned& nloc, unsigned& nx) {
    const unsigned G = gridDim.x * gridDim.y * gridDim.z;
    unsigned sum, cnt, mine, sp = 0u;
    for (;;) {
        sum = 0u; cnt = 0u; mine = 0u;
#pragma unroll
        for (unsigned j = 0; j < 16; ++j) { const unsigned c = xb_ld(&bar[XB_XCNT(j)]); sum += c; cnt += (c > 0u) ? 1u : 0u; mine = (j == x) ? c : mine; }
        if (sum == G) break;
        __builtin_amdgcn_s_sleep(1);
        if ((++sp & 255u) == 0u) { if (xb_ld(&bar[XB_TMO])) break; if (sp > XB_SPIN_CAP) { atomicAdd(&bar[XB_TMO], 1u); break; } }
    }
    nloc = mine > 0u ? mine : 1u; nx = cnt > 0u ? cnt : 1u;
}
__device__ __forceinline__ void xcd_barrier(const XcdBarrier& b) {
    asm volatile("s_waitcnt vmcnt(0)" ::: "memory");
    __syncthreads();
    if (threadIdx.x == 0) {
        unsigned* bar = b.bar;
        __builtin_amdgcn_s_waitcnt(0);
        unsigned nloc = b.st[0], nx = b.st[1];
        if (nloc == 0u) { xcd_barrier_complete(bar, b.x, nloc, nx); b.st[0] = nloc; b.st[1] = nx; }
        const unsigned old = xb_add(&bar[XB_XSUB(b.x)], 1u);
        const unsigned gen = old / nloc;
        if (old + 1u == (gen + 1u) * nloc) {
            __builtin_amdgcn_fence(__ATOMIC_RELEASE, "agent");
            asm volatile("s_waitcnt vmcnt(0)" ::: "memory");
            const unsigned og = xb_add(&bar[XB_TOP], 1u);
            const unsigned tg = og / nx;
            if (og + 1u == (tg + 1u) * nx) xb_add(&bar[XB_TOPGEN], 1u);
            else XB_SPIN(xb_ld(&bar[XB_TOPGEN]) == tg, bar);
            __builtin_amdgcn_fence(__ATOMIC_ACQUIRE, "agent");
            xb_add(&bar[XB_XGEN(b.x)], 1u);
            asm volatile("s_waitcnt vmcnt(0)" ::: "memory");
        } else {
            XB_SPIN(xb_ld(&bar[XB_XGEN(b.x)]) == gen, bar);
            __builtin_amdgcn_fence(__ATOMIC_ACQUIRE, "agent");
            asm volatile("s_waitcnt vmcnt(0)" ::: "memory");
        }
    }
    __syncthreads();
}

__global__ void __launch_bounds__(NTHR, 2) fwd(Args a_) {
    extern __shared__ __attribute__((aligned(16))) unsigned char lds[];
    cg::grid_group grid = cg::this_grid();
    const int lo = a_.ph_lo, hi = a_.ph_hi; const int rp_phase = a_.rep_phase, rp_count = a_.rep_count & 255;
#define IN(k) (lo <= (k) && (k) < hi)
    volatile __attribute__((address_space(3))) unsigned* bst = (volatile __attribute__((address_space(3))) unsigned*)((__attribute__((address_space(3))) unsigned char*)lds + (LDS_BYTES - 64));
    if (threadIdx.x < 2) bst[threadIdx.x] = 0u;
    __syncthreads();
    const XcdBarrier xbar = xcd_barrier_post((unsigned*)(a_.ws + WS_CTL), bst);
    if (lo < 0) grid.sync();
#define SEAM(k) do { if (IN(k) && IN((k) + 1)) xcd_barrier(xbar); } while (0)
    if (IN(0)) _Pragma("unroll 1") for (int rep = 0, nrep = (rp_phase == 0) ? rp_count : 1; rep < nrep; ++rep) phase_prep(kargs(), lds);
    SEAM(0);
    if (IN(1)) _Pragma("unroll 1") for (int rep = 0, nrep = (rp_phase == 1) ? rp_count : 1; rep < nrep; ++rep) phase_norm(kargs(), 0, false, true, lds);
    SEAM(1);
    for (int l = 0; l < DEPTH; ++l) {
        const int p = 2 + 6 * l;
        if (IN(p)) {
            unsigned char* ws = kargs().ws;
            const bf16_t* HB = (const bf16_t*)(ws + WS_HB);
            const bf16_t* WinT = (const bf16_t*)(ws + WS_WINT) + (size_t)l * NPK * DM;
#if NAIVE_GEMM
            gemm_naive(HB, WinT, MT, NU1, DM, ws + WS_U1, NU1, 0, lds);
            gemm_naive(HB, WinT + (size_t)NU1 * DM, MT, NU2, DM, ws + WS_UT, MT, 1, lds);
#else
            DecIn d{(const char*)HB, (const char*)WinT, (char*)(ws + WS_U1), (char*)(ws + WS_UT)};
            pg8::GridOrder<DecIn> S; S.init(MT / 256, NPK / 256, gridDim.x, blockIdx.x, d);
            _Pragma("unroll 1") for (int rep = 0, nrep = (rp_phase == 2) ? rp_count : 1; rep < nrep; ++rep) pg8::gemm_phase<true>((PG8_LAS unsigned char*)lds, DM, S);
#endif
        }
        SEAM(p);
        if (IN(p + 1)) _Pragma("unroll 1") for (int rep = 0, nrep = (rp_phase == 9) ? rp_count : 1; rep < nrep; ++rep) phase_mprep(kargs(), l, lds, rep);
        SEAM(p + 1);
        if (IN(p + 2)) {
            const int nrep = (rp_phase == 3 || rp_phase == 4 || rp_phase == 5 || rp_phase == 11) ? rp_count : 1;
            _Pragma("unroll 1") for (int rep = 0; rep < nrep; ++rep)
                phase_mixers(kargs(), l, lds, rep, rep == 0 || rp_phase == 3 || rp_phase == 11, rep == 0 || rp_phase == 4 || rp_phase == 11, rep == 0 || rp_phase == 5 || rp_phase == 11);
        }
        SEAM(p + 2);
        if (IN(p + 3)) _Pragma("unroll 1") for (int rep = 0, nrep = (rp_phase == 6) ? rp_count : 1; rep < nrep; ++rep) phase_combine(kargs(), l, lds);
        SEAM(p + 3);
        if (IN(p + 4)) {
            unsigned char* ws = kargs().ws;
            const bf16_t* WoutT = (const bf16_t*)(ws + WS_WOUTT) + (size_t)l * DM * DM;
#if NAIVE_GEMM
            gemm_naive((const bf16_t*)(ws + WS_YMIX), WoutT, (l == 0) ? MT : MLAT, DM, DM, ws + WS_U1, DM, 2, lds);
#else
            DecOut d{(const char*)(ws + WS_YMIX), (const char*)WoutT, (char*)(ws + WS_U1)};
            pg8::GridOrder<DecOut> S; S.init(((l == 0) ? MT : MLAT) / 256, DM / 256, gridDim.x, blockIdx.x, d);
            _Pragma("unroll 1") for (int rep = 0, nrep = (rp_phase == 7) ? rp_count : 1; rep < nrep; ++rep) pg8::gemm_phase<true>((PG8_LAS unsigned char*)lds, DM, S);
#endif
        }
        SEAM(p + 4);
        if (IN(p + 5)) _Pragma("unroll 1") for (int rep = 0, nrep = (rp_phase == 8 && l == 0) ? rp_count : 1; rep < nrep; ++rep) phase_norm(kargs(), l + 1, true, l + 1 < DEPTH, lds);
        SEAM(p + 5);
    }
    if (rp_phase == 10) for (int rep = 0; rep < rp_count; ++rep) xcd_barrier(xbar);
#undef IN
#undef SEAM
}

constexpr int NPHASES = 2 + 6 * DEPTH;

extern "C" void kernel_launch(void* const* d_in, const int* in_sizes, int n_in, void* d_out, int out_size, void* d_ws, size_t ws_size, hipStream_t stream) {
    static int grid = 0;
    if (grid == 0) {
        if (n_in != 23 || out_size != MLAT * DM || ws_size < WS_END) { fprintf(stderr, "kernel_launch: unexpected shapes n_in %d out %d ws %zu\n", n_in, out_size, ws_size); grid = -1; return; }
        int dev = 0, cus = 0, per_cu = 0;
        (void)hipGetDevice(&dev);
        (void)hipDeviceGetAttribute(&cus, hipDeviceAttributeMultiprocessorCount, dev);
        (void)hipFuncSetAttribute((const void*)fwd, hipFuncAttributeMaxDynamicSharedMemorySize, LDS_BYTES);
        (void)hipOccupancyMaxActiveBlocksPerMultiprocessor(&per_cu, (const void*)fwd, NTHR, LDS_BYTES);
        if (per_cu < 1) per_cu = 1;
        grid = cus * per_cu;
        fprintf(stderr, "kernel_launch: cus %d per_cu %d grid %d ws %zu\n", cus, per_cu, grid, ws_size);
    }
    if (grid < 0) return;
    Args a{};
    for (int i = 0; i < 23; ++i) a.in[i] = (const float*)d_in[i];
    a.out = (float*)d_out; a.ws = (unsigned char*)d_ws;
    (void)hipMemsetAsync((char*)d_ws + WS_CTL, 0, 32768, stream);
    a.ph_lo = 0; a.ph_hi = NPHASES; a.rep_phase = PROBE_PHASE; a.rep_count = PROBE_COUNT;
    void* kargs[] = {&a};
    hipError_t e = hipLaunchCooperativeKernel((const void*)fwd, dim3(grid), dim3(NTHR), kargs, LDS_BYTES, stream);
    if (e != hipSuccess) fprintf(stderr, "kernel_launch: cooperative launch failed: %s (grid %d)\n", hipGetErrorString(e), grid);
}
```
